# Optimizing an MI355X kernel written in HIP

```python
import math
import jax, jax.numpy as jnp
from jax import lax
import numpy as np

D_MODEL = 1024
BATCH = 32
SEQ = 256
DEPTH = 2
DEC_BATCH = 2
DEC_SEQ = 1024
PAST_LEN = 256

GRID_W = 64
MLA_HEADS = 6
MLA_NOPE = 64
MLA_ROPE = 32
MLA_QK = MLA_NOPE + MLA_ROPE
MLA_V = 64
Q_LORA = 256
KV_LORA = 128
NA_HEADS = 6
NA_HD = 64
NA_KR = 8
NA_KW = 16
DF_HEADS = 4
DF_HD = 64
DF_QK = 32

MLA_W = MLA_HEADS * MLA_V
NA_W = NA_HEADS * NA_HD
DF_W = DF_HEADS * DF_HD
MIX_W = MLA_W + NA_W + DF_W
SPLIT_SIZES = (Q_LORA, KV_LORA, MLA_ROPE, NA_W, NA_W, NA_W, DF_W, DF_W, DF_W)
IN_COLS = Q_LORA + KV_LORA + MLA_ROPE + 3 * NA_W + 3 * DF_W
D_FF = -(-8 * D_MODEL // (3 * 256)) * 256
ROPE_BASE = 10000.0
EPS = 1e-6
Q_BLOCK = 128
NEG = -1e30

kernel_name = 'hybrid_mla_natten_diff_dit_step'


def _rms(x, g):
    xf = x.astype(jnp.float32)
    y = xf * lax.rsqrt(jnp.mean(xf * xf, axis=-1, keepdims=True) + EPS)
    return (y * g.astype(jnp.float32)).astype(x.dtype)


def _rms_pairs(x, g):
    s = x.shape
    return _rms(x.reshape(s[:-1] + (2, DF_QK)), g).reshape(s)


def _heads(t, n):
    b, l, _ = t.shape
    return t.reshape(b, l, n, -1).transpose(0, 2, 1, 3)


def _merge(t):
    b, h, l, d = t.shape
    return t.transpose(0, 2, 1, 3).reshape(b, l, h * d)


def _axial_rope(length, rot_dim):
    t = jnp.arange(length)
    row = (t // GRID_W).astype(jnp.float32)
    col = (t % GRID_W).astype(jnp.float32)
    n = rot_dim // 4
    inv = 1.0 / (ROPE_BASE ** (jnp.arange(n, dtype=jnp.float32) * 2.0 / (rot_dim // 2)))
    ar = row[:, None] * inv
    ac = col[:, None] * inv
    ang = jnp.concatenate([ar, ar, ac, ac], axis=-1)
    return jnp.cos(ang), jnp.sin(ang)


def _rotate_axial(x):
    xs = x.reshape(x.shape[:-1] + (2, 2, -1))
    x1, x2 = xs[..., 0, :], xs[..., 1, :]
    return jnp.stack([-x2, x1], axis=-2).reshape(x.shape)


def _apply_rope(x, cos, sin):
    xf = x.astype(jnp.float32)
    return (xf * cos + _rotate_axial(xf) * sin).astype(x.dtype)


def _rope_tail(x, cos, sin):
    return jnp.concatenate([x[..., :MLA_NOPE], _apply_rope(x[..., MLA_NOPE:], cos, sin)], axis=-1)


def _rope_pairs(x, cos, sin):
    s = x.shape
    xr = x.reshape(s[:-1] + (2, DF_QK))
    return _apply_rope(xr, cos[:, None], sin[:, None]).reshape(s)


def _over_query_blocks(fn, q):
    b, h, l, d = q.shape
    qb = math.gcd(l, Q_BLOCK)
    nb = l // qb
    blocks = q.reshape(b, h, nb, qb, d).transpose(2, 0, 1, 3, 4)
    out = lax.map(fn, blocks)
    return out.transpose(1, 2, 0, 3, 4).reshape(b, h, l, out.shape[-1])


def _softmax_attend(q, k, v, scale):
    def blk(qb):
        s = jnp.einsum('bhqd,bhkd->bhqk', qb, k).astype(jnp.float32) * scale
        p = jax.nn.softmax(s, axis=-1).astype(v.dtype)
        return jnp.einsum('bhqk,bhkd->bhqd', p, v)
    return _over_query_blocks(blk, q)


def _diff_lambda(lp, lam_init):
    f = lambda a: a.astype(jnp.float32)
    return (jnp.exp(jnp.sum(f(lp['df_lq1']) * f(lp['df_lk1'])))
            - jnp.exp(jnp.sum(f(lp['df_lq2']) * f(lp['df_lk2']))) + lam_init)


def _diff_attend(q, k, v, lp, lam_init):
    scale = DF_QK ** -0.5
    lam = _diff_lambda(lp, lam_init)
    k1, k2 = k[..., :DF_QK], k[..., DF_QK:]

    def blk(qb):
        s1 = jnp.einsum('bhqd,bhkd->bhqk', qb[..., :DF_QK], k1).astype(jnp.float32) * scale
        s2 = jnp.einsum('bhqd,bhkd->bhqk', qb[..., DF_QK:], k2).astype(jnp.float32) * scale
        p = jax.nn.softmax(s1, axis=-1) - lam * jax.nn.softmax(s2, axis=-1)
        return jnp.einsum('bhqk,bhkd->bhqd', p.astype(v.dtype), v)
    o = _over_query_blocks(blk, q)
    return _rms(o, lp['g_df_sub']) * (1.0 - lam_init)


def _neighbourhood_attend(q, k, v, k_ctx, v_ctx, rpb):
    b, h, L, d = q.shape
    rows = L // GRID_W
    kr = min(NA_KR, rows)
    kw = NA_KW
    r = jnp.arange(rows)
    cidx = jnp.arange(GRID_W)
    row_idx = jnp.clip(r - kr // 2, 0, rows - kr)[:, None] + jnp.arange(kr)[None, :]
    col_start = jnp.clip(cidx - kw // 2, 0, GRID_W - kw)
    in_win = (cidx[None, :] >= col_start[:, None]) & (cidx[None, :] < col_start[:, None] + kw)
    rel_r = row_idx - r[:, None] + (NA_KR - 1)
    rel_c = jnp.clip(cidx[None, :] - cidx[:, None], -(kw - 1), kw - 1) + (kw - 1)
    bias = rpb[:, rel_r[:, None, :, None], rel_c[None, :, None, :]]
    qg = q.reshape(b, h, rows, GRID_W, d)
    kg = k.reshape(b, h, rows, GRID_W, d)[:, :, row_idx]
    vg = v.reshape(b, h, rows, GRID_W, d)[:, :, row_idx]
    scale = d ** -0.5
    s_win = jnp.einsum('bhrqd,bhrjkd->bhrqjk', qg, kg).astype(jnp.float32) * scale + bias[None].astype(jnp.float32)
    s_win = jnp.where(in_win[:, None, :], s_win, NEG)
    s_ctx = jnp.einsum('bhrqd,bhcd->bhrqc', qg, k_ctx).astype(jnp.float32) * scale
    n_win = kr * GRID_W
    p = jax.nn.softmax(jnp.concatenate([s_win.reshape(b, h, rows, GRID_W, n_win), s_ctx], axis=-1), axis=-1).astype(v.dtype)
    p_win = p[..., :n_win].reshape(b, h, rows, GRID_W, kr, GRID_W)
    o = (jnp.einsum('bhrqjk,bhrjkd->bhrqd', p_win, vg)
         + jnp.einsum('bhrqc,bhcd->bhrqd', p[..., n_win:], v_ctx))
    return o.reshape(b, h, L, d)


def _modulation(cvec, w_mod, b_mod):
    m = jax.nn.silu(cvec) @ w_mod + b_mod
    return jnp.split(m[:, None, :], 6, axis=-1)


def _split_in(z):
    idx = np.cumsum(SPLIT_SIZES)[:-1].tolist()
    return jnp.split(z, idx, axis=-1)


def _mixer_front(x, mod, lp):
    sh, sc = mod[0], mod[1]
    h = _rms(x, lp['g_mix']) * (1.0 + sc) + sh
    cq, ckv, krope, na_q, na_k, na_v, df_q, df_k, df_v = _split_in(h @ lp['w_in'])
    q_mla = _rms(_heads(_rms(cq, lp['g_qa']) @ lp['w_uq'], MLA_HEADS), lp['g_mla_q'])
    ckv_n = _rms(ckv, lp['g_kva'])
    q_na = _rms(_heads(na_q, NA_HEADS), lp['g_na_q'])
    k_na = _rms(_heads(na_k, NA_HEADS), lp['g_na_k'])
    v_na = _heads(na_v, NA_HEADS)
    q_df = _rms_pairs(_heads(df_q, DF_HEADS), lp['g_df_q'])
    k_df = _rms_pairs(_heads(df_k, DF_HEADS), lp['g_df_k'])
    v_df = _heads(df_v, DF_HEADS)
    return q_mla, ckv_n, krope, q_na, k_na, v_na, q_df, k_df, v_df


def _mla_keys(ckv_n, krope, lp):
    kv = _heads(ckv_n @ lp['w_ukv'], MLA_HEADS)
    b, h, l, _ = kv.shape
    kr = jnp.broadcast_to(krope[:, None], (b, h, l, MLA_ROPE))
    k = _rms(jnp.concatenate([kv[..., :MLA_NOPE], kr], axis=-1), lp['g_mla_k'])
    return k, kv[..., MLA_NOPE:]


def _finish(x, o_mla, o_na, o_df, mod, lp):
    mix = jnp.concatenate([_merge(o_mla), _merge(o_na), _merge(o_df)], axis=-1) @ lp['w_out']
    x = x + mod[2] * mix
    h = _rms(x, lp['g_ffn']) * (1.0 + mod[4]) + mod[3]
    ffn = (jax.nn.silu(h @ lp['w_gate']) * (h @ lp['w_up'])) @ lp['w_down']
    return x + mod[5] * ffn


def _context_layer(x, mod, lp, lam_init):
    q_mla, ckv_n, krope, q_na, k_na, v_na, q_df, k_df, v_df = _mixer_front(x, mod, lp)
    k_mla, v_mla = _mla_keys(ckv_n, krope, lp)
    o_mla = _softmax_attend(q_mla, k_mla, v_mla, MLA_QK ** -0.5)
    o_na = _softmax_attend(q_na, k_na, v_na, NA_HD ** -0.5)
    o_df = _diff_attend(q_df, k_df, v_df, lp, lam_init)
    return _finish(x, o_mla, o_na, o_df, mod, lp), (ckv_n, krope, k_na, v_na, k_df, v_df)


def _latent_layer(x, mod, lp, lam_init, ctx):
    ckv_c, krope_c, k_na_c, v_na_c, k_df_c, v_df_c = ctx
    L = x.shape[1]
    cos_m, sin_m = _axial_rope(L, MLA_ROPE)
    cos_d, sin_d = _axial_rope(L, DF_QK)
    q_mla, ckv_n, krope, q_na, k_na, v_na, q_df, k_df, v_df = _mixer_front(x, mod, lp)
    q_mla = _rope_tail(q_mla, cos_m, sin_m)
    k_lat, v_lat = _mla_keys(ckv_n, krope, lp)
    k_lat = _rope_tail(k_lat, cos_m, sin_m)
    k_ctx, v_ctx = _mla_keys(ckv_c, krope_c, lp)
    o_mla = _softmax_attend(q_mla, jnp.concatenate([k_ctx, k_lat], axis=2),
                            jnp.concatenate([v_ctx, v_lat], axis=2), MLA_QK ** -0.5)
    o_na = _neighbourhood_attend(q_na, k_na, v_na, k_na_c, v_na_c, lp['na_rpb'])
    q_df = _rope_pairs(q_df, cos_d, sin_d)
    k_df = _rope_pairs(k_df, cos_d, sin_d)
    o_df = _diff_attend(q_df, jnp.concatenate([k_df_c, k_df], axis=2),
                        jnp.concatenate([v_df_c, v_df], axis=2), lp, lam_init)
    return _finish(x, o_mla, o_na, o_df, mod, lp)


def setup_inputs(seed: int = 0) -> dict:
    key = jax.random.key(seed)
    ks = jax.random.split(key, 36)
    f32 = jnp.float32
    nrm = lambda k, shape, s: jax.random.normal(k, shape, f32) * s
    gain = lambda k, shape: 1.0 + 0.05 * jax.random.normal(k, shape, f32)
    return {
        'x_prompt': nrm(ks[0], (BATCH, SEQ, D_MODEL), 1.0),
        'x_sample': nrm(ks[1], (DEC_BATCH, DEC_SEQ, D_MODEL), 1.0),
        'cache_mla_ckv': nrm(ks[2], (DEC_BATCH, DEPTH, PAST_LEN, KV_LORA), 1.0),
        'cache_mla_krope': nrm(ks[3], (DEC_BATCH, DEPTH, PAST_LEN, MLA_ROPE), 1.0),
        'cache_na_k': nrm(ks[4], (DEC_BATCH, DEPTH, NA_HEADS, PAST_LEN, NA_HD), 1.0),
        'cache_na_v': nrm(ks[5], (DEC_BATCH, DEPTH, NA_HEADS, PAST_LEN, NA_HD), 1.0),
        'cache_df_k': nrm(ks[6], (DEC_BATCH, DEPTH, DF_HEADS, PAST_LEN, 2 * DF_QK), 1.0),
        'cache_df_v': nrm(ks[7], (DEC_BATCH, DEPTH, DF_HEADS, PAST_LEN, DF_HD), 1.0),
        'c': nrm(ks[8], (DEC_BATCH, D_MODEL), 1.0),
        'c_ctx': nrm(ks[9], (D_MODEL,), 1.0),
        'w_mod': nrm(ks[10], (DEPTH, D_MODEL, 6 * D_MODEL), 0.5 * D_MODEL ** -0.5),
        'b_mod': nrm(ks[11], (DEPTH, 6 * D_MODEL), 0.01),
        'g_mix': gain(ks[12], (DEPTH, D_MODEL)),
        'w_in': nrm(ks[13], (DEPTH, D_MODEL, IN_COLS), D_MODEL ** -0.5),
        'g_qa': gain(ks[14], (DEPTH, Q_LORA)),
        'w_uq': nrm(ks[15], (DEPTH, Q_LORA, MLA_HEADS * MLA_QK), Q_LORA ** -0.5),
        'g_kva': gain(ks[16], (DEPTH, KV_LORA)),
        'w_ukv': nrm(ks[17], (DEPTH, KV_LORA, MLA_HEADS * (MLA_NOPE + MLA_V)), KV_LORA ** -0.5),
        'g_mla_q': gain(ks[18], (DEPTH, MLA_QK)),
        'g_mla_k': gain(ks[19], (DEPTH, MLA_QK)),
        'g_na_q': gain(ks[20], (DEPTH, NA_HD)),
        'g_na_k': gain(ks[21], (DEPTH, NA_HD)),
        'na_rpb': nrm(ks[22], (DEPTH, NA_HEADS, 2 * NA_KR - 1, 2 * NA_KW - 1), 0.1),
        'g_df_q': gain(ks[23], (DEPTH, DF_QK)),
        'g_df_k': gain(ks[24], (DEPTH, DF_QK)),
        'df_lq1': nrm(ks[25], (DEPTH, DF_QK), 0.1),
        'df_lk1': nrm(ks[26], (DEPTH, DF_QK), 0.1),
        'df_lq2': nrm(ks[27], (DEPTH, DF_QK), 0.1),
        'df_lk2': nrm(ks[28], (DEPTH, DF_QK), 0.1),
        'g_df_sub': gain(ks[29], (DEPTH, DF_HD)),
        'w_out': nrm(ks[30], (DEPTH, MIX_W, D_MODEL), MIX_W ** -0.5),
        'g_ffn': gain(ks[31], (DEPTH, D_MODEL)),
        'w_gate': nrm(ks[32], (DEPTH, D_MODEL, D_FF), D_MODEL ** -0.5),
        'w_up': nrm(ks[33], (DEPTH, D_MODEL, D_FF), D_MODEL ** -0.5),
        'w_down': nrm(ks[34], (DEPTH, D_FF, D_MODEL), D_FF ** -0.5),
    }


def reference(x_prompt, x_sample, cache_mla_ckv, cache_mla_krope, cache_na_k, cache_na_v,
              cache_df_k, cache_df_v, c, c_ctx, w_mod, b_mod, g_mix, w_in, g_qa, w_uq, g_kva,
              w_ukv, g_mla_q, g_mla_k, g_na_q, g_na_k, na_rpb, g_df_q, g_df_k, df_lq1, df_lk1,
              df_lq2, df_lk2, g_df_sub, w_out, g_ffn, w_gate, w_up, w_down):
    xp = x_prompt
    xs = x_sample
    new = [[], [], [], [], [], []]
    for l in range(DEPTH):
        lp = {'g_mix': g_mix[l], 'w_in': w_in[l], 'g_qa': g_qa[l], 'w_uq': w_uq[l],
              'g_kva': g_kva[l], 'w_ukv': w_ukv[l], 'g_mla_q': g_mla_q[l], 'g_mla_k': g_mla_k[l],
              'g_na_q': g_na_q[l], 'g_na_k': g_na_k[l], 'na_rpb': na_rpb[l],
              'g_df_q': g_df_q[l], 'g_df_k': g_df_k[l], 'df_lq1': df_lq1[l], 'df_lk1': df_lk1[l],
              'df_lq2': df_lq2[l], 'df_lk2': df_lk2[l], 'g_df_sub': g_df_sub[l],
              'w_out': w_out[l], 'g_ffn': g_ffn[l], 'w_gate': w_gate[l], 'w_up': w_up[l],
              'w_down': w_down[l]}
        lam_init = 0.8 - 0.6 * math.exp(-0.3 * l)
        mod_ctx = _modulation(c_ctx[None, :], w_mod[l], b_mod[l])
        mod_lat = _modulation(c, w_mod[l], b_mod[l])
        xp, ctx_new = _context_layer(xp, mod_ctx, lp, lam_init)
        for lst, t in zip(new, ctx_new):
            lst.append(t)
        ctx_cached = (cache_mla_ckv[:, l], cache_mla_krope[:, l], cache_na_k[:, l],
                      cache_na_v[:, l], cache_df_k[:, l], cache_df_v[:, l])
        xs = _latent_layer(xs, mod_lat, lp, lam_init, ctx_cached)
    new_mla_ckv = jnp.stack(new[0], axis=1)
    new_mla_krope = jnp.stack(new[1], axis=1)
    new_na_k = jnp.stack(new[2], axis=1)
    new_na_v = jnp.stack(new[3], axis=1)
    new_df_k = jnp.stack(new[4], axis=1)
    new_df_v = jnp.stack(new[5], axis=1)
    return (xp, xs, new_mla_ckv, new_mla_krope, new_na_k, new_na_v, new_df_k, new_df_v)
```

```cpp
#include <hip/hip_runtime.h>
#include <hip/hip_cooperative_groups.h>
#include <cstdio>
#include <cstdint>
namespace cg = cooperative_groups;

typedef unsigned short u16;
typedef __attribute__((ext_vector_type(8))) short bf16x8;
typedef __attribute__((ext_vector_type(4))) float f32x4;
typedef __attribute__((ext_vector_type(16))) float f32x16;
typedef __attribute__((ext_vector_type(4))) unsigned u32x4;

#define DI __device__ __forceinline__

constexpr int D = 1024;
constexpr int TCTX = 8192;
constexpr int TLAT = 2048;
constexpr int T = TCTX + TLAT;
constexpr int NIN = 2560;
constexpr int DFF = 2816;
constexpr int NGU = 2 * DFF;
constexpr float EPS = 1e-6f;
constexpr int NKL = 1280;

constexpr size_t OUT_YP = 0;
constexpr size_t OUT_CKV = 10485760;
constexpr size_t OUT_KROPE = 12582912;
constexpr size_t OUT_NAK = 13107200;
constexpr size_t OUT_NAV = 19398656;
constexpr size_t OUT_DFK = 25690112;
constexpr size_t OUT_DFV = 29884416;

struct Params {
  const float *x_prompt, *x_sample, *cache_mla_ckv, *cache_mla_krope, *cache_na_k, *cache_na_v, *cache_df_k, *cache_df_v, *c, *c_ctx;
  const float *w_mod, *b_mod, *g_mix, *w_in, *g_qa, *w_uq, *g_kva, *w_ukv, *g_mla_q, *g_mla_k, *g_na_q, *g_na_k, *na_rpb, *g_df_q,
      *g_df_k, *df_lq1, *df_lk1, *df_lq2, *df_lk2, *g_df_sub, *w_out, *g_ffn, *w_gate, *w_up, *w_down;
  float* out;
  u16 *win_t, *wuq_t, *wukv_t, *wout_t, *wgu_t, *wdn_t;
  float* mod;
  u16* h;
  float *cq, *ckv, *krope;
  u16 *qmla, *qna, *qdf;
  u16 *kmla_c, *vmla_c, *kna_c, *vna_c, *kdf_c, *vdf_c;
  u16 *kmla_l, *vmla_l, *kna_l, *vna_l, *kdf_l, *vdf_l;
  u16* o;
  u16 *xa, *xb;
  u16* act;
  float* lam;
  unsigned* counters;
  unsigned* bar;
};

DI int opaque_v(int x) { asm volatile("" : "+v"(x)); return x; }
DI int opaque_s(int x) { asm volatile("" : "+s"(x)); return x; }
#define TIDX opaque_v((int)threadIdx.x)
#define BIDX opaque_s((int)blockIdx.x)
DI unsigned cvtpk(float lo, float hi) {
  unsigned r;
  asm volatile("v_cvt_pk_bf16_f32 %0, %1, %2" : "=v"(r) : "v"(lo), "v"(hi));
  return r;
}
DI u16 f2bf(float f) { return (u16)(cvtpk(f, 0.f) & 0xffffu); }
DI bf16x8 pack8(float a0, float a1, float a2, float a3, float a4, float a5, float a6, float a7) {
  uint4 u;
  u.x = cvtpk(a0, a1); u.y = cvtpk(a2, a3); u.z = cvtpk(a4, a5); u.w = cvtpk(a6, a7);
  return __builtin_bit_cast(bf16x8, u);
}
DI void st_bf4(u16* p, float a, float b, float c, float d) {
  uint2 u; u.x = cvtpk(a, b); u.y = cvtpk(c, d);
  *(uint2*)p = u;
}
DI f32x16 mfma32(bf16x8 a, bf16x8 b, f32x16 c) { return __builtin_amdgcn_mfma_f32_32x32x16_bf16(a, b, c, 0, 0, 0); }
DI f32x4 mfma16(bf16x8 a, bf16x8 b, f32x4 c) { return __builtin_amdgcn_mfma_f32_16x16x32_bf16(a, b, c, 0, 0, 0); }
DI float lam_init_of(int l) { return l == 0 ? 0.2f : 0.35550906759f; }
DI f32x4 bf4_to_f32(uint2 u) {
  f32x4 r;
  r[0] = __uint_as_float(u.x << 16); r[1] = __uint_as_float(u.x & 0xffff0000u);
  r[2] = __uint_as_float(u.y << 16); r[3] = __uint_as_float(u.y & 0xffff0000u);
  return r;
}
struct ResSrc { const float* f; const u16* h; };
DI ResSrc xrow_in(const Params& p, int l, int t) {
  ResSrc r; r.f = nullptr; r.h = nullptr;
  if (l == 0) r.f = t < TCTX ? p.x_prompt + (size_t)t * D : p.x_sample + (size_t)(t - TCTX) * D;
  else r.h = p.xb + (size_t)t * D;
  return r;
}
DI ResSrc xa_row(const Params& p, int t) { ResSrc r; r.f = nullptr; r.h = p.xa + (size_t)t * D; return r; }
DI f32x4 res_ld4(const ResSrc& s, int c) { return s.f ? *(const f32x4*)(s.f + c) : bf4_to_f32(*(const uint2*)(s.h + c)); }
DI int cond_of(int t) { return t < TCTX ? 0 : 1 + ((t - TCTX) >> 10); }

DI void rope32(f32x16& x, int s, int hh) {
  const float prow = (float)(s >> 6), pcol = (float)(s & 63);
  const float hs = hh ? 0.01f : 1.0f;
  f32x16 y;
#pragma unroll
  for (int reg = 0; reg < 16; ++reg) {
    const int a = reg >> 3, half = (reg >> 2) & 1, i3 = reg & 3;
    const float base = (i3 == 0) ? 1.0f : (i3 == 1) ? 0.31622776601683794f : (i3 == 2) ? 0.1f : 0.031622776601683794f;
    const float ang = (a ? pcol : prow) * (base * hs);
    const float cs = __cosf(ang), sn = __sinf(ang);
    const float partner = x[reg ^ 4];
    y[reg] = x[reg] * cs + (half ? partner : -partner) * sn;
  }
  x = y;
}


#define XB_TMO      128
#define XB_XCNT(j)  (256  + 64 * (j))
#define XB_XSUB(j)  (1280 + 64 * (j))
#define XB_XGEN(j)  (2304 + 64 * (j))
#define XB_TOP      3328
#define XB_TOPGEN   3392
#define XCD_BAR_WORDS 3456
#define XB_SPIN_CAP (1u << 22)
#define LAS __attribute__((address_space(3)))
DI unsigned xb_ld(unsigned* p) { return __hip_atomic_load(p, __ATOMIC_RELAXED, __HIP_MEMORY_SCOPE_AGENT); }
DI unsigned xb_add(unsigned* p, unsigned v) { return __hip_atomic_fetch_add(p, v, __ATOMIC_RELAXED, __HIP_MEMORY_SCOPE_AGENT); }
DI unsigned xb_xcc_id() { return (unsigned)__builtin_amdgcn_s_getreg((3 << 11) | 20) & 0xFu; }
#define XB_SPIN(cond, bar) do { unsigned _sp = 0; while (cond) { __builtin_amdgcn_s_sleep(1); \
    if ((++_sp & 255u) == 0u) { if (xb_ld(&(bar)[XB_TMO])) break; if (_sp > XB_SPIN_CAP) { atomicAdd(&(bar)[XB_TMO], 1u); break; } } } } while (0)
struct XcdBarrier { unsigned* bar; unsigned x; volatile LAS unsigned* st; };
DI XcdBarrier xcd_barrier_post(unsigned* bar, volatile LAS unsigned* st) {
  XcdBarrier b; b.bar = bar; b.x = xb_xcc_id(); b.st = st;
  if (threadIdx.x == 0) (void)xb_add(&bar[XB_XCNT(b.x)], 1u);
  return b;
}
DI void xcd_barrier_complete(unsigned* bar, unsigned x, unsigned& nloc, unsigned& nx) {
  const unsigned G = gridDim.x * gridDim.y * gridDim.z;
  unsigned sum, cnt, mine, sp = 0u;
  for (;;) {
    sum = 0u; cnt = 0u; mine = 0u;
#pragma unroll
    for (unsigned j = 0; j < 16; ++j) { const unsigned c = xb_ld(&bar[XB_XCNT(j)]); sum += c; cnt += (c > 0u) ? 1u : 0u; mine = (j == x) ? c : mine; }
    if (sum == G) break;
    __builtin_amdgcn_s_sleep(1);
    if ((++sp & 255u) == 0u) { if (xb_ld(&bar[XB_TMO])) break; if (sp > XB_SPIN_CAP) { atomicAdd(&bar[XB_TMO], 1u); break; } }
  }
  nloc = mine > 0u ? mine : 1u; nx = cnt > 0u ? cnt : 1u;
}
DI void xcd_barrier(const XcdBarrier& b) {
  asm volatile("s_waitcnt vmcnt(0)" ::: "memory");
  __syncthreads();
  if (threadIdx.x == 0) {
    unsigned* bar = b.bar;
    __builtin_amdgcn_s_waitcnt(0);
    unsigned nloc = b.st[0], nx = b.st[1];
    if (nloc == 0u) { xcd_barrier_complete(bar, b.x, nloc, nx); b.st[0] = nloc; b.st[1] = nx; }
    const unsigned old = xb_add(&bar[XB_XSUB(b.x)], 1u);
    const unsigned gen = old / nloc;
    if (old + 1u == (gen + 1u) * nloc) {
      __builtin_amdgcn_fence(__ATOMIC_RELEASE, "agent");
      asm volatile("s_waitcnt vmcnt(0)" ::: "memory");
      const unsigned og = xb_add(&bar[XB_TOP], 1u);
      const unsigned tg = og / nx;
      if (og + 1u == (tg + 1u) * nx) xb_add(&bar[XB_TOPGEN], 1u);
      else XB_SPIN(xb_ld(&bar[XB_TOPGEN]) == tg, bar);
      __builtin_amdgcn_fence(__ATOMIC_ACQUIRE, "agent");
      xb_add(&bar[XB_XGEN(b.x)], 1u);
      asm volatile("s_waitcnt vmcnt(0)" ::: "memory");
    } else {
      XB_SPIN(xb_ld(&bar[XB_XGEN(b.x)]) == gen, bar);
      __builtin_amdgcn_fence(__ATOMIC_ACQUIRE, "agent");
      asm volatile("s_waitcnt vmcnt(0)" ::: "memory");
    }
  }
  __syncthreads();
}

DI size_t kf_off(int kidx, int d8  , int ndk) { return ((size_t)((kidx >> 5) * ndk + (d8 >> 4)) * 64 + ((d8 >> 3) & 1) * 32 + (kidx & 31)) * 8; }
DI size_t vf_off(int kidx, int d) {
  const int kin = kidx & 31, q = kin & 15;
  return ((size_t)(((kidx >> 5) * 2 + (kin >> 4)) * 2 + (d >> 5)) * 64 + ((q >> 2) & 1) * 32 + (d & 31)) * 8 + 4 * (q >> 3) + (q & 3);
}

DI int phys_row(int L) {
  const int cl = L & 31;
  const int rho = 16 * ((cl >> 2) & 1) + 4 * (cl >> 3) + (cl & 3);
  return (L & ~255) + ((L >> 5) & 1) * 128 + ((L >> 6) & 3) * 32 + rho;
}
DI int map_row(int type, int n) {
  if (type == 1) {
    const int L = (n < 384) ? n : (n < 416) ? 2304 + (n - 384) : n - 32;
    return phys_row(L);
  }
  if (type == 2 || type == 3) {
    const int cl = n & 31;
    const int rho = 16 * ((cl >> 2) & 1) + 4 * (cl >> 3) + (cl & 3);
    return (n >> 7) * 256 + (type == 3 ? 128 : 0) + ((n >> 5) & 3) * 32 + rho;
  }
  if (type == 0) return phys_row(n);
  return n;
}
DI void transpose_tile(const float* __restrict__ src, int ld_src, int N, int k0, int n0, u16* __restrict__ dst, int ld_dst,
                       int type, int mode, u16* tile, int ng) {
  const int tid = TIDX;
  {
    const int c4 = tid & 15, r0 = tid >> 4;
    float4 v[4][2];
#pragma unroll
    for (int j = 0; j < 4; ++j)
#pragma unroll
      for (int ps = 0; ps < 2; ++ps) {
        v[j][ps] = make_float4(0.f, 0.f, 0.f, 0.f);
        if (j < ng && n0 + j * 64 + c4 * 4 < N) {
          const f32x4 t4 = __builtin_nontemporal_load((const f32x4*)(src + (size_t)(k0 + r0 + ps * 32) * ld_src + n0 + j * 64 + c4 * 4));
          v[j][ps] = make_float4(t4[0], t4[1], t4[2], t4[3]);
        }
      }
#pragma unroll
    for (int j = 0; j < 4; ++j)
      if (j < ng) {
#pragma unroll
        for (int ps = 0; ps < 2; ++ps) {
          unsigned* tp = (unsigned*)(tile + j * 4224 + (r0 + ps * 32) * 66 + c4 * 4);
          tp[0] = cvtpk(v[j][ps].x, v[j][ps].y);
          tp[1] = cvtpk(v[j][ps].z, v[j][ps].w);
        }
      }
  }
  __syncthreads();
  {
    const int kc = tid & 7, nrow = tid >> 3;
    const int k = k0 + kc * 8;
#pragma unroll
    for (int j = 0; j < 4; ++j) {
      const int n = n0 + j * 64 + nrow;
      if (j < ng && n < N) {
        const u16* tj = tile + j * 4224;
        unsigned w[4];
#pragma unroll
        for (int q = 0; q < 4; ++q) {
          const unsigned lo = tj[(kc * 8 + 2 * q) * 66 + nrow];
          const unsigned hi = tj[(kc * 8 + 2 * q + 1) * 66 + nrow];
          w[q] = lo | (hi << 16);
        }
        size_t off;
        if (mode == 0) {
          if (type == 4) {
            off = ((size_t)((n >> 5) * (ld_dst >> 4) + (k >> 4)) * 64 + ((k >> 3) & 1) * 32 + (n & 31)) * 8;
          } else off = (size_t)map_row(type, n) * ld_dst + k;
          *(uint4*)(dst + off) = make_uint4(w[0], w[1], w[2], w[3]);
        } else {
          const size_t o0 = vf_off(k, n);
          *(uint2*)(dst + o0) = make_uint2(w[0], w[1]);
          *(uint2*)(dst + o0 + 32 * 8) = make_uint2(w[2], w[3]);
        }
      }
    }
  }
  __syncthreads();
}

DI void mod_item(const Params& p, int l, int chunk, float* lds) {
  const int tid = TIDX;
  float* sv = lds;
  float* red = lds + 3072;
  for (int i = tid; i < 3072; i += 512) {
    const int n = i >> 10, k = i & 1023;
    const float v = (n == 0) ? p.c_ctx[k] : p.c[(n - 1) * 1024 + k];
    sv[i] = v / (1.f + expf(-v));
  }
  __syncthreads();
  const int c4 = tid & 15, kg = tid >> 4;
  const int c0 = chunk * 64;
  float acc[3][4];
#pragma unroll
  for (int n = 0; n < 3; ++n)
#pragma unroll
    for (int e = 0; e < 4; ++e) acc[n][e] = 0.f;
  const float* wp = p.w_mod + ((size_t)l * 1024 + kg * 32) * 6144 + c0 + c4 * 4;
#pragma unroll 8
  for (int kk = 0; kk < 32; ++kk) {
    const f32x4 w4 = __builtin_nontemporal_load((const f32x4*)(wp + (size_t)kk * 6144));
    const float4 w = make_float4(w4[0], w4[1], w4[2], w4[3]);
    const int k = kg * 32 + kk;
#pragma unroll
    for (int n = 0; n < 3; ++n) {
      const float s = sv[n * 1024 + k];
      acc[n][0] += s * w.x; acc[n][1] += s * w.y; acc[n][2] += s * w.z; acc[n][3] += s * w.w;
    }
  }
#pragma unroll
  for (int n = 0; n < 3; ++n)
#pragma unroll
    for (int e = 0; e < 4; ++e) red[(kg * 12 + n * 4 + e) * 16 + c4] = acc[n][e];
  __syncthreads();
  if (tid < 192) {
    const int n = tid >> 6, cc = tid & 63, cc4 = cc >> 2, e = cc & 3;
    float s = 0.f;
#pragma unroll
    for (int g = 0; g < 32; ++g) s += red[(g * 12 + n * 4 + e) * 16 + cc4];
    p.mod[(size_t)(l * 3 + n) * 6144 + c0 + cc] = s + p.b_mod[(size_t)l * 6144 + c0 + cc];
  }
  __syncthreads();
}

constexpr int P0_TR_PER_LAYER = 160 + 12 + 6 + 64 + 176 + 176 + 176 + 48 + 32;
constexpr int P0_MOD_PER_LAYER = 96;
constexpr int P0_KC_PER_LAYER = 20;
constexpr int P0_PER_LAYER = P0_TR_PER_LAYER + P0_MOD_PER_LAYER + P0_KC_PER_LAYER;

DI void prep_item(const Params& p, int l, int r, char* lds) {
  const int tid = TIDX;
    if (r < P0_MOD_PER_LAYER) { mod_item(p, l, r, (float*)lds); return; }
    r -= P0_MOD_PER_LAYER;
    u16* tile = (u16*)lds;
    if (r < 160) {
      const int kt = r / 10, g = r % 10;
      transpose_tile(p.w_in + (size_t)l * 1024 * 2336, 2336, 2336, kt * 64, g * 256, p.win_t + (size_t)l * NIN * 1024, 1024, 1, 0, tile, min(4, 37 - 4 * g));
      return;
    }
    r -= 160;
    if (r < 12) {
      const int kt = r / 3, g = r % 3;
      transpose_tile(p.w_uq + (size_t)l * 256 * 576, 576, 576, kt * 64, g * 256, p.wuq_t + (size_t)l * 576 * 256, 256, 4, 0, tile, min(4, 9 - 4 * g));
      return;
    }
    r -= 12;
    if (r < 6) {
      const int kt = r / 3, g = r % 3;
      transpose_tile(p.w_ukv + (size_t)l * 128 * 768, 768, 768, kt * 64, g * 256, p.wukv_t + (size_t)l * 768 * 128, 128, 4, 0, tile, 4);
      return;
    }
    r -= 6;
    if (r < 64) {
      const int kt = r / 4, g = r % 4;
      transpose_tile(p.w_out + (size_t)l * 1024 * 1024, 1024, 1024, kt * 64, g * 256, p.wout_t + (size_t)l * 1024 * 1024, 1024, 0, 0, tile, 4);
      return;
    }
    r -= 64;
    if (r < 176) {
      const int kt = r / 11, g = r % 11;
      transpose_tile(p.w_gate + (size_t)l * 1024 * DFF, DFF, DFF, kt * 64, g * 256, p.wgu_t + (size_t)l * NGU * 1024, 1024, 2, 0, tile, 4);
      return;
    }
    r -= 176;
    if (r < 176) {
      const int kt = r / 11, g = r % 11;
      transpose_tile(p.w_up + (size_t)l * 1024 * DFF, DFF, DFF, kt * 64, g * 256, p.wgu_t + (size_t)l * NGU * 1024, 1024, 3, 0, tile, 4);
      return;
    }
    r -= 176;
    if (r < 176) {
      const int kt = r / 4, g = r % 4;
      transpose_tile(p.w_down + (size_t)l * DFF * 1024, 1024, 1024, kt * 64, g * 256, p.wdn_t + (size_t)l * 1024 * DFF, DFF, 0, 0, tile, 4);
      return;
    }
    r -= 176;
    if (r < 48) {
      const int bh = r >> 2, kt = r & 3, b = bh / 6, hh = bh % 6;
      transpose_tile(p.cache_na_v + ((size_t)((b * 2 + l) * 6 + hh) * 256) * 64, 64, 64, kt * 64, 0,
                     p.vna_l + (size_t)l * (2 * 6 * 64 * NKL) + (size_t)bh * (64 * NKL), 0, 0, 1, tile, 1);
      return;
    }
    r -= 48;
    if (r < 32) {
      const int bh = r >> 2, kt = r & 3, b = bh / 4, hh = bh % 4;
      transpose_tile(p.cache_df_v + ((size_t)((b * 2 + l) * 4 + hh) * 256) * 64, 64, 64, kt * 64, 0,
                     p.vdf_l + (size_t)l * (2 * 4 * 64 * NKL) + (size_t)bh * (64 * NKL), 0, 0, 1, tile, 1);
      return;
    }
    r -= 32;
    {
      const float* src;
      u16* dst;
      if (r < 12) {
        const int b = r / 6, hh = r % 6;
        src = p.cache_na_k + ((size_t)((b * 2 + l) * 6 + hh) * 256) * 64;
        dst = p.kna_l + (size_t)l * (2 * 6 * NKL * 64) + (size_t)(b * 6 + hh) * (NKL * 64);
      } else {
        const int q = r - 12, b = q / 4, hh = q % 4;
        src = p.cache_df_k + ((size_t)((b * 2 + l) * 4 + hh) * 256) * 64;
        dst = p.kdf_l + (size_t)l * (2 * 4 * NKL * 64) + (size_t)(b * 4 + hh) * (NKL * 64);
      }
      float4 v[8];
#pragma unroll
      for (int i = 0; i < 8; ++i) v[i] = *(const float4*)(src + (tid + 512 * i) * 4);
#pragma unroll
      for (int i = 0; i < 8; ++i) {
        const int e = (tid + 512 * i) * 4;
        const int key = e >> 6, d4 = e & 63;
        st_bf4(dst + kf_off(key, d4 & ~7, 4) + (d4 & 7), v[i].x, v[i].y, v[i].z, v[i].w);
      }
    }
}

constexpr int P0_W_ITEMS = 160 + 12 + 6 + 64 + 176 + 176 + 176;
DI void phase_prep(const Params& p, char* lds) {
  const int tid = TIDX;
  if (BIDX == 0 && tid == 0) {
    for (int l = 0; l < 2; ++l) {
      float s1 = 0.f, s2 = 0.f;
      for (int i = 0; i < 32; ++i) {
        s1 += p.df_lq1[l * 32 + i] * p.df_lk1[l * 32 + i];
        s2 += p.df_lq2[l * 32 + i] * p.df_lk2[l * 32 + i];
      }
      p.lam[l] = expf(s1) - expf(s2) + lam_init_of(l);
    }
  }
  constexpr int NREST0 = P0_PER_LAYER - P0_MOD_PER_LAYER;
  constexpr int NREST1 = P0_PER_LAYER - P0_MOD_PER_LAYER - P0_W_ITEMS;
  for (int item = BIDX; item < 2 * P0_MOD_PER_LAYER + NREST0 + NREST1; item += gridDim.x) {
    int l, r;
    if (item < 2 * P0_MOD_PER_LAYER) { l = item / P0_MOD_PER_LAYER; r = item % P0_MOD_PER_LAYER; }
    else if (item < 2 * P0_MOD_PER_LAYER + NREST0) { l = 0; r = P0_MOD_PER_LAYER + (item - 2 * P0_MOD_PER_LAYER); }
    else { l = 1; r = P0_MOD_PER_LAYER + P0_W_ITEMS + (item - 2 * P0_MOD_PER_LAYER - NREST0); }
    prep_item(p, l, r, lds);
  }
}

DI void prep_deferred(const Params& p, char* lds, int cap) {
  const int tid = TIDX;
  volatile LAS unsigned* slot = (volatile LAS unsigned*)((LAS unsigned char*)lds + 131072 + 8);
  for (int n = 0; n < cap; ++n) {
    __syncthreads();
    if (tid == 0) *slot = atomicAdd(&p.counters[8], 1u);
    __syncthreads();
    const unsigned it = __builtin_amdgcn_readfirstlane(*slot);
    if (it >= (unsigned)P0_W_ITEMS) break;
    prep_item(p, 1, P0_MOD_PER_LAYER + (int)it, lds);
  }
}

DI void phase_norm(const Params& p, int l, int which  ) {
  const int lane = TIDX & 63, wid = TIDX >> 6;
  const float* g = (which == 0 ? p.g_mix : p.g_ffn) + l * D;
  const int nw = gridDim.x * 8;
  for (int t = BIDX * 8 + wid; t < T; t += 2 * nw) {
    const int t1 = t + nw;
    const bool has1 = t1 < T;
    const int tb = has1 ? t1 : t;
    const ResSrc xr0 = (which == 0) ? xrow_in(p, l, t) : xa_row(p, t);
    const ResSrc xr1 = (which == 0) ? xrow_in(p, l, tb) : xa_row(p, tb);
    const float* sh0 = p.mod + (size_t)((l * 3 + cond_of(t)) * 6 + (which == 0 ? 0 : 3)) * D;
    const float* sh1 = p.mod + (size_t)((l * 3 + cond_of(tb)) * 6 + (which == 0 ? 0 : 3)) * D;
    float4 v0[4], v1[4], gg[4], sa0[4], sb0[4], sa1[4], sb1[4];
#pragma unroll
    for (int i = 0; i < 4; ++i) {
      const int c = i * 256 + lane * 4;
      { const f32x4 a = res_ld4(xr0, c), b2 = res_ld4(xr1, c); v0[i] = make_float4(a[0], a[1], a[2], a[3]); v1[i] = make_float4(b2[0], b2[1], b2[2], b2[3]); }
      gg[i] = *(const float4*)(g + c);
      sb0[i] = *(const float4*)(sh0 + c); sa0[i] = *(const float4*)(sh0 + D + c);
      sb1[i] = *(const float4*)(sh1 + c); sa1[i] = *(const float4*)(sh1 + D + c);
    }
    float ss0 = 0.f, ss1 = 0.f;
#pragma unroll
    for (int i = 0; i < 4; ++i) {
      ss0 += v0[i].x * v0[i].x + v0[i].y * v0[i].y + v0[i].z * v0[i].z + v0[i].w * v0[i].w;
      ss1 += v1[i].x * v1[i].x + v1[i].y * v1[i].y + v1[i].z * v1[i].z + v1[i].w * v1[i].w;
    }
#pragma unroll
    for (int m = 1; m < 64; m <<= 1) { ss0 += __shfl_xor(ss0, m); ss1 += __shfl_xor(ss1, m); }
    const float r0 = rsqrtf(ss0 * (1.f / D) + EPS), r1 = rsqrtf(ss1 * (1.f / D) + EPS);
#pragma unroll
    for (int i = 0; i < 4; ++i) {
      const int c = i * 256 + lane * 4;
      st_bf4(p.h + (size_t)t * D + c, v0[i].x * r0 * gg[i].x * (1.f + sa0[i].x) + sb0[i].x, v0[i].y * r0 * gg[i].y * (1.f + sa0[i].y) + sb0[i].y,
             v0[i].z * r0 * gg[i].z * (1.f + sa0[i].z) + sb0[i].z, v0[i].w * r0 * gg[i].w * (1.f + sa0[i].w) + sb0[i].w);
    }
    if (has1) {
#pragma unroll
      for (int i = 0; i < 4; ++i) {
        const int c = i * 256 + lane * 4;
        st_bf4(p.h + (size_t)t1 * D + c, v1[i].x * r1 * gg[i].x * (1.f + sa1[i].x) + sb1[i].x, v1[i].y * r1 * gg[i].y * (1.f + sa1[i].y) + sb1[i].y,
               v1[i].z * r1 * gg[i].z * (1.f + sa1[i].z) + sb1[i].z, v1[i].w * r1 * gg[i].w * (1.f + sa1[i].w) + sb1[i].w);
      }
    }
  }
}

namespace pg8 {
typedef unsigned short bf16_t;
constexpr int BM = 256, BK = 64, HALF = 128, HTB = HALF * BK * 2, STAGE_BYTES = 8 * HTB, NXCD = 8, WGM = 8;
DI int lds_byte(int r, int c) { const int st = (r >> 4) * 2 + (c >> 5), rr = r & 15, cc = c & 31, ob = rr * 64 + cc * 2; return st * 1024 + (ob ^ (((ob >> 9) & 1) << 5)); }
DI void stage_rc(int b, int& R, int& C) { const int st = b / 1024, sb = b % 1024, swz = sb ^ (((sb >> 9) & 1) << 5); R = (st >> 1) * 16 + swz / 64; C = (st & 1) * 32 + (swz % 64) / 2; }
struct Unit { int pm, pn; };
struct StaticOrder {
  int nM, nN, nwg, G, c;
  DI void init(int M, int N, int G_, int c_) { nM = M / BM; nN = N / BM; nwg = nM * nN; G = G_; c = c_; }
  DI bool next(int i, Unit& u) const {
    const long L = (long)i * G + c; if (L >= nwg) return false;
    int wgid = (int)L; { const int q = nwg / NXCD, r = nwg % NXCD, xcd = wgid % NXCD, off = wgid / NXCD; wgid = (xcd < r ? xcd * (q + 1) : r * (q + 1) + (xcd - r) * q) + off; }
    const int nig = WGM * nN, gid = wgid / nig, fm = gid * WGM, gsz = (nM - fm) < WGM ? (nM - fm) : WGM;
    u.pm = fm + ((wgid % nig) % gsz); u.pn = (wgid % nig) / gsz; return true;
  }
};

template <class Epi>
DI void gemm_phase(LAS unsigned char* lds, const bf16_t* gA, const bf16_t* gBt, int M, int N, int K, const Epi& E) {
  const int tid = TIDX, wid = __builtin_amdgcn_readfirstlane(tid >> 6), lane = tid & 63, wr = wid >> 2, wc = wid & 3, fr = lane & 15, fq = lane >> 4;
  const int nt = K / BK;
  StaticOrder S; S.init(M, N, (int)gridDim.x, BIDX);
  unsigned voffA[2];
#pragma unroll
  for (int i = 0; i < 2; ++i) { int R, C; stage_rc(tid * 16 + i * 8192, R, C); voffA[i] = (unsigned)(R * K + C) * 2u; }
  const size_t kstep = (size_t)(BK * 2);
  const size_t hstep = (size_t)HALF * K * 2;
  const size_t tstep = 2 * hstep;
  const unsigned ldsw = (unsigned)wid * 1024u;
  const int aoff = lds_byte(wr * 64 + fr, fq * 8), boff = lds_byte(wc * 32 + fr, fq * 8);
#define PG8_SA(b, h) (((b) * 2 + (h)) * HTB)
#define PG8_SB(b, h) ((4 + (b) * 2 + (h)) * HTB)
#define PG8_STAGE(bufoff, gbase) do { _Pragma("unroll") for (int _i = 0; _i < 2; ++_i) \
    __builtin_amdgcn_global_load_lds((const unsigned*)((const char*)(gbase) + voffA[_i]), (LAS unsigned*)(lds + (bufoff) + ldsw + _i * 8192), 16, 0, 0); } while (0)
#define PG8_LDA(dst, b, h) do { _Pragma("unroll") for (int m = 0; m < 4; ++m) _Pragma("unroll") for (int k = 0; k < 2; ++k) dst[m][k] = *(const LAS bf16x8*)(lds + PG8_SA(b, h) + aoff + m * 2048 + k * 1024); } while (0)
#define PG8_LDB(dst, b, h) do { _Pragma("unroll") for (int n = 0; n < 2; ++n) _Pragma("unroll") for (int k = 0; k < 2; ++k) dst[n][k] = *(const LAS bf16x8*)(lds + PG8_SB(b, h) + boff + n * 2048 + k * 1024); } while (0)
#define PG8_MMA(ai, bj, At, Bt) do { __builtin_amdgcn_s_setprio(1); _Pragma("unroll") for (int m = 0; m < 4; ++m) _Pragma("unroll") for (int n = 0; n < 2; ++n) _Pragma("unroll") for (int k = 0; k < 2; ++k) \
    acc[ai][bj][m][n] = __builtin_amdgcn_mfma_f32_16x16x32_bf16(Bt[n][k], At[m][k], acc[ai][bj][m][n], 0, 0, 0); __builtin_amdgcn_s_setprio(0); } while (0)
#define PG8_WAIT_V(n) asm volatile("s_waitcnt vmcnt(" #n ")" ::: "memory")
#define PG8_WAIT_L(n) asm volatile("s_waitcnt lgkmcnt(" #n ")" ::: "memory")
#define PG8_BAR __builtin_amdgcn_s_barrier()
#define PG8_SCHED __builtin_amdgcn_sched_barrier(0)
  Unit cur, nxt; int ui = 0;
  if (!S.next(0, cur)) return;
  f32x4 acc[2][2][4][2];
#pragma unroll
  for (int a = 0; a < 2; ++a)
#pragma unroll
    for (int b = 0; b < 2; ++b)
#pragma unroll
      for (int m = 0; m < 4; ++m)
#pragma unroll
        for (int n = 0; n < 2; ++n) acc[a][b][m][n] = (f32x4){0.f, 0.f, 0.f, 0.f};
  bf16x8 At[4][2], B0[2][2], B1[2][2];
  const char* cA = (const char*)gA + (size_t)cur.pm * tstep; const char* cB = (const char*)gBt + (size_t)cur.pn * tstep;
  PG8_STAGE(PG8_SB(0, 0), cB); PG8_STAGE(PG8_SA(0, 0), cA); PG8_STAGE(PG8_SB(0, 1), cB + hstep); PG8_STAGE(PG8_SA(0, 1), cA + hstep);
  if (wr == 1) PG8_BAR;
  PG8_WAIT_V(4); PG8_BAR;
  PG8_STAGE(PG8_SB(1, 0), cB + kstep); PG8_STAGE(PG8_SA(1, 0), cA + kstep); PG8_STAGE(PG8_SB(1, 1), cB + hstep + kstep);
  PG8_WAIT_V(6); PG8_BAR;
  for (;;) {
    const bool has_next = S.next(ui + 1, nxt);
    const char* nA = has_next ? (const char*)gA + (size_t)nxt.pm * tstep : cA; const char* nB = has_next ? (const char*)gBt + (size_t)nxt.pn * tstep : cB;
    for (int t = 0; t < nt; t += 2) {
      const bool last = (t == nt - 2);
      const char* a1 = cA + (size_t)(t + 1) * kstep;
      const char* a2 = last ? nA : cA + (size_t)(t + 2) * kstep; const char* b2 = last ? nB : cB + (size_t)(t + 2) * kstep;
      const char* a3 = a2 + kstep; const char* b3 = b2 + kstep;
      PG8_LDB(B0, 0, 0); PG8_SCHED; PG8_LDA(At, 0, 0); PG8_STAGE(PG8_SA(1, 1), a1 + hstep);
      PG8_WAIT_L(8); PG8_BAR; PG8_WAIT_L(0); PG8_MMA(0, 0, At, B0); PG8_BAR; PG8_SCHED;
      PG8_LDB(B1, 0, 1); PG8_STAGE(PG8_SB(0, 0), b2);
      PG8_BAR; PG8_WAIT_L(0); PG8_MMA(0, 1, At, B1); PG8_BAR;
      PG8_LDA(At, 0, 1); PG8_STAGE(PG8_SA(0, 0), a2);
      PG8_BAR; PG8_WAIT_L(0); PG8_MMA(1, 0, At, B0); PG8_BAR; PG8_SCHED;
      PG8_STAGE(PG8_SB(0, 1), b2 + hstep);
      PG8_WAIT_V(6); PG8_BAR; PG8_MMA(1, 1, At, B1); PG8_BAR;
      PG8_LDB(B0, 1, 0); PG8_SCHED; PG8_LDA(At, 1, 0); PG8_STAGE(PG8_SA(0, 1), a2 + hstep);
      PG8_WAIT_L(8); PG8_BAR; PG8_WAIT_L(0); PG8_MMA(0, 0, At, B0); PG8_BAR; PG8_SCHED;
      PG8_LDB(B1, 1, 1); PG8_STAGE(PG8_SB(1, 0), b3);
      PG8_BAR; PG8_WAIT_L(0); PG8_MMA(0, 1, At, B1); PG8_BAR;
      PG8_LDA(At, 1, 1); PG8_STAGE(PG8_SA(1, 0), a3);
      PG8_BAR; PG8_WAIT_L(0); PG8_MMA(1, 0, At, B0); PG8_BAR; PG8_SCHED;
      PG8_STAGE(PG8_SB(1, 1), b3 + hstep);
      PG8_WAIT_V(6); PG8_BAR; PG8_MMA(1, 1, At, B1); PG8_BAR;
    }
    {
      int fr2 = fr, fq2 = fq; Unit cu = cur;
      asm volatile("" : "+v"(fr2), "+v"(fq2), "+s"(cu.pm), "+s"(cu.pn));
      E(acc, cu, wr, wc, fr2, fq2);
    }
    if (!has_next) break;
#pragma unroll
    for (int a = 0; a < 2; ++a)
#pragma unroll
      for (int b = 0; b < 2; ++b)
#pragma unroll
        for (int m = 0; m < 4; ++m)
#pragma unroll
          for (int n = 0; n < 2; ++n) acc[a][b][m][n] = (f32x4){0.f, 0.f, 0.f, 0.f};
    cur = nxt; cA = nA; cB = nB; ++ui;
  }
  PG8_WAIT_V(0);
  if (wr == 0) PG8_BAR;
  PG8_BAR;
#undef PG8_SA
#undef PG8_SB
#undef PG8_STAGE
#undef PG8_LDA
#undef PG8_LDB
#undef PG8_MMA
#undef PG8_WAIT_V
#undef PG8_WAIT_L
#undef PG8_BAR
#undef PG8_SCHED
}
}

typedef f32x4 AccT[2][2][4][2];
DI void st_nt4(float* p_, f32x4 v_) { __builtin_nontemporal_store(v_, (f32x4*)p_); }
DI float dot4(f32x4 a) { return a[0] * a[0] + a[1] * a[1] + a[2] * a[2] + a[3] * a[3]; }
DI float rowsum_q(float v) { v += __shfl_xor(v, 16); v += __shfl_xor(v, 32); return v; }
DI void st_bf8(u16* p, f32x4 a, f32x4 b) {
  u32x4 w; w.x = cvtpk(a[0], a[1]); w.y = cvtpk(a[2], a[3]); w.z = cvtpk(b[0], b[1]); w.w = cvtpk(b[2], b[3]);
  *(u32x4*)p = w;
}

struct EpiIn {
  const Params& p; int l;
  DI void operator()(const AccT& acc, const pg8::Unit& u, int wr, int wc, int fr, int fq) const {
    const int wcb = u.pn * 4 + wc;
    if (wcb > 36) return;
    const bool is_ctx = u.pm < 32;
    const int r0 = u.pm * 256 + wr * 64 + fr;
    int b, s0;
    if (is_ctx) { b = u.pm; s0 = wr * 64 + fr; }
    else { const int tl = r0 - TCTX; b = tl >> 10; s0 = tl & 1023; }
    const int c8 = 8 * fq;
    if (wcb < 4) {
#pragma unroll
      for (int ai = 0; ai < 2; ++ai)
#pragma unroll
        for (int m = 0; m < 4; ++m) {
          asm volatile("" ::: "memory");
          float* rp = p.cq + (size_t)(r0 + ai * 128 + m * 16) * 256 + wcb * 64 + c8;
#pragma unroll
          for (int bj = 0; bj < 2; ++bj)
#pragma unroll
            for (int n = 0; n < 2; ++n) *(f32x4*)(rp + bj * 32 + 4 * n) = acc[ai][bj][m][n];
        }
    } else if (wcb < 6) {
#pragma unroll
      for (int ai = 0; ai < 2; ++ai)
#pragma unroll
        for (int m = 0; m < 4; ++m) {
          asm volatile("" ::: "memory");
          float* rp = p.ckv + (size_t)(r0 + ai * 128 + m * 16) * 128 + (wcb - 4) * 64 + c8;
#pragma unroll
          for (int bj = 0; bj < 2; ++bj)
#pragma unroll
            for (int n = 0; n < 2; ++n) *(f32x4*)(rp + bj * 32 + 4 * n) = acc[ai][bj][m][n];
        }
    } else if (wcb < 18) {
      const bool isq = wcb < 12;
      const int hd = isq ? wcb - 6 : wcb - 12;
      const float* g = (isq ? p.g_na_q : p.g_na_k) + l * 64 + c8;
      f32x4 gv[2][2];
#pragma unroll
      for (int bj = 0; bj < 2; ++bj)
#pragma unroll
        for (int n = 0; n < 2; ++n) gv[bj][n] = *(const f32x4*)(g + bj * 32 + 4 * n);
#pragma unroll
      for (int ai = 0; ai < 2; ++ai)
#pragma unroll
        for (int m = 0; m < 4; ++m) {
          asm volatile("" ::: "memory");
          float ss = dot4(acc[ai][0][m][0]) + dot4(acc[ai][0][m][1]) + dot4(acc[ai][1][m][0]) + dot4(acc[ai][1][m][1]);
          ss = rowsum_q(ss);
          const float rstd = rsqrtf(ss * (1.f / 64.f) + EPS) * (isq ? 0.18033688011112042f : 1.f);
          const int t = r0 + ai * 128 + m * 16, s = s0 + ai * 128 + m * 16;
          f32x4 v[2][2];
#pragma unroll
          for (int bj = 0; bj < 2; ++bj)
#pragma unroll
            for (int n = 0; n < 2; ++n) v[bj][n] = acc[ai][bj][m][n] * rstd * gv[bj][n];
          if (isq) {
            u16* qp = p.qna + (size_t)t * 384 + hd * 64 + c8;
            st_bf8(qp, v[0][0], v[0][1]); st_bf8(qp + 32, v[1][0], v[1][1]);
          } else if (is_ctx) {
            float* op = p.out + OUT_NAK + ((size_t)((b * 2 + l) * 6 + hd) * 256 + s) * 64 + c8;
            st_nt4(op, v[0][0]); st_nt4(op + 4, v[0][1]); st_nt4(op + 32, v[1][0]); st_nt4(op + 36, v[1][1]);
            u16* kp = p.kna_c + (size_t)(b * 6 + hd) * (256 * 64);
            st_bf8(kp + kf_off(s, c8, 4), v[0][0], v[0][1]); st_bf8(kp + kf_off(s, 32 + c8, 4), v[1][0], v[1][1]);
          } else {
            u16* kp = p.kna_l + (size_t)l * (2 * 6 * NKL * 64) + (size_t)(b * 6 + hd) * (NKL * 64);
            st_bf8(kp + kf_off(256 + s, c8, 4), v[0][0], v[0][1]); st_bf8(kp + kf_off(256 + s, 32 + c8, 4), v[1][0], v[1][1]);
          }
        }
    } else if (wcb < 24 || (wcb >= 32 && wcb < 36)) {
      const bool isna = wcb < 24;
      const int hd = isna ? wcb - 18 : wcb - 32;
      const int nh = isna ? 6 : 4;
      const int vh = isna ? hd : 6 + hd;
      float* ob = p.out + (isna ? OUT_NAV : OUT_DFV) + ((size_t)((b * 2 + l) * nh + hd) * 256) * 64 + c8;
      u16* vb = is_ctx ? (isna ? p.vna_c : p.vdf_c) + (size_t)(b * nh + hd) * (64 * 256)
                       : (isna ? p.vna_l : p.vdf_l) + (size_t)l * (2 * nh * 64 * NKL) + (size_t)(b * nh + hd) * (64 * NKL);
      (void)vh;
#pragma unroll
      for (int ai = 0; ai < 2; ++ai)
#pragma unroll
        for (int m = 0; m < 4; ++m) {
          asm volatile("" ::: "memory");
          const int s = s0 + ai * 128 + m * 16;
          u16* vk = vb + vf_off((is_ctx ? 0 : 256) + s, c8);
#pragma unroll
          for (int bj = 0; bj < 2; ++bj)
#pragma unroll
            for (int n = 0; n < 2; ++n) {
              const unsigned lo = cvtpk(acc[ai][bj][m][n][0], acc[ai][bj][m][n][1]), hi = cvtpk(acc[ai][bj][m][n][2], acc[ai][bj][m][n][3]);
              u16* q = vk + bj * 512 + n * 32;
              q[0] = (u16)(lo & 0xffffu); q[8] = (u16)(lo >> 16); q[16] = (u16)(hi & 0xffffu); q[24] = (u16)(hi >> 16);
            }
          if (is_ctx) {
            float* op = ob + (size_t)s * 64;
            st_nt4(op, acc[ai][0][m][0]); st_nt4(op + 4, acc[ai][0][m][1]); st_nt4(op + 32, acc[ai][1][m][0]); st_nt4(op + 36, acc[ai][1][m][1]);
          }
        }
    } else if (wcb < 32) {
      const bool isq = wcb < 28;
      const int hd = isq ? wcb - 24 : wcb - 28;
      const float* g = (isq ? p.g_df_q : p.g_df_k) + l * 32 + c8;
      const f32x4 g0 = *(const f32x4*)(g), g1 = *(const f32x4*)(g + 4);
      const int ra = fq >> 1, half = fq & 1;
#pragma unroll
      for (int ai = 0; ai < 2; ++ai)
#pragma unroll
        for (int m = 0; m < 4; ++m) {
          asm volatile("" ::: "memory");
          const int t = r0 + ai * 128 + m * 16, s = s0 + ai * 128 + m * 16;
          f32x4 v[2][2];
#pragma unroll
          for (int bj = 0; bj < 2; ++bj) {
            float ss = dot4(acc[ai][bj][m][0]) + dot4(acc[ai][bj][m][1]);
            ss = rowsum_q(ss);
            const float rstd = rsqrtf(ss * (1.f / 32.f) + EPS) * (isq ? 0.25503486164919736f : 1.f);
            v[bj][0] = acc[ai][bj][m][0] * rstd * g0;
            v[bj][1] = acc[ai][bj][m][1] * rstd * g1;
          }
          if (!is_ctx) {
            const float pos = ra ? (float)(s & 63) : (float)(s >> 6);
#pragma unroll
            for (int bj = 0; bj < 2; ++bj)
#pragma unroll
              for (int n = 0; n < 2; ++n)
#pragma unroll
                for (int e = 0; e < 4; ++e) {
                  const int i = 4 * n + e;
                  const float inv = (i == 0) ? 1.0f : (i == 1) ? 0.31622776601683794f : (i == 2) ? 0.1f : (i == 3) ? 0.031622776601683794f
                                  : (i == 4) ? 0.01f : (i == 5) ? 0.0031622776601683794f : (i == 6) ? 0.001f : 0.00031622776601683794f;
                  const float ang = pos * inv;
                  const float cs = __cosf(ang), sn = __sinf(ang);
                  const float x = v[bj][n][e];
                  const float partner = __shfl_xor(x, 16);
                  v[bj][n][e] = x * cs + (half ? partner : -partner) * sn;
                }
          }
          if (isq) {
            u16* qp = p.qdf + (size_t)t * 256 + hd * 64 + c8;
            st_bf8(qp, v[0][0], v[0][1]); st_bf8(qp + 32, v[1][0], v[1][1]);
          } else if (is_ctx) {
            float* op = p.out + OUT_DFK + ((size_t)((b * 2 + l) * 4 + hd) * 256 + s) * 64 + c8;
            st_nt4(op, v[0][0]); st_nt4(op + 4, v[0][1]); st_nt4(op + 32, v[1][0]); st_nt4(op + 36, v[1][1]);
            u16* kp = p.kdf_c + (size_t)(b * 4 + hd) * (256 * 64);
            st_bf8(kp + kf_off(s, c8, 4), v[0][0], v[0][1]); st_bf8(kp + kf_off(s, 32 + c8, 4), v[1][0], v[1][1]);
          } else {
            u16* kp = p.kdf_l + (size_t)l * (2 * 4 * NKL * 64) + (size_t)(b * 4 + hd) * (NKL * 64);
            st_bf8(kp + kf_off(256 + s, c8, 4), v[0][0], v[0][1]); st_bf8(kp + kf_off(256 + s, 32 + c8, 4), v[1][0], v[1][1]);
          }
        }
    } else {
#pragma unroll
      for (int ai = 0; ai < 2; ++ai)
#pragma unroll
        for (int m = 0; m < 4; ++m) {
          asm volatile("" ::: "memory");
          const int t = r0 + ai * 128 + m * 16, s = s0 + ai * 128 + m * 16;
          float* kp = p.krope + (size_t)t * 32 + c8;
          *(f32x4*)(kp) = acc[ai][0][m][0]; *(f32x4*)(kp + 4) = acc[ai][0][m][1];
          if (is_ctx) {
            float* op = p.out + OUT_KROPE + ((size_t)(b * 2 + l) * 256 + s) * 32 + c8;
            st_nt4(op, acc[ai][0][m][0]); st_nt4(op + 4, acc[ai][0][m][1]);
          }
        }
    }
  }
};

template <int WHICH  >
struct EpiRes {
  const Params& p; int l;
  DI void operator()(const AccT& acc, const pg8::Unit& u, int wr, int wc, int fr, int fq) const {
    const int cond = u.pm < 32 ? 0 : 1 + ((u.pm - 32) >> 2);
    const int c0 = u.pn * 256 + wc * 64 + 8 * fq;
    const float* gate = p.mod + (size_t)((l * 3 + cond) * 6 + (WHICH == 0 ? 2 : 5)) * D + c0;
    f32x4 gv[2][2];
#pragma unroll
    for (int bj = 0; bj < 2; ++bj)
#pragma unroll
      for (int n = 0; n < 2; ++n) gv[bj][n] = *(const f32x4*)(gate + bj * 32 + 4 * n);
    u16* dsth = (WHICH == 0) ? p.xa : p.xb;
    const bool to_out = (WHICH == 1 && l == 1);
#pragma unroll
    for (int ai = 0; ai < 2; ++ai)
#pragma unroll
      for (int mh = 0; mh < 2; ++mh) {
        f32x4 xi[2][2][2];
#pragma unroll
        for (int mm = 0; mm < 2; ++mm) {
          const int m = mh * 2 + mm;
          const int t = u.pm * 256 + ai * 128 + wr * 64 + m * 16 + fr;
          const ResSrc xin = (WHICH == 0) ? xrow_in(p, l, t) : xa_row(p, t);
#pragma unroll
          for (int bj = 0; bj < 2; ++bj)
#pragma unroll
            for (int n = 0; n < 2; ++n) xi[mm][bj][n] = res_ld4(xin, c0 + bj * 32 + 4 * n);
        }
#pragma unroll
        for (int mm = 0; mm < 2; ++mm) {
          const int m = mh * 2 + mm;
          const int t = u.pm * 256 + ai * 128 + wr * 64 + m * 16 + fr;
          if (to_out) {
            float* xo = p.out + (size_t)t * D + c0;
#pragma unroll
            for (int bj = 0; bj < 2; ++bj)
#pragma unroll
              for (int n = 0; n < 2; ++n) st_nt4(xo + bj * 32 + 4 * n, xi[mm][bj][n] + gv[bj][n] * acc[ai][bj][m][n]);
          } else {
            u16* xo = dsth + (size_t)t * D + c0;
#pragma unroll
            for (int bj = 0; bj < 2; ++bj)
              st_bf8(xo + bj * 32, xi[mm][bj][0] + gv[bj][0] * acc[ai][bj][m][0], xi[mm][bj][1] + gv[bj][1] * acc[ai][bj][m][1]);
          }
        }
      }
  }
};

struct EpiGU {
  const Params& p;
  DI void operator()(const AccT& acc, const pg8::Unit& u, int wr, int wc, int fr, int fq) const {
    const int f0 = u.pn * 128 + wc * 32 + 8 * fq;
#pragma unroll
    for (int ai = 0; ai < 2; ++ai)
#pragma unroll
      for (int m = 0; m < 4; ++m) {
        const int t = u.pm * 256 + ai * 128 + wr * 64 + m * 16 + fr;
        f32x4 o[2];
#pragma unroll
        for (int n = 0; n < 2; ++n)
#pragma unroll
          for (int e = 0; e < 4; ++e) {
            const float gvv = acc[ai][0][m][n][e], uv = acc[ai][1][m][n][e];
            o[n][e] = gvv / (1.f + __expf(-gvv)) * uv;
          }
        st_bf8(p.act + (size_t)t * DFF + f0, o[0], o[1]);
      }
  }
};

DI void mla_q_load(const Params& p, int l, int tb, bf16x8 (&bfr)[16], float& rstd) {
  const int lane = TIDX & 63, l31 = lane & 31, hh = lane >> 5;
  const int tok = tb * 32 + l31;
  const float* cqrow = p.cq + (size_t)tok * 256;
  const float* gq = p.g_qa + l * 256;
  float ss = 0.f;
#pragma unroll
  for (int ks = 0; ks < 16; ++ks) {
    const int k = ks * 16 + 8 * hh;
    const float4 a = *(const float4*)(cqrow + k), b2 = *(const float4*)(cqrow + k + 4);
    const float4 ga = *(const float4*)(gq + k), gb = *(const float4*)(gq + k + 4);
    ss += a.x * a.x + a.y * a.y + a.z * a.z + a.w * a.w + b2.x * b2.x + b2.y * b2.y + b2.z * b2.z + b2.w * b2.w;
    bfr[ks] = pack8(a.x * ga.x, a.y * ga.y, a.z * ga.z, a.w * ga.w, b2.x * gb.x, b2.y * gb.y, b2.z * gb.z, b2.w * gb.w);
  }
  ss += __shfl_xor(ss, 32);
  rstd = rsqrtf(ss * (1.f / 256.f) + EPS);
}

DI void mla_q_compute(const Params& p, int l, int tb, int h, const LAS unsigned char* wl, const bf16x8 (&bfr)[16], float rstd) {
  const int lane = TIDX & 63, l31 = lane & 31, hh = lane >> 5;
  const int tok = tb * 32 + l31;
  float4 gq2[3][4];
#pragma unroll
  for (int nt = 0; nt < 3; ++nt)
#pragma unroll
    for (int gi = 0; gi < 4; ++gi) gq2[nt][gi] = *(const float4*)(p.g_mla_q + l * 96 + nt * 32 + 8 * gi + 4 * hh);
  f32x16 acc[3];
  const LAS unsigned char* W = wl + lane * 16;
#pragma unroll
  for (int nt = 0; nt < 3; ++nt) {
#pragma unroll
    for (int r = 0; r < 16; ++r) acc[nt][r] = 0.f;
#pragma unroll
    for (int ks = 0; ks < 16; ++ks) {
      const bf16x8 wf = *(const LAS bf16x8*)(W + (nt * 16 + ks) * 1024);
      acc[nt] = mfma32(wf, bfr[ks], acc[nt]);
    }
  }
  float s2 = 0.f;
#pragma unroll
  for (int nt = 0; nt < 3; ++nt)
#pragma unroll
    for (int r = 0; r < 16; ++r) { acc[nt][r] *= rstd; s2 += acc[nt][r] * acc[nt][r]; }
  s2 += __shfl_xor(s2, 32);
  const float rstd2 = rsqrtf(s2 * (1.f / 96.f) + EPS) * 0.14724444602590306f;
#pragma unroll
  for (int nt = 0; nt < 3; ++nt)
#pragma unroll
    for (int gi = 0; gi < 4; ++gi) {
      const float4 gg = gq2[nt][gi];
      acc[nt][4 * gi + 0] *= rstd2 * gg.x; acc[nt][4 * gi + 1] *= rstd2 * gg.y;
      acc[nt][4 * gi + 2] *= rstd2 * gg.z; acc[nt][4 * gi + 3] *= rstd2 * gg.w;
    }
  if (tok >= TCTX) rope32(acc[2], (tok - TCTX) & 1023, hh);
  u16* qo = p.qmla + (size_t)tok * 576 + h * 96 + 4 * hh;
#pragma unroll
  for (int nt = 0; nt < 3; ++nt)
#pragma unroll
    for (int gi = 0; gi < 4; ++gi)
      st_bf4(qo + nt * 32 + 8 * gi, acc[nt][4 * gi], acc[nt][4 * gi + 1], acc[nt][4 * gi + 2], acc[nt][4 * gi + 3]);
}

struct KvRow { const float* csrc; const float* krsrc; int b, s; bool is_tok, is_ctx; };
DI KvRow kv_row(const Params& p, int l, int rb) {
  const int lane = TIDX & 63, l31 = lane & 31;
  const int row = rb * 32 + l31;
  KvRow r;
  r.is_tok = row < T;
  r.is_ctx = row < TCTX;
  if (r.is_tok) {
    r.csrc = p.ckv + (size_t)row * 128;
    r.krsrc = p.krope + (size_t)row * 32;
    if (r.is_ctx) { r.b = row >> 8; r.s = row & 255; }
    else { r.b = (row - TCTX) >> 10; r.s = (row - TCTX) & 1023; }
  } else {
    const int rr = row - T;
    r.b = rr >> 8; r.s = rr & 255;
    r.csrc = p.cache_mla_ckv + ((size_t)(r.b * 2 + l) * 256 + r.s) * 128;
    r.krsrc = p.cache_mla_krope + ((size_t)(r.b * 2 + l) * 256 + r.s) * 32;
  }
  return r;
}

DI void mla_kv_load(const Params& p, int l, int rb, bf16x8 (&bfr)[8], float& rstd) {
  const int lane = TIDX & 63, hh = lane >> 5;
  const KvRow R = kv_row(p, l, rb);
  const float* gk = p.g_kva + l * 128;
  float ss = 0.f;
#pragma unroll
  for (int ks = 0; ks < 8; ++ks) {
    const int k = ks * 16 + 8 * hh;
    const float4 a = *(const float4*)(R.csrc + k), b2 = *(const float4*)(R.csrc + k + 4);
    float4 ga = make_float4(1.f, 1.f, 1.f, 1.f), gb = ga;
    if (R.is_tok) { ga = *(const float4*)(gk + k); gb = *(const float4*)(gk + k + 4); }
    ss += a.x * a.x + a.y * a.y + a.z * a.z + a.w * a.w + b2.x * b2.x + b2.y * b2.y + b2.z * b2.z + b2.w * b2.w;
    bfr[ks] = pack8(a.x * ga.x, a.y * ga.y, a.z * ga.z, a.w * ga.w, b2.x * gb.x, b2.y * gb.y, b2.z * gb.z, b2.w * gb.w);
  }
  ss += __shfl_xor(ss, 32);
  rstd = R.is_tok ? rsqrtf(ss * (1.f / 128.f) + EPS) : 1.f;
}

DI void mla_kv_compute(const Params& p, int l, int rb, int h, const LAS unsigned char* wl, const bf16x8 (&bfr)[8], float rstd) {
  const int lane = TIDX & 63, hh = lane >> 5;
  const KvRow R = kv_row(p, l, rb);
  const bool is_tok = R.is_tok, is_ctx = R.is_ctx;
  const int b = R.b, s = R.s;
  const float* gk = p.g_kva + l * 128;
  f32x16 kr;
#pragma unroll
  for (int gi = 0; gi < 4; ++gi) {
    const float4 v = *(const float4*)(R.krsrc + 8 * gi + 4 * hh);
    kr[4 * gi] = v.x; kr[4 * gi + 1] = v.y; kr[4 * gi + 2] = v.z; kr[4 * gi + 3] = v.w;
  }
  const float* g = p.g_mla_k + l * 96;
  float4 gk0[4], gk1[4], gk2[4];
#pragma unroll
  for (int gi = 0; gi < 4; ++gi) {
    gk0[gi] = *(const float4*)(g + 8 * gi + 4 * hh); gk1[gi] = *(const float4*)(g + 32 + 8 * gi + 4 * hh); gk2[gi] = *(const float4*)(g + 64 + 8 * gi + 4 * hh);
  }
  f32x16 acc[4];
  const LAS unsigned char* W = wl + lane * 16;
#pragma unroll
  for (int nt = 0; nt < 4; ++nt) {
#pragma unroll
    for (int r = 0; r < 16; ++r) acc[nt][r] = 0.f;
#pragma unroll
    for (int ks = 0; ks < 8; ++ks) {
      const bf16x8 wf = *(const LAS bf16x8*)(W + (nt * 8 + ks) * 1024);
      acc[nt] = mfma32(wf, bfr[ks], acc[nt]);
    }
  }
  float sk = 0.f;
#pragma unroll
  for (int nt = 0; nt < 4; ++nt)
#pragma unroll
    for (int r = 0; r < 16; ++r) acc[nt][r] *= rstd;
#pragma unroll
  for (int r = 0; r < 16; ++r) sk += acc[0][r] * acc[0][r] + acc[1][r] * acc[1][r] + kr[r] * kr[r];
  sk += __shfl_xor(sk, 32);
  const float rstdk = rsqrtf(sk * (1.f / 96.f) + EPS);
#pragma unroll
  for (int gi = 0; gi < 4; ++gi) {
    const float4 g0 = gk0[gi], g1 = gk1[gi], g2 = gk2[gi];
    acc[0][4 * gi] *= rstdk * g0.x; acc[0][4 * gi + 1] *= rstdk * g0.y; acc[0][4 * gi + 2] *= rstdk * g0.z; acc[0][4 * gi + 3] *= rstdk * g0.w;
    acc[1][4 * gi] *= rstdk * g1.x; acc[1][4 * gi + 1] *= rstdk * g1.y; acc[1][4 * gi + 2] *= rstdk * g1.z; acc[1][4 * gi + 3] *= rstdk * g1.w;
    kr[4 * gi] *= rstdk * g2.x; kr[4 * gi + 1] *= rstdk * g2.y; kr[4 * gi + 2] *= rstdk * g2.z; kr[4 * gi + 3] *= rstdk * g2.w;
  }
  if (is_tok && !is_ctx) rope32(kr, s, hh);
  u16 *kd, *vd;
  int kidx;
  if (is_ctx) {
    kidx = s;
    kd = p.kmla_c + (size_t)(b * 6 + h) * (256 * 96);
    vd = p.vmla_c + (size_t)(b * 6 + h) * (64 * 256);
  } else {
    kidx = is_tok ? 256 + s : s;
    kd = p.kmla_l + (size_t)l * (2 * 6 * NKL * 96) + (size_t)(b * 6 + h) * (NKL * 96);
    vd = p.vmla_l + (size_t)l * (2 * 6 * 64 * NKL) + (size_t)(b * 6 + h) * (64 * NKL);
  }
#pragma unroll
  for (int gi = 0; gi < 4; ++gi) {
    st_bf4(kd + kf_off(kidx, 8 * gi, 6) + 4 * hh, acc[0][4 * gi], acc[0][4 * gi + 1], acc[0][4 * gi + 2], acc[0][4 * gi + 3]);
    st_bf4(kd + kf_off(kidx, 32 + 8 * gi, 6) + 4 * hh, acc[1][4 * gi], acc[1][4 * gi + 1], acc[1][4 * gi + 2], acc[1][4 * gi + 3]);
    st_bf4(kd + kf_off(kidx, 64 + 8 * gi, 6) + 4 * hh, kr[4 * gi], kr[4 * gi + 1], kr[4 * gi + 2], kr[4 * gi + 3]);
  }
#pragma unroll
  for (int nt = 0; nt < 2; ++nt)
#pragma unroll
    for (int r = 0; r < 16; ++r) {
      const int d = nt * 32 + (r & 3) + 8 * (r >> 2) + 4 * hh;
      vd[vf_off(kidx, d)] = f2bf(acc[2 + nt][r]);
    }
  if (is_ctx && h == 0) {
    float* ob = p.out + OUT_CKV + ((size_t)(b * 2 + l) * 256 + s) * 128;
    float4 oa[8], obv[8];
#pragma unroll
    for (int ks = 0; ks < 8; ++ks) {
      const int k = ks * 16 + 8 * hh;
      const float4 a = *(const float4*)(R.csrc + k), b2 = *(const float4*)(R.csrc + k + 4);
      const float4 ga = *(const float4*)(gk + k), gb = *(const float4*)(gk + k + 4);
      oa[ks] = make_float4(a.x * rstd * ga.x, a.y * rstd * ga.y, a.z * rstd * ga.z, a.w * rstd * ga.w);
      obv[ks] = make_float4(b2.x * rstd * gb.x, b2.y * rstd * gb.y, b2.z * rstd * gb.z, b2.w * rstd * gb.w);
    }
#pragma unroll
    for (int ks = 0; ks < 8; ++ks) {
      const int k = ks * 16 + 8 * hh;
      st_nt4(ob + k, (f32x4){oa[ks].x, oa[ks].y, oa[ks].z, oa[ks].w});
      st_nt4(ob + k + 4, (f32x4){obv[ks].x, obv[ks].y, obv[ks].z, obv[ks].w});
    }
  }
}

DI void phase_mla_up(const Params& p, int l, char* lds) {
  const int tid = TIDX, lane = tid & 63, w = __builtin_amdgcn_readfirstlane(tid >> 6);
  LAS unsigned char* ldsl = (LAS unsigned char*)lds;
  const int nslot = ((int)gridDim.x + 7) >> 3;
  for (int it0 = (BIDX & 7) * nslot + (BIDX >> 3); it0 < 252 + 8 * nslot; it0 += 8 * nslot) {
    const int item = it0;
    if (item >= 252 || (BIDX >> 3) >= nslot) break;
    __syncthreads();
    const bool hasq = item < 240;
    const int h = item % 6, grp = item / 6;
    if (hasq) {
      const u16* wsrc = p.wuq_t + (size_t)l * 576 * 256 + (size_t)(h * 3) * (16 * 512) + lane * 8;
#pragma unroll
      for (int i = 0; i < 6; ++i) {
        const int blk = w + 8 * i;
        __builtin_amdgcn_global_load_lds((const unsigned*)(wsrc + blk * 512), (LAS unsigned*)(ldsl + blk * 1024), 16, 0, 0);
      }
    }
    {
      const u16* wsrc = p.wukv_t + (size_t)l * 768 * 128 + (size_t)(h * 4) * (8 * 512) + lane * 8;
#pragma unroll
      for (int i = 0; i < 4; ++i) {
        const int blk = w + 8 * i;
        __builtin_amdgcn_global_load_lds((const unsigned*)(wsrc + blk * 512), (LAS unsigned*)(ldsl + 49152 + blk * 1024), 16, 0, 0);
      }
    }
    bf16x8 bq[16], bk[8];
    float rq = 1.f, rk = 1.f;
    if (hasq) mla_q_load(p, l, grp * 8 + w, bq, rq);
    mla_kv_load(p, l, grp * 8 + w, bk, rk);
    asm volatile("s_waitcnt vmcnt(0)" ::: "memory");
    __syncthreads();
    if (hasq) mla_q_compute(p, l, grp * 8 + w, h, ldsl, bq, rq);
    mla_kv_compute(p, l, grp * 8 + w, h, ldsl + 49152, bk, rk);
  }
}

constexpr int ATT_NST = 8, ATT_STB = 10240, ATT_RPB_OFF = ATT_NST * ATT_STB;
#define ATT_BAR() do { __builtin_amdgcn_s_barrier(); asm volatile("" ::: "memory"); } while (0)

template <int NDK>
DI void att_issue(LAS unsigned char* lds, const u16* Kb, const u16* Vb, int kt, int st, int w, int lane) {
#pragma unroll
  for (int i = 0; i < 2; ++i) {
    const int j = w + 8 * i;
    if (j < NDK + 4) {
      const u16* src = (j < NDK) ? Kb + (size_t)kt * (NDK * 512) + j * 512 : Vb + (size_t)kt * 2048 + (j - NDK) * 512;
      const int dst = st * ATT_STB + ((j < NDK) ? j * 1024 : 6144 + (j - NDK) * 1024);
      __builtin_amdgcn_global_load_lds((const unsigned*)(src + lane * 8), (LAS unsigned*)(lds + dst), 16, 0, 0);
    }
  }
}

template <int DQK, int MODE>
DI void attn_block_single(LAS unsigned char* lds, const u16* __restrict__ Kb, const u16* __restrict__ Vb, const u16* __restrict__ qrow,
                          u16* __restrict__ orow, float scale, int ntiles, int r, int qc, int rs0) {
  const int tid = TIDX, lane = tid & 63, w = __builtin_amdgcn_readfirstlane(tid >> 6), hh = lane >> 5;
  constexpr int NDK = DQK / 16;
  const int nl = (w + 8 < NDK + 4) ? 2 : 1;
#define ATT_KT(t_) ((MODE == 1 && (t_) >= 8) ? 8 + (rs0 + (((t_) - 8) >> 1)) * 2 + (((t_) - 8) & 1) : (t_))
  for (int tt = 0; tt < ATT_NST - 1; ++tt) { const int tc = min(tt, ntiles - 1); att_issue<NDK>(lds, Kb, Vb, ATT_KT(tc), tt, w, lane); }
  bf16x8 qf[NDK];
#pragma unroll
  for (int dk = 0; dk < NDK; ++dk) qf[dk] = *(const bf16x8*)(qrow + dk * 16 + 8 * hh);
#pragma unroll
  for (int dk = 0; dk < NDK; ++dk) asm volatile("" :: "v"(qf[dk]));
  f32x16 o0, o1;
#pragma unroll
  for (int i = 0; i < 16; ++i) { o0[i] = 0.f; o1[i] = 0.f; }
  float mrun = -1e30f, lsum = 0.f;
  int rs = 0, cs = 0;
  if (MODE == 1) { rs = min(max(r - 4, 0), 8); cs = min(max(qc - 8, 0), 48); }
  const LAS float* rpbl = (const LAS float*)(lds + ATT_RPB_OFF);
  for (int t = 0; t < ntiles; ++t) {
    if (nl == 2) asm volatile("s_waitcnt vmcnt(12)" ::: "memory"); else asm volatile("s_waitcnt vmcnt(6)" ::: "memory");
    ATT_BAR();
    { const int tn = min(t + ATT_NST - 1, ntiles - 1); att_issue<NDK>(lds, Kb, Vb, ATT_KT(tn), (t + ATT_NST - 1) & (ATT_NST - 1), w, lane); }
    int jr = 0, ct = 0;
    if (MODE == 1 && t >= 8) {
      jr = rs0 + ((t - 8) >> 1) - rs; ct = (t - 8) & 1;
      if (jr < 0 || jr > 7) continue;
    }
    const LAS unsigned char* sp = lds + (t & (ATT_NST - 1)) * ATT_STB + lane * 16;
    f32x16 s;
#pragma unroll
    for (int i = 0; i < 16; ++i) s[i] = 0.f;
    __builtin_amdgcn_s_setprio(1);
#pragma unroll
    for (int dk = 0; dk < NDK; ++dk) s = mfma32(*(const LAS bf16x8*)(sp + dk * 1024), qf[dk], s);
    __builtin_amdgcn_s_setprio(0);
    const bf16x8 v00 = *(const LAS bf16x8*)(sp + 6144), v01 = *(const LAS bf16x8*)(sp + 6144 + 1024),
                 v10 = *(const LAS bf16x8*)(sp + 6144 + 2048), v11 = *(const LAS bf16x8*)(sp + 6144 + 3072);
    float tmax = -1e30f;
    if (MODE == 1 && t >= 8) {
      const LAS float* rp = rpbl + (rs + jr - r + 7) * 31;
#pragma unroll
      for (int reg = 0; reg < 16; ++reg) {
        const int kc = ct * 32 + (reg & 3) + 8 * (reg >> 2) + 4 * hh;
        const int rc = min(max(kc - qc, -15), 15) + 15;
        const float bias = rp[rc];
        const float v = (kc >= cs && kc < cs + 16) ? s[reg] + bias : -1e30f;
        s[reg] = v;
        tmax = fmaxf(tmax, v);
      }
    } else {
#pragma unroll
      for (int reg = 0; reg < 16; ++reg) tmax = fmaxf(tmax, s[reg]);
    }
    tmax = fmaxf(tmax, __shfl_xor(tmax, 32));
    const float mn = fmaxf(mrun, tmax);
    if (__builtin_amdgcn_ballot_w64(mn != mrun) != 0ull) {
      const float alpha = __builtin_amdgcn_exp2f(mrun - mn);
      lsum *= alpha;
#pragma unroll
      for (int i = 0; i < 16; ++i) { o0[i] *= alpha; o1[i] *= alpha; }
    }
    mrun = mn;
    float ps = 0.f;
#pragma unroll
    for (int reg = 0; reg < 16; ++reg) { const float pv = __builtin_amdgcn_exp2f(s[reg] - mn); s[reg] = pv; ps += pv; }
    lsum += ps;
    const bf16x8 pf0 = pack8(s[0], s[1], s[2], s[3], s[4], s[5], s[6], s[7]);
    const bf16x8 pf1 = pack8(s[8], s[9], s[10], s[11], s[12], s[13], s[14], s[15]);
    __builtin_amdgcn_s_setprio(1);
    o0 = mfma32(v00, pf0, o0);
    o1 = mfma32(v01, pf0, o1);
    o0 = mfma32(v10, pf1, o0);
    o1 = mfma32(v11, pf1, o1);
    __builtin_amdgcn_s_setprio(0);
  }
#undef ATT_KT
  asm volatile("s_waitcnt vmcnt(0)" ::: "memory");
  ATT_BAR();
  lsum += __shfl_xor(lsum, 32);
  const float inv = 1.f / lsum;
  u16* op = orow + 4 * hh;
#pragma unroll
  for (int gi = 0; gi < 4; ++gi) {
    st_bf4(op + 8 * gi, o0[4 * gi] * inv, o0[4 * gi + 1] * inv, o0[4 * gi + 2] * inv, o0[4 * gi + 3] * inv);
    st_bf4(op + 32 + 8 * gi, o1[4 * gi] * inv, o1[4 * gi + 1] * inv, o1[4 * gi + 2] * inv, o1[4 * gi + 3] * inv);
  }
}

template <int DQK>
DI void attn_block_pp(LAS unsigned char* lds, const u16* __restrict__ Kb, const u16* __restrict__ Vb, const u16* __restrict__ qrow,
                      u16* __restrict__ orow, int ntiles) {
  const int tid = TIDX, lane = tid & 63, w = __builtin_amdgcn_readfirstlane(tid >> 6), hh = lane >> 5;
  constexpr int NDK = DQK / 16;
  const int nl = (w + 8 < NDK + 4) ? 2 : 1;
  for (int tt = 0; tt < ATT_NST - 1; ++tt) att_issue<NDK>(lds, Kb, Vb, min(tt, ntiles - 1), tt, w, lane);
  bf16x8 qf[NDK];
#pragma unroll
  for (int dk = 0; dk < NDK; ++dk) qf[dk] = *(const bf16x8*)(qrow + dk * 16 + 8 * hh);
#pragma unroll
  for (int dk = 0; dk < NDK; ++dk) asm volatile("" :: "v"(qf[dk]));
  f32x16 o0, o1;
#pragma unroll
  for (int i = 0; i < 16; ++i) { o0[i] = 0.f; o1[i] = 0.f; }
  float mrun = -1e30f, lsum = 0.f;
  asm volatile("s_waitcnt vmcnt(0)" ::: "memory");
  ATT_BAR();
  f32x16 sn;
#pragma unroll
  for (int i = 0; i < 16; ++i) sn[i] = 0.f;
  {
    const LAS unsigned char* sp0 = lds + lane * 16;
#pragma unroll
    for (int dk = 0; dk < NDK; ++dk) sn = mfma32(*(const LAS bf16x8*)(sp0 + dk * 1024), qf[dk], sn);
  }
  for (int t = 0; t < ntiles; ++t) {
    if (nl == 2) asm volatile("s_waitcnt vmcnt(10)" ::: "memory"); else asm volatile("s_waitcnt vmcnt(5)" ::: "memory");
    ATT_BAR();
    { const int tn = min(t + ATT_NST - 1, ntiles - 1); att_issue<NDK>(lds, Kb, Vb, tn, (t + ATT_NST - 1) & (ATT_NST - 1), w, lane); }
    const LAS unsigned char* sp = lds + (t & (ATT_NST - 1)) * ATT_STB + lane * 16;
    const LAS unsigned char* spn = lds + ((t + 1) & (ATT_NST - 1)) * ATT_STB + lane * 16;
    f32x16 s = sn;
    const bf16x8 v00 = *(const LAS bf16x8*)(sp + 6144), v01 = *(const LAS bf16x8*)(sp + 6144 + 1024),
                 v10 = *(const LAS bf16x8*)(sp + 6144 + 2048), v11 = *(const LAS bf16x8*)(sp + 6144 + 3072);
#pragma unroll
    for (int i = 0; i < 16; ++i) sn[i] = 0.f;
#pragma unroll
    for (int dk = 0; dk < NDK; ++dk) sn = mfma32(*(const LAS bf16x8*)(spn + dk * 1024), qf[dk], sn);
    float tmax = -1e30f;
#pragma unroll
    for (int reg = 0; reg < 16; ++reg) tmax = fmaxf(tmax, s[reg]);
    tmax = fmaxf(tmax, __shfl_xor(tmax, 32));
    const float mn = fmaxf(mrun, tmax);
    {
      const float alpha = __builtin_amdgcn_exp2f(mrun - mn);
      lsum *= alpha;
#pragma unroll
      for (int i = 0; i < 16; ++i) { o0[i] *= alpha; o1[i] *= alpha; }
    }
    mrun = mn;
    float ps = 0.f;
#pragma unroll
    for (int reg = 0; reg < 16; ++reg) { const float pv = __builtin_amdgcn_exp2f(s[reg] - mn); s[reg] = pv; ps += pv; }
    lsum += ps;
    const bf16x8 pf0 = pack8(s[0], s[1], s[2], s[3], s[4], s[5], s[6], s[7]);
    const bf16x8 pf1 = pack8(s[8], s[9], s[10], s[11], s[12], s[13], s[14], s[15]);
    __builtin_amdgcn_s_setprio(1);
    o0 = mfma32(v00, pf0, o0);
    o1 = mfma32(v01, pf0, o1);
    o0 = mfma32(v10, pf1, o0);
    o1 = mfma32(v11, pf1, o1);
    __builtin_amdgcn_s_setprio(0);
  }
  asm volatile("s_waitcnt vmcnt(0)" ::: "memory");
  ATT_BAR();
  lsum += __shfl_xor(lsum, 32);
  const float inv = 1.f / lsum;
  u16* op = orow + 4 * hh;
#pragma unroll
  for (int gi = 0; gi < 4; ++gi) {
    st_bf4(op + 8 * gi, o0[4 * gi] * inv, o0[4 * gi + 1] * inv, o0[4 * gi + 2] * inv, o0[4 * gi + 3] * inv);
    st_bf4(op + 32 + 8 * gi, o1[4 * gi] * inv, o1[4 * gi + 1] * inv, o1[4 * gi + 2] * inv, o1[4 * gi + 3] * inv);
  }
}

DI void attn_block_diff(LAS unsigned char* lds, const u16* __restrict__ Kb, const u16* __restrict__ Vb, const u16* __restrict__ qrow,
                        u16* __restrict__ orow, float scale, int ntiles, float lam, const float* __restrict__ gsub, float outscale) {
  const int tid = TIDX, lane = tid & 63, w = __builtin_amdgcn_readfirstlane(tid >> 6), hh = lane >> 5;
  for (int tt = 0; tt < ATT_NST - 1; ++tt) att_issue<4>(lds, Kb, Vb, min(tt, ntiles - 1), tt, w, lane);
  bf16x8 qf[4];
#pragma unroll
  for (int dk = 0; dk < 4; ++dk) qf[dk] = *(const bf16x8*)(qrow + dk * 16 + 8 * hh);
#pragma unroll
  for (int dk = 0; dk < 4; ++dk) asm volatile("" :: "v"(qf[dk]));
  f32x16 oa0, oa1, ob0, ob1;
#pragma unroll
  for (int i = 0; i < 16; ++i) { oa0[i] = 0.f; oa1[i] = 0.f; ob0[i] = 0.f; ob1[i] = 0.f; }
  float m1 = -1e30f, l1 = 0.f, m2 = -1e30f, l2 = 0.f;
  asm volatile("s_waitcnt vmcnt(0)" ::: "memory");
  ATT_BAR();
  f32x16 sn1, sn2;
#pragma unroll
  for (int i = 0; i < 16; ++i) { sn1[i] = 0.f; sn2[i] = 0.f; }
  {
    const LAS unsigned char* sp0 = lds + lane * 16;
    sn1 = mfma32(*(const LAS bf16x8*)(sp0), qf[0], sn1); sn2 = mfma32(*(const LAS bf16x8*)(sp0 + 2048), qf[2], sn2);
    sn1 = mfma32(*(const LAS bf16x8*)(sp0 + 1024), qf[1], sn1); sn2 = mfma32(*(const LAS bf16x8*)(sp0 + 3072), qf[3], sn2);
  }
  for (int t = 0; t < ntiles; ++t) {
    asm volatile("s_waitcnt vmcnt(5)" ::: "memory");
    ATT_BAR();
    att_issue<4>(lds, Kb, Vb, min(t + ATT_NST - 1, ntiles - 1), (t + ATT_NST - 1) & (ATT_NST - 1), w, lane);
    const LAS unsigned char* sp = lds + (t & (ATT_NST - 1)) * ATT_STB + lane * 16;
    const LAS unsigned char* spn = lds + ((t + 1) & (ATT_NST - 1)) * ATT_STB + lane * 16;
    f32x16 s1 = sn1, s2 = sn2;
#pragma unroll
    for (int i = 0; i < 16; ++i) { sn1[i] = 0.f; sn2[i] = 0.f; }
    sn1 = mfma32(*(const LAS bf16x8*)(spn), qf[0], sn1); sn2 = mfma32(*(const LAS bf16x8*)(spn + 2048), qf[2], sn2);
    sn1 = mfma32(*(const LAS bf16x8*)(spn + 1024), qf[1], sn1); sn2 = mfma32(*(const LAS bf16x8*)(spn + 3072), qf[3], sn2);
    const bf16x8 v00 = *(const LAS bf16x8*)(sp + 6144), v10 = *(const LAS bf16x8*)(sp + 6144 + 1024),
                 v01 = *(const LAS bf16x8*)(sp + 6144 + 2048), v11 = *(const LAS bf16x8*)(sp + 6144 + 3072);
    float t1 = -1e30f, t2 = -1e30f;
#pragma unroll
    for (int reg = 0; reg < 16; ++reg) {
      t1 = fmaxf(t1, s1[reg]); t2 = fmaxf(t2, s2[reg]);
    }
    t1 = fmaxf(t1, __shfl_xor(t1, 32));
    t2 = fmaxf(t2, __shfl_xor(t2, 32));
    const float mn1 = fmaxf(m1, t1), mn2 = fmaxf(m2, t2);
    {
      const float a1 = __builtin_amdgcn_exp2f(m1 - mn1), a2 = __builtin_amdgcn_exp2f(m2 - mn2);
      l1 *= a1; l2 *= a2;
#pragma unroll
      for (int i = 0; i < 16; ++i) { oa0[i] *= a1; oa1[i] *= a1; ob0[i] *= a2; ob1[i] *= a2; }
    }
    m1 = mn1; m2 = mn2;
    float p1 = 0.f, p2 = 0.f;
#pragma unroll
    for (int reg = 0; reg < 16; ++reg) {
      const float e1 = __builtin_amdgcn_exp2f(s1[reg] - mn1), e2 = __builtin_amdgcn_exp2f(s2[reg] - mn2);
      s1[reg] = e1; s2[reg] = e2; p1 += e1; p2 += e2;
    }
    l1 += p1; l2 += p2;
    const bf16x8 pa0 = pack8(s1[0], s1[1], s1[2], s1[3], s1[4], s1[5], s1[6], s1[7]);
    const bf16x8 pa1 = pack8(s1[8], s1[9], s1[10], s1[11], s1[12], s1[13], s1[14], s1[15]);
    const bf16x8 pb0 = pack8(s2[0], s2[1], s2[2], s2[3], s2[4], s2[5], s2[6], s2[7]);
    const bf16x8 pb1 = pack8(s2[8], s2[9], s2[10], s2[11], s2[12], s2[13], s2[14], s2[15]);
    __builtin_amdgcn_s_setprio(1);
    oa0 = mfma32(v00, pa0, oa0); oa1 = mfma32(v10, pa0, oa1);
    oa0 = mfma32(v01, pa1, oa0); oa1 = mfma32(v11, pa1, oa1);
    ob0 = mfma32(v00, pb0, ob0); ob1 = mfma32(v10, pb0, ob1);
    ob0 = mfma32(v01, pb1, ob0); ob1 = mfma32(v11, pb1, ob1);
    __builtin_amdgcn_s_setprio(0);
  }
  asm volatile("s_waitcnt vmcnt(0)" ::: "memory");
  ATT_BAR();
  l1 += __shfl_xor(l1, 32);
  l2 += __shfl_xor(l2, 32);
  const float i1 = 1.f / l1, i2 = lam / l2;
  float ss = 0.f;
#pragma unroll
  for (int i = 0; i < 16; ++i) {
    oa0[i] = oa0[i] * i1 - ob0[i] * i2;
    oa1[i] = oa1[i] * i1 - ob1[i] * i2;
    ss += oa0[i] * oa0[i] + oa1[i] * oa1[i];
  }
  ss += __shfl_xor(ss, 32);
  const float rstd = rsqrtf(ss * (1.f / 64.f) + EPS) * outscale;
  u16* op = orow + 4 * hh;
  float4 gs0[4], gs1[4];
#pragma unroll
  for (int gi = 0; gi < 4; ++gi) { gs0[gi] = *(const float4*)(gsub + 8 * gi + 4 * hh); gs1[gi] = *(const float4*)(gsub + 32 + 8 * gi + 4 * hh); }
#pragma unroll
  for (int gi = 0; gi < 4; ++gi) {
    const float4 g0 = gs0[gi], g1 = gs1[gi];
    st_bf4(op + 8 * gi, oa0[4 * gi] * rstd * g0.x, oa0[4 * gi + 1] * rstd * g0.y, oa0[4 * gi + 2] * rstd * g0.z, oa0[4 * gi + 3] * rstd * g0.w);
    st_bf4(op + 32 + 8 * gi, oa1[4 * gi] * rstd * g1.x, oa1[4 * gi + 1] * rstd * g1.y, oa1[4 * gi + 2] * rstd * g1.z, oa1[4 * gi + 3] * rstd * g1.w);
  }
}

constexpr int ATT_ITEMS = 640;
DI void phase_attn(const Params& p, int l, char* ldsg) {
  LAS unsigned char* lds = (LAS unsigned char*)ldsg;
  const int tid = TIDX, lane = tid & 63, l31 = lane & 31, w = __builtin_amdgcn_readfirstlane(tid >> 6);
  const float lam = p.lam[l];
  const float outscale = 1.f - lam_init_of(l);
  volatile LAS unsigned* slot = (volatile LAS unsigned*)(lds + 131072 + 8);
  for (;;) {
    __syncthreads();
    if (tid == 0) *slot = atomicAdd(&p.counters[l], 1u);
    __syncthreads();
    const unsigned it = __builtin_amdgcn_readfirstlane(*slot);
    if (it >= (unsigned)ATT_ITEMS) break;
    int idx = (int)it;
    if (idx < 32) {
      const int b = idx >> 4, h = (idx >> 2) & 3, qb = (idx & 3) * 8 + w;
      const int tok = TCTX + b * 1024 + qb * 32 + l31;
      attn_block_diff(lds, p.kdf_l + (size_t)l * (2 * 4 * NKL * 64) + (size_t)(b * 4 + h) * (NKL * 64),
                      p.vdf_l + (size_t)l * (2 * 4 * 64 * NKL) + (size_t)(b * 4 + h) * (64 * NKL), p.qdf + (size_t)tok * 256 + h * 64,
                      p.o + (size_t)tok * D + 768 + h * 64, 0.17677669529663687f, 40, lam, p.g_df_sub + l * 64, outscale);
      continue;
    }
    idx -= 32;
    if (idx < 48) {
      const int b = idx / 24, h = (idx >> 2) % 6, qb = (idx & 3) * 8 + w;
      const int tok = TCTX + b * 1024 + qb * 32 + l31;
      attn_block_pp<96>(lds, p.kmla_l + (size_t)l * (2 * 6 * NKL * 96) + (size_t)(b * 6 + h) * (NKL * 96),
                               p.vmla_l + (size_t)l * (2 * 6 * 64 * NKL) + (size_t)(b * 6 + h) * (64 * NKL), p.qmla + (size_t)tok * 576 + h * 96,
                               p.o + (size_t)tok * D + h * 64, 40);
      continue;
    }
    idx -= 48;
    if (idx < 48) {
      const int b = idx / 24, h = (idx >> 2) % 6, qt = idx & 3, qb = qt * 8 + w;
      const int tok = TCTX + b * 1024 + qb * 32 + l31;
      {
        const float* rg = p.na_rpb + (size_t)(l * 6 + h) * (15 * 31);
        LAS float* rl = (LAS float*)(lds + ATT_RPB_OFF);
        if (tid < 465) rl[tid] = rg[tid] * 1.4426950408889634f;
      }
      const int r0 = qt * 4;
      const int rs0 = min(max(r0 - 4, 0), 8), rs3 = min(max(r0 + 3 - 4, 0), 8);
      const int ntiles = 8 + 2 * (rs3 + 8 - rs0);
      attn_block_single<64, 1>(lds, p.kna_l + (size_t)l * (2 * 6 * NKL * 64) + (size_t)(b * 6 + h) * (NKL * 64),
                               p.vna_l + (size_t)l * (2 * 6 * 64 * NKL) + (size_t)(b * 6 + h) * (64 * NKL), p.qna + (size_t)tok * 384 + h * 64,
                               p.o + (size_t)tok * D + 384 + h * 64, 0.125f, ntiles, qb >> 1, (qb & 1) * 32 + l31, rs0);
      continue;
    }
    idx -= 48;
    if (idx < 192) {
      const int b = idx / 6, h = idx % 6;
      const int tok = b * 256 + w * 32 + l31;
      attn_block_pp<96>(lds, p.kmla_c + (size_t)(b * 6 + h) * (256 * 96), p.vmla_c + (size_t)(b * 6 + h) * (64 * 256),
                               p.qmla + (size_t)tok * 576 + h * 96, p.o + (size_t)tok * D + h * 64, 8);
      continue;
    }
    idx -= 192;
    if (idx < 192) {
      const int b = idx / 6, h = idx % 6;
      const int tok = b * 256 + w * 32 + l31;
      attn_block_pp<64>(lds, p.kna_c + (size_t)(b * 6 + h) * (256 * 64), p.vna_c + (size_t)(b * 6 + h) * (64 * 256),
                               p.qna + (size_t)tok * 384 + h * 64, p.o + (size_t)tok * D + 384 + h * 64, 8);
      continue;
    }
    idx -= 192;
    {
      const int b = idx >> 2, h = idx & 3;
      const int tok = b * 256 + w * 32 + l31;
      attn_block_diff(lds, p.kdf_c + (size_t)(b * 4 + h) * (256 * 64), p.vdf_c + (size_t)(b * 4 + h) * (64 * 256), p.qdf + (size_t)tok * 256 + h * 64,
                      p.o + (size_t)tok * D + 768 + h * 64, 0.17677669529663687f, 8, lam, p.g_df_sub + l * 64, outscale);
    }
  }
}

__global__ void __launch_bounds__(512, 2) fwd_megakernel(Params p, int ph_begin, int ph_end) {
  __shared__ __attribute__((aligned(16))) char lds[131072 + 16];
  cg::grid_group grid = cg::this_grid();
  if (ph_begin < 0) grid.sync();
  if (threadIdx.x == 0) *(uint4*)(lds + 131072) = make_uint4(0u, 0u, 0u, 0u);
  __syncthreads();
  XcdBarrier xb = xcd_barrier_post(p.bar, (volatile LAS unsigned*)(lds + 131072));
  LAS unsigned char* ldsl = (LAS unsigned char*)lds;
  for (int ph = ph_begin; ph < ph_end; ++ph) {
    if (ph > ph_begin) xcd_barrier(xb);
    if (ph == 0) { phase_prep(p, lds); continue; }
    const int l = (ph - 1) >> 3, s = (ph - 1) & 7;
    switch (s) {
      case 0: if (l == 1) prep_deferred(p, lds, 1 << 20); phase_norm(p, l, 0); break;
      case 1: { EpiIn e{p, l}; pg8::gemm_phase(ldsl, p.h, p.win_t + (size_t)l * NIN * D, T, NIN, D, e); } break;
      case 2: phase_mla_up(p, l, lds); break;
      case 3: phase_attn(p, l, lds); break;
      case 4: { EpiRes<0> e{p, l}; pg8::gemm_phase(ldsl, p.o, p.wout_t + (size_t)l * D * D, T, D, D, e); if (l == 0) prep_deferred(p, lds, BIDX >= 160 ? 4 : 0); } break;
      case 5: phase_norm(p, l, 1); break;
      case 6: { EpiGU e{p}; pg8::gemm_phase(ldsl, p.h, p.wgu_t + (size_t)l * NGU * D, T, NGU, D, e); } break;
      case 7: { EpiRes<1> e{p, l}; pg8::gemm_phase(ldsl, p.act, p.wdn_t + (size_t)l * D * DFF, T, D, DFF, e); if (l == 0) prep_deferred(p, lds, 1 << 20); } break;
    }
  }
}

extern "C" void kernel_launch(void* const* d_in, const int* in_sizes, int n_in, void* d_out, int out_size, void* d_ws, size_t ws_size,
                              hipStream_t stream) {
  static int grid_blocks = 0;
  if (!grid_blocks) {
    int dev = 0, cus = 0, per_cu = 0;
    hipGetDevice(&dev);
    hipDeviceGetAttribute(&cus, hipDeviceAttributeMultiprocessorCount, dev);
    hipOccupancyMaxActiveBlocksPerMultiprocessor(&per_cu, fwd_megakernel, 512, 0);
    if (per_cu > 1) per_cu = 1;
    if (per_cu < 1) per_cu = 1;
    grid_blocks = cus * per_cu;
  }
  Params p{};
  const float** ins = (const float**)&p;
  for (int i = 0; i < 35; ++i) ins[i] = (const float*)d_in[i];
  p.out = (float*)d_out;
  char* w = (char*)d_ws;
  size_t off = 0;
  auto alloc = [&](size_t bytes) { char* r = w + off; off += (bytes + 255) & ~(size_t)255; return r; };
  p.win_t = (u16*)alloc((size_t)2 * NIN * 1024 * 2);
  p.wuq_t = (u16*)alloc((size_t)2 * 576 * 256 * 2);
  p.wukv_t = (u16*)alloc((size_t)2 * 768 * 128 * 2);
  p.wout_t = (u16*)alloc((size_t)2 * 1024 * 1024 * 2);
  p.wgu_t = (u16*)alloc((size_t)2 * NGU * 1024 * 2);
  p.wdn_t = (u16*)alloc((size_t)2 * 1024 * DFF * 2);
  p.mod = (float*)alloc((size_t)2 * 3 * 6144 * 4);
  p.h = (u16*)alloc((size_t)T * D * 2);
  p.cq = (float*)alloc((size_t)T * 256 * 4);
  p.ckv = (float*)alloc((size_t)T * 128 * 4);
  p.krope = (float*)alloc((size_t)T * 32 * 4);
  p.qmla = (u16*)alloc((size_t)T * 576 * 2);
  p.qna = (u16*)alloc((size_t)T * 384 * 2);
  p.qdf = (u16*)alloc((size_t)T * 256 * 2);
  p.kmla_c = (u16*)alloc((size_t)32 * 6 * 256 * 96 * 2);
  p.vmla_c = (u16*)alloc((size_t)32 * 6 * 64 * 256 * 2);
  p.kna_c = (u16*)alloc((size_t)32 * 6 * 256 * 64 * 2);
  p.vna_c = (u16*)alloc((size_t)32 * 6 * 64 * 256 * 2);
  p.kdf_c = (u16*)alloc((size_t)32 * 4 * 256 * 64 * 2);
  p.vdf_c = (u16*)alloc((size_t)32 * 4 * 64 * 256 * 2);
  p.kmla_l = (u16*)alloc((size_t)2 * 2 * 6 * NKL * 96 * 2);
  p.vmla_l = (u16*)alloc((size_t)2 * 2 * 6 * 64 * NKL * 2);
  p.kna_l = (u16*)alloc((size_t)2 * 2 * 6 * NKL * 64 * 2);
  p.vna_l = (u16*)alloc((size_t)2 * 2 * 6 * 64 * NKL * 2);
  p.kdf_l = (u16*)alloc((size_t)2 * 2 * 4 * NKL * 64 * 2);
  p.vdf_l = (u16*)alloc((size_t)2 * 2 * 4 * 64 * NKL * 2);
  p.o = (u16*)alloc((size_t)T * D * 2);
  p.xa = (u16*)alloc((size_t)T * D * 2);
  p.xb = (u16*)alloc((size_t)T * D * 2);
  p.act = (u16*)alloc((size_t)T * DFF * 2);
  p.lam = (float*)alloc(256);
  p.bar = (unsigned*)alloc((size_t)XCD_BAR_WORDS * 4 + 256);
  p.counters = p.bar + XCD_BAR_WORDS;
  if (off > ws_size) { fprintf(stderr, "workspace too small: need %zu have %zu\n", off, ws_size); return; }
  hipMemsetAsync(p.bar, 0, (size_t)XCD_BAR_WORDS * 4 + 256, stream);
  int b = 0, e = 17;
  void* args[] = {&p, &b, &e};
  hipError_t err = hipLaunchCooperativeKernel((void*)fwd_megakernel, dim3(grid_blocks), dim3(512), args, 0, stream);
  if (err != hipSuccess) fprintf(stderr, "cooperative launch failed: %s (grid %d)\n", hipGetErrorString(err), grid_blocks);
}
```

```cpp
#include <hip/hip_runtime.h>
#include <hip/hip_cooperative_groups.h>
#include <cstdio>
#include <cstdint>
namespace cg = cooperative_groups;

typedef unsigned short u16;
typedef __attribute__((ext_vector_type(8))) short bf16x8;
typedef __attribute__((ext_vector_type(4))) float f32x4;
typedef __attribute__((ext_vector_type(16))) float f32x16;
typedef __attribute__((ext_vector_type(4))) unsigned u32x4;

#define DI __device__ __forceinline__

constexpr int D = 1024;
constexpr int TCTX = 8192;
constexpr int TLAT = 2048;
constexpr int T = TCTX + TLAT;
constexpr int NIN = 2560;
constexpr int DFF = 2816;
constexpr int NGU = 2 * DFF;
constexpr float EPS = 1e-6f;
constexpr int NKL = 1280;

constexpr size_t OUT_YP = 0;
constexpr size_t OUT_CKV = 10485760;
constexpr size_t OUT_KROPE = 12582912;
constexpr size_t OUT_NAK = 13107200;
constexpr size_t OUT_NAV = 19398656;
constexpr size_t OUT_DFK = 25690112;
constexpr size_t OUT_DFV = 29884416;

struct Params {
  const float *x_prompt, *x_sample, *cache_mla_ckv, *cache_mla_krope, *cache_na_k, *cache_na_v, *cache_df_k, *cache_df_v, *c, *c_ctx;
  const float *w_mod, *b_mod, *g_mix, *w_in, *g_qa, *w_uq, *g_kva, *w_ukv, *g_mla_q, *g_mla_k, *g_na_q, *g_na_k, *na_rpb, *g_df_q,
      *g_df_k, *df_lq1, *df_lk1, *df_lq2, *df_lk2, *g_df_sub, *w_out, *g_ffn, *w_gate, *w_up, *w_down;
  float* out;
  u16 *win_t, *wuq_t, *wukv_t, *wout_t, *wgu_t, *wdn_t;
  float* mod;
  u16* h;
  float *cq, *ckv, *krope;
  u16 *qmla, *qna, *qdf;
  u16 *kmla_c, *vmla_c, *kna_c, *vna_c, *kdf_c, *vdf_c;
  u16 *kmla_l, *vmla_l, *kna_l, *vna_l, *kdf_l, *vdf_l;
  u16* o;
  u16 *xa, *xb;
  u16* act;
  float* lam;
  unsigned* counters;
  unsigned* bar;
};

DI int opaque_v(int x) { asm volatile("" : "+v"(x)); return x; }
DI int opaque_s(int x) { asm volatile("" : "+s"(x)); return x; }
#define TIDX opaque_v((int)threadIdx.x)
#define BIDX opaque_s((int)blockIdx.x)
DI unsigned cvtpk(float lo, float hi) {
  unsigned r;
  asm volatile("v_cvt_pk_bf16_f32 %0, %1, %2" : "=v"(r) : "v"(lo), "v"(hi));
  return r;
}
DI u16 f2bf(float f) { return (u16)(cvtpk(f, 0.f) & 0xffffu); }
DI bf16x8 pack8(float a0, float a1, float a2, float a3, float a4, float a5, float a6, float a7) {
  uint4 u;
  u.x = cvtpk(a0, a1); u.y = cvtpk(a2, a3); u.z = cvtpk(a4, a5); u.w = cvtpk(a6, a7);
  return __builtin_bit_cast(bf16x8, u);
}
DI void st_bf4(u16* p, float a, float b, float c, float d) {
  uint2 u; u.x = cvtpk(a, b); u.y = cvtpk(c, d);
  *(uint2*)p = u;
}
DI f32x16 mfma32(bf16x8 a, bf16x8 b, f32x16 c) { return __builtin_amdgcn_mfma_f32_32x32x16_bf16(a, b, c, 0, 0, 0); }
DI f32x4 mfma16(bf16x8 a, bf16x8 b, f32x4 c) { return __builtin_amdgcn_mfma_f32_16x16x32_bf16(a, b, c, 0, 0, 0); }
DI float lam_init_of(int l) { return l == 0 ? 0.2f : 0.35550906759f; }
DI f32x4 bf4_to_f32(uint2 u) {
  f32x4 r;
  r[0] = __uint_as_float(u.x << 16); r[1] = __uint_as_float(u.x & 0xffff0000u);
  r[2] = __uint_as_float(u.y << 16); r[3] = __uint_as_float(u.y & 0xffff0000u);
  return r;
}
struct ResSrc { const float* f; const u16* h; };
DI ResSrc xrow_in(const Params& p, int l, int t) {
  ResSrc r; r.f = nullptr; r.h = nullptr;
  if (l == 0) r.f = t < TCTX ? p.x_prompt + (size_t)t * D : p.x_sample + (size_t)(t - TCTX) * D;
  else r.h = p.xb + (size_t)t * D;
  return r;
}
DI ResSrc xa_row(const Params& p, int t) { ResSrc r; r.f = nullptr; r.h = p.xa + (size_t)t * D; return r; }
DI f32x4 res_ld4(const ResSrc& s, int c) { return s.f ? *(const f32x4*)(s.f + c) : bf4_to_f32(*(const uint2*)(s.h + c)); }
DI int cond_of(int t) { return t < TCTX ? 0 : 1 + ((t - TCTX) >> 10); }

DI void rope32(f32x16& x, int s, int hh) {
  const float prow = (float)(s >> 6), pcol = (float)(s & 63);
  const float hs = hh ? 0.01f : 1.0f;
  f32x16 y;
#pragma unroll
  for (int reg = 0; reg < 16; ++reg) {
    const int a = reg >> 3, half = (reg >> 2) & 1, i3 = reg & 3;
    const float base = (i3 == 0) ? 1.0f : (i3 == 1) ? 0.31622776601683794f : (i3 == 2) ? 0.1f : 0.031622776601683794f;
    const float ang = (a ? pcol : prow) * (base * hs);
    const float cs = __cosf(ang), sn = __sinf(ang);
    const float partner = x[reg ^ 4];
    y[reg] = x[reg] * cs + (half ? partner : -partner) * sn;
  }
  x = y;
}


#define XB_TMO      128
#define XB_XCNT(j)  (256  + 64 * (j))
#define XB_XSUB(j)  (1280 + 64 * (j))
#define XB_XGEN(j)  (2304 + 64 * (j))
#define XB_TOP      3328
#define XB_TOPGEN   3392
#define XCD_BAR_WORDS 3456
#define XB_SPIN_CAP (1u << 22)
#define LAS __attribute__((address_space(3)))
DI unsigned xb_ld(unsigned* p) { return __hip_atomic_load(p, __ATOMIC_RELAXED, __HIP_MEMORY_SCOPE_AGENT); }
DI unsigned xb_add(unsigned* p, unsigned v) { return __hip_atomic_fetch_add(p, v, __ATOMIC_RELAXED, __HIP_MEMORY_SCOPE_AGENT); }
DI unsigned xb_xcc_id() { return (unsigned)__builtin_amdgcn_s_getreg((3 << 11) | 20) & 0xFu; }
#define XB_SPIN(cond, bar) do { unsigned _sp = 0; while (cond) { __builtin_amdgcn_s_sleep(1); \
    if ((++_sp & 255u) == 0u) { if (xb_ld(&(bar)[XB_TMO])) break; if (_sp > XB_SPIN_CAP) { atomicAdd(&(bar)[XB_TMO], 1u); break; } } } } while (0)
struct XcdBarrier { unsigned* bar; unsigned x; volatile LAS unsigned* st; };
DI XcdBarrier xcd_barrier_post(unsigned* bar, volatile LAS unsigned* st) {
  XcdBarrier b; b.bar = bar; b.x = xb_xcc_id(); b.st = st;
  if (threadIdx.x == 0) (void)xb_add(&bar[XB_XCNT(b.x)], 1u);
  return b;
}
DI void xcd_barrier_complete(unsigned* bar, unsigned x, unsigned& nloc, unsigned& nx) {
  const unsigned G = gridDim.x * gridDim.y * gridDim.z;
  unsigned sum, cnt, mine, sp = 0u;
  for (;;) {
    sum = 0u; cnt = 0u; mine = 0u;
#pragma unroll
    for (unsigned j = 0; j < 16; ++j) { const unsigned c = xb_ld(&bar[XB_XCNT(j)]); sum += c; cnt += (c > 0u) ? 1u : 0u; mine = (j == x) ? c : mine; }
    if (sum == G) break;
    __builtin_amdgcn_s_sleep(1);
    if ((++sp & 255u) == 0u) { if (xb_ld(&bar[XB_TMO])) break; if (sp > XB_SPIN_CAP) { atomicAdd(&bar[XB_TMO], 1u); break; } }
  }
  nloc = mine > 0u ? mine : 1u; nx = cnt > 0u ? cnt : 1u;
}
DI void xcd_barrier(const XcdBarrier& b) {
  asm volatile("s_waitcnt vmcnt(0)" ::: "memory");
  __syncthreads();
  if (threadIdx.x == 0) {
    unsigned* bar = b.bar;
    __builtin_amdgcn_s_waitcnt(0);
    unsigned nloc = b.st[0], nx = b.st[1];
    if (nloc == 0u) { xcd_barrier_complete(bar, b.x, nloc, nx); b.st[0] = nloc; b.st[1] = nx; }
    const unsigned old = xb_add(&bar[XB_XSUB(b.x)], 1u);
    const unsigned gen = old / nloc;
    if (old + 1u == (gen + 1u) * nloc) {
      __builtin_amdgcn_fence(__ATOMIC_RELEASE, "agent");
      asm volatile("s_waitcnt vmcnt(0)" ::: "memory");
      const unsigned og = xb_add(&bar[XB_TOP], 1u);
      const unsigned tg = og / nx;
      if (og + 1u == (tg + 1u) * nx) xb_add(&bar[XB_TOPGEN], 1u);
      else XB_SPIN(xb_ld(&bar[XB_TOPGEN]) == tg, bar);
      __builtin_amdgcn_fence(__ATOMIC_ACQUIRE, "agent");
      xb_add(&bar[XB_XGEN(b.x)], 1u);
      asm volatile("s_waitcnt vmcnt(0)" ::: "memory");
    } else {
      XB_SPIN(xb_ld(&bar[XB_XGEN(b.x)]) == gen, bar);
      __builtin_amdgcn_fence(__ATOMIC_ACQUIRE, "agent");
      asm volatile("s_waitcnt vmcnt(0)" ::: "memory");
    }
  }
  __syncthreads();
}

DI size_t kf_off(int kidx, int d8  , int ndk) { return ((size_t)((kidx >> 5) * ndk + (d8 >> 4)) * 64 + ((d8 >> 3) & 1) * 32 + (kidx & 31)) * 8; }
DI size_t vf_off(int kidx, int d) {
  const int kin = kidx & 31, q = kin & 15;
  return ((size_t)(((kidx >> 5) * 2 + (kin >> 4)) * 2 + (d >> 5)) * 64 + ((q >> 2) & 1) * 32 + (d & 31)) * 8 + 4 * (q >> 3) + (q & 3);
}

DI int phys_row(int L) {
  const int cl = L & 31;
  const int rho = 16 * ((cl >> 2) & 1) + 4 * (cl >> 3) + (cl & 3);
  return (L & ~255) + ((L >> 5) & 1) * 128 + ((L >> 6) & 3) * 32 + rho;
}
DI int map_row(int type, int n) {
  if (type == 1) {
    const int L = (n < 384) ? n : (n < 416) ? 2304 + (n - 384) : n - 32;
    return phys_row(L);
  }
  if (type == 2 || type == 3) {
    const int cl = n & 31;
    const int rho = 16 * ((cl >> 2) & 1) + 4 * (cl >> 3) + (cl & 3);
    return (n >> 7) * 256 + (type == 3 ? 128 : 0) + ((n >> 5) & 3) * 32 + rho;
  }
  if (type == 0) return phys_row(n);
  return n;
}
DI void transpose_tile(const float* __restrict__ src, int ld_src, int N, int k0, int n0, u16* __restrict__ dst, int ld_dst,
                       int type, int mode, u16* tile, int ng) {
  const int tid = TIDX;
  {
    const int c4 = tid & 15, r0 = tid >> 4;
    float4 v[4][2];
#pragma unroll
    for (int j = 0; j < 4; ++j)
#pragma unroll
      for (int ps = 0; ps < 2; ++ps) {
        v[j][ps] = make_float4(0.f, 0.f, 0.f, 0.f);
        if (j < ng && n0 + j * 64 + c4 * 4 < N) {
          const f32x4 t4 = __builtin_nontemporal_load((const f32x4*)(src + (size_t)(k0 + r0 + ps * 32) * ld_src + n0 + j * 64 + c4 * 4));
          v[j][ps] = make_float4(t4[0], t4[1], t4[2], t4[3]);
        }
      }
#pragma unroll
    for (int j = 0; j < 4; ++j)
      if (j < ng) {
#pragma unroll
        for (int ps = 0; ps < 2; ++ps) {
          unsigned* tp = (unsigned*)(tile + j * 4224 + (r0 + ps * 32) * 66 + c4 * 4);
          tp[0] = cvtpk(v[j][ps].x, v[j][ps].y);
          tp[1] = cvtpk(v[j][ps].z, v[j][ps].w);
        }
      }
  }
  __syncthreads();
  {
    const int kc = tid & 7, nrow = tid >> 3;
    const int k = k0 + kc * 8;
#pragma unroll
    for (int j = 0; j < 4; ++j) {
      const int n = n0 + j * 64 + nrow;
      if (j < ng && n < N) {
        const u16* tj = tile + j * 4224;
        unsigned w[4];
#pragma unroll
        for (int q = 0; q < 4; ++q) {
          const unsigned lo = tj[(kc * 8 + 2 * q) * 66 + nrow];
          const unsigned hi = tj[(kc * 8 + 2 * q + 1) * 66 + nrow];
          w[q] = lo | (hi << 16);
        }
        size_t off;
        if (mode == 0) {
          if (type == 4) {
            off = ((size_t)((n >> 5) * (ld_dst >> 4) + (k >> 4)) * 64 + ((k >> 3) & 1) * 32 + (n & 31)) * 8;
          } else off = (size_t)map_row(type, n) * ld_dst + k;
          *(uint4*)(dst + off) = make_uint4(w[0], w[1], w[2], w[3]);
        } else {
          const size_t o0 = vf_off(k, n);
          *(uint2*)(dst + o0) = make_uint2(w[0], w[1]);
          *(uint2*)(dst + o0 + 32 * 8) = make_uint2(w[2], w[3]);
        }
      }
    }
  }
  __syncthreads();
}

DI void mod_item(const Params& p, int l, int chunk, float* lds) {
  const int tid = TIDX;
  float* sv = lds;
  float* red = lds + 3072;
  for (int i = tid; i < 3072; i += 512) {
    const int n = i >> 10, k = i & 1023;
    const float v = (n == 0) ? p.c_ctx[k] : p.c[(n - 1) * 1024 + k];
    sv[i] = v / (1.f + expf(-v));
  }
  __syncthreads();
  const int c4 = tid & 15, kg = tid >> 4;
  const int c0 = chunk * 64;
  float acc[3][4];
#pragma unroll
  for (int n = 0; n < 3; ++n)
#pragma unroll
    for (int e = 0; e < 4; ++e) acc[n][e] = 0.f;
  const float* wp = p.w_mod + ((size_t)l * 1024 + kg * 32) * 6144 + c0 + c4 * 4;
#pragma unroll 8
  for (int kk = 0; kk < 32; ++kk) {
    const f32x4 w4 = __builtin_nontemporal_load((const f32x4*)(wp + (size_t)kk * 6144));
    const float4 w = make_float4(w4[0], w4[1], w4[2], w4[3]);
    const int k = kg * 32 + kk;
#pragma unroll
    for (int n = 0; n < 3; ++n) {
      const float s = sv[n * 1024 + k];
      acc[n][0] += s * w.x; acc[n][1] += s * w.y; acc[n][2] += s * w.z; acc[n][3] += s * w.w;
    }
  }
#pragma unroll
  for (int n = 0; n < 3; ++n)
#pragma unroll
    for (int e = 0; e < 4; ++e) red[(kg * 12 + n * 4 + e) * 16 + c4] = acc[n][e];
  __syncthreads();
  if (tid < 192) {
    const int n = tid >> 6, cc = tid & 63, cc4 = cc >> 2, e = cc & 3;
    float s = 0.f;
#pragma unroll
    for (int g = 0; g < 32; ++g) s += red[(g * 12 + n * 4 + e) * 16 + cc4];
    p.mod[(size_t)(l * 3 + n) * 6144 + c0 + cc] = s + p.b_mod[(size_t)l * 6144 + c0 + cc];
  }
  __syncthreads();
}

constexpr int P0_TR_PER_LAYER = 160 + 12 + 6 + 64 + 176 + 176 + 176 + 48 + 32;
constexpr int P0_MOD_PER_LAYER = 96;
constexpr int P0_KC_PER_LAYER = 20;
constexpr int P0_PER_LAYER = P0_TR_PER_LAYER + P0_MOD_PER_LAYER + P0_KC_PER_LAYER;

DI void prep_item(const Params& p, int l, int r, char* lds) {
  const int tid = TIDX;
    if (r < P0_MOD_PER_LAYER) { mod_item(p, l, r, (float*)lds); return; }
    r -= P0_MOD_PER_LAYER;
    u16* tile = (u16*)lds;
    if (r < 160) {
      const int kt = r / 10, g = r % 10;
      transpose_tile(p.w_in + (size_t)l * 1024 * 2336, 2336, 2336, kt * 64, g * 256, p.win_t + (size_t)l * NIN * 1024, 1024, 1, 0, tile, min(4, 37 - 4 * g));
      return;
    }
    r -= 160;
    if (r < 12) {
      const int kt = r / 3, g = r % 3;
      transpose_tile(p.w_uq + (size_t)l * 256 * 576, 576, 576, kt * 64, g * 256, p.wuq_t + (size_t)l * 576 * 256, 256, 4, 0, tile, min(4, 9 - 4 * g));
      return;
    }
    r -= 12;
    if (r < 6) {
      const int kt = r / 3, g = r % 3;
      transpose_tile(p.w_ukv + (size_t)l * 128 * 768, 768, 768, kt * 64, g * 256, p.wukv_t + (size_t)l * 768 * 128, 128, 4, 0, tile, 4);
      return;
    }
    r -= 6;
    if (r < 64) {
      const int kt = r / 4, g = r % 4;
      transpose_tile(p.w_out + (size_t)l * 1024 * 1024, 1024, 1024, kt * 64, g * 256, p.wout_t + (size_t)l * 1024 * 1024, 1024, 0, 0, tile, 4);
      return;
    }
    r -= 64;
    if (r < 176) {
      const int kt = r / 11, g = r % 11;
      transpose_tile(p.w_gate + (size_t)l * 1024 * DFF, DFF, DFF, kt * 64, g * 256, p.wgu_t + (size_t)l * NGU * 1024, 1024, 2, 0, tile, 4);
      return;
    }
    r -= 176;
    if (r < 176) {
      const int kt = r / 11, g = r % 11;
      transpose_tile(p.w_up + (size_t)l * 1024 * DFF, DFF, DFF, kt * 64, g * 256, p.wgu_t + (size_t)l * NGU * 1024, 1024, 3, 0, tile, 4);
      return;
    }
    r -= 176;
    if (r < 176) {
      const int kt = r / 4, g = r % 4;
      transpose_tile(p.w_down + (size_t)l * DFF * 1024, 1024, 1024, kt * 64, g * 256, p.wdn_t + (size_t)l * 1024 * DFF, DFF, 0, 0, tile, 4);
      return;
    }
    r -= 176;
    if (r < 48) {
      const int bh = r >> 2, kt = r & 3, b = bh / 6, hh = bh % 6;
      transpose_tile(p.cache_na_v + ((size_t)((b * 2 + l) * 6 + hh) * 256) * 64, 64, 64, kt * 64, 0,
                     p.vna_l + (size_t)l * (2 * 6 * 64 * NKL) + (size_t)bh * (64 * NKL), 0, 0, 1, tile, 1);
      return;
    }
    r -= 48;
    if (r < 32) {
      const int bh = r >> 2, kt = r & 3, b = bh / 4, hh = bh % 4;
      transpose_tile(p.cache_df_v + ((size_t)((b * 2 + l) * 4 + hh) * 256) * 64, 64, 64, kt * 64, 0,
                     p.vdf_l + (size_t)l * (2 * 4 * 64 * NKL) + (size_t)bh * (64 * NKL), 0, 0, 1, tile, 1);
      return;
    }
    r -= 32;
    {
      const float* src;
      u16* dst;
      if (r < 12) {
        const int b = r / 6, hh = r % 6;
        src = p.cache_na_k + ((size_t)((b * 2 + l) * 6 + hh) * 256) * 64;
        dst = p.kna_l + (size_t)l * (2 * 6 * NKL * 64) + (size_t)(b * 6 + hh) * (NKL * 64);
      } else {
        const int q = r - 12, b = q / 4, hh = q % 4;
        src = p.cache_df_k + ((size_t)((b * 2 + l) * 4 + hh) * 256) * 64;
        dst = p.kdf_l + (size_t)l * (2 * 4 * NKL * 64) + (size_t)(b * 4 + hh) * (NKL * 64);
      }
      float4 v[8];
#pragma unroll
      for (int i = 0; i < 8; ++i) v[i] = *(const float4*)(src + (tid + 512 * i) * 4);
#pragma unroll
      for (int i = 0; i < 8; ++i) {
        const int e = (tid + 512 * i) * 4;
        const int key = e >> 6, d4 = e & 63;
        st_bf4(dst + kf_off(key, d4 & ~7, 4) + (d4 & 7), v[i].x, v[i].y, v[i].z, v[i].w);
      }
    }
}

constexpr int P0_W_ITEMS = 160 + 12 + 6 + 64 + 176 + 176 + 176;
DI void phase_prep(const Params& p, char* lds) {
  const int tid = TIDX;
  if (BIDX == 0 && tid == 0) {
    for (int l = 0; l < 2; ++l) {
      float s1 = 0.f, s2 = 0.f;
      for (int i = 0; i < 32; ++i) {
        s1 += p.df_lq1[l * 32 + i] * p.df_lk1[l * 32 + i];
        s2 += p.df_lq2[l * 32 + i] * p.df_lk2[l * 32 + i];
      }
      p.lam[l] = expf(s1) - expf(s2) + lam_init_of(l);
    }
  }
  constexpr int NREST0 = P0_PER_LAYER - P0_MOD_PER_LAYER;
  constexpr int NREST1 = P0_PER_LAYER - P0_MOD_PER_LAYER - P0_W_ITEMS;
  for (int item = BIDX; item < 2 * P0_MOD_PER_LAYER + NREST0 + NREST1; item += gridDim.x) {
    int l, r;
    if (item < 2 * P0_MOD_PER_LAYER) { l = item / P0_MOD_PER_LAYER; r = item % P0_MOD_PER_LAYER; }
    else if (item < 2 * P0_MOD_PER_LAYER + NREST0) { l = 0; r = P0_MOD_PER_LAYER + (item - 2 * P0_MOD_PER_LAYER); }
    else { l = 1; r = P0_MOD_PER_LAYER + P0_W_ITEMS + (item - 2 * P0_MOD_PER_LAYER - NREST0); }
    prep_item(p, l, r, lds);
  }
}

DI void prep_deferred(const Params& p, char* lds, int cap) {
  const int tid = TIDX;
  volatile LAS unsigned* slot = (volatile LAS unsigned*)((LAS unsigned char*)lds + 131072 + 8);
  for (int n = 0; n < cap; ++n) {
    __syncthreads();
    if (tid == 0) *slot = atomicAdd(&p.counters[8], 1u);
    __syncthreads();
    const unsigned it = __builtin_amdgcn_readfirstlane(*slot);
    if (it >= (unsigned)P0_W_ITEMS) break;
    prep_item(p, 1, P0_MOD_PER_LAYER + (int)it, lds);
  }
}

DI void phase_norm(const Params& p, int l, int which  ) {
  const int lane = TIDX & 63, wid = TIDX >> 6;
  const float* g = (which == 0 ? p.g_mix : p.g_ffn) + l * D;
  const int nw = gridDim.x * 8;
  for (int t = BIDX * 8 + wid; t < T; t += 2 * nw) {
    const int t1 = t + nw;
    const bool has1 = t1 < T;
    const int tb = has1 ? t1 : t;
    const ResSrc xr0 = (which == 0) ? xrow_in(p, l, t) : xa_row(p, t);
    const ResSrc xr1 = (which == 0) ? xrow_in(p, l, tb) : xa_row(p, tb);
    const float* sh0 = p.mod + (size_t)((l * 3 + cond_of(t)) * 6 + (which == 0 ? 0 : 3)) * D;
    const float* sh1 = p.mod + (size_t)((l * 3 + cond_of(tb)) * 6 + (which == 0 ? 0 : 3)) * D;
    float4 v0[4], v1[4], gg[4], sa0[4], sb0[4], sa1[4], sb1[4];
#pragma unroll
    for (int i = 0; i < 4; ++i) {
      const int c = i * 256 + lane * 4;
      { const f32x4 a = res_ld4(xr0, c), b2 = res_ld4(xr1, c); v0[i] = make_float4(a[0], a[1], a[2], a[3]); v1[i] = make_float4(b2[0], b2[1], b2[2], b2[3]); }
      gg[i] = *(const float4*)(g + c);
      sb0[i] = *(const float4*)(sh0 + c); sa0[i] = *(const float4*)(sh0 + D + c);
      sb1[i] = *(const float4*)(sh1 + c); sa1[i] = *(const float4*)(sh1 + D + c);
    }
    float ss0 = 0.f, ss1 = 0.f;
#pragma unroll
    for (int i = 0; i < 4; ++i) {
      ss0 += v0[i].x * v0[i].x + v0[i].y * v0[i].y + v0[i].z * v0[i].z + v0[i].w * v0[i].w;
      ss1 += v1[i].x * v1[i].x + v1[i].y * v1[i].y + v1[i].z * v1[i].z + v1[i].w * v1[i].w;
    }
#pragma unroll
    for (int m = 1; m < 64; m <<= 1) { ss0 += __shfl_xor(ss0, m); ss1 += __shfl_xor(ss1, m); }
    const float r0 = rsqrtf(ss0 * (1.f / D) + EPS), r1 = rsqrtf(ss1 * (1.f / D) + EPS);
#pragma unroll
    for (int i = 0; i < 4; ++i) {
      const int c = i * 256 + lane * 4;
      st_bf4(p.h + (size_t)t * D + c, v0[i].x * r0 * gg[i].x * (1.f + sa0[i].x) + sb0[i].x, v0[i].y * r0 * gg[i].y * (1.f + sa0[i].y) + sb0[i].y,
             v0[i].z * r0 * gg[i].z * (1.f + sa0[i].z) + sb0[i].z, v0[i].w * r0 * gg[i].w * (1.f + sa0[i].w) + sb0[i].w);
    }
    if (has1) {
#pragma unroll
      for (int i = 0; i < 4; ++i) {
        const int c = i * 256 + lane * 4;
        st_bf4(p.h + (size_t)t1 * D + c, v1[i].x * r1 * gg[i].x * (1.f + sa1[i].x) + sb1[i].x, v1[i].y * r1 * gg[i].y * (1.f + sa1[i].y) + sb1[i].y,
               v1[i].z * r1 * gg[i].z * (1.f + sa1[i].z) + sb1[i].z, v1[i].w * r1 * gg[i].w * (1.f + sa1[i].w) + sb1[i].w);
      }
    }
  }
}

namespace pg8 {
typedef unsigned short bf16_t;
constexpr int BM = 256, BK = 64, HALF = 128, HTB = HALF * BK * 2, STAGE_BYTES = 8 * HTB, NXCD = 8, WGM = 8;
DI int lds_byte(int r, int c) { const int st = (r >> 4) * 2 + (c >> 5), rr = r & 15, cc = c & 31, ob = rr * 64 + cc * 2; return st * 1024 + (ob ^ (((ob >> 9) & 1) << 5)); }
DI void stage_rc(int b, int& R, int& C) { const int st = b / 1024, sb = b % 1024, swz = sb ^ (((sb >> 9) & 1) << 5); R = (st >> 1) * 16 + swz / 64; C = (st & 1) * 32 + (swz % 64) / 2; }
struct Unit { int pm, pn; };
struct StaticOrder {
  int nM, nN, nwg, G, c;
  DI void init(int M, int N, int G_, int c_) { nM = M / BM; nN = N / BM; nwg = nM * nN; G = G_; c = c_; }
  DI bool next(int i, Unit& u) const {
    const long L = (long)i * G + c; if (L >= nwg) return false;
    int wgid = (int)L; { const int q = nwg / NXCD, r = nwg % NXCD, xcd = wgid % NXCD, off = wgid / NXCD; wgid = (xcd < r ? xcd * (q + 1) : r * (q + 1) + (xcd - r) * q) + off; }
    const int nig = WGM * nN, gid = wgid / nig, fm = gid * WGM, gsz = (nM - fm) < WGM ? (nM - fm) : WGM;
    u.pm = fm + ((wgid % nig) % gsz); u.pn = (wgid % nig) / gsz; return true;
  }
};

template <class Epi>
DI void gemm_phase(LAS unsigned char* lds, const bf16_t* gA, const bf16_t* gBt, int M, int N, int K, const Epi& E) {
  const int tid = TIDX, wid = __builtin_amdgcn_readfirstlane(tid >> 6), lane = tid & 63, wr = wid >> 2, wc = wid & 3, fr = lane & 15, fq = lane >> 4;
  const int nt = K / BK;
  StaticOrder S; S.init(M, N, (int)gridDim.x, BIDX);
  unsigned voffA[2];
#pragma unroll
  for (int i = 0; i < 2; ++i) { int R, C; stage_rc(tid * 16 + i * 8192, R, C); voffA[i] = (unsigned)(R * K + C) * 2u; }
  const size_t kstep = (size_t)(BK * 2);
  const size_t hstep = (size_t)HALF * K * 2;
  const size_t tstep = 2 * hstep;
  const unsigned ldsw = (unsigned)wid * 1024u;
  const int aoff = lds_byte(wr * 64 + fr, fq * 8), boff = lds_byte(wc * 32 + fr, fq * 8);
#define PG8_SA(b, h) (((b) * 2 + (h)) * HTB)
#define PG8_SB(b, h) ((4 + (b) * 2 + (h)) * HTB)
#define PG8_STAGE(bufoff, gbase) do { _Pragma("unroll") for (int _i = 0; _i < 2; ++_i) \
    __builtin_amdgcn_global_load_lds((const unsigned*)((const char*)(gbase) + voffA[_i]), (LAS unsigned*)(lds + (bufoff) + ldsw + _i * 8192), 16, 0, 0); } while (0)
#define PG8_LDA(dst, b, h) do { _Pragma("unroll") for (int m = 0; m < 4; ++m) _Pragma("unroll") for (int k = 0; k < 2; ++k) dst[m][k] = *(const LAS bf16x8*)(lds + PG8_SA(b, h) + aoff + m * 2048 + k * 1024); } while (0)
#define PG8_LDB(dst, b, h) do { _Pragma("unroll") for (int n = 0; n < 2; ++n) _Pragma("unroll") for (int k = 0; k < 2; ++k) dst[n][k] = *(const LAS bf16x8*)(lds + PG8_SB(b, h) + boff + n * 2048 + k * 1024); } while (0)
#define PG8_MMA(ai, bj, At, Bt) do { __builtin_amdgcn_s_setprio(1); _Pragma("unroll") for (int m = 0; m < 4; ++m) _Pragma("unroll") for (int n = 0; n < 2; ++n) _Pragma("unroll") for (int k = 0; k < 2; ++k) \
    acc[ai][bj][m][n] = __builtin_amdgcn_mfma_f32_16x16x32_bf16(Bt[n][k], At[m][k], acc[ai][bj][m][n], 0, 0, 0); __builtin_amdgcn_s_setprio(0); } while (0)
#define PG8_WAIT_V(n) asm volatile("s_waitcnt vmcnt(" #n ")" ::: "memory")
#define PG8_WAIT_L(n) asm volatile("s_waitcnt lgkmcnt(" #n ")" ::: "memory")
#define PG8_BAR __builtin_amdgcn_s_barrier()
#define PG8_SCHED __builtin_amdgcn_sched_barrier(0)
  Unit cur, nxt; int ui = 0;
  if (!S.next(0, cur)) return;
  f32x4 acc[2][2][4][2];
#pragma unroll
  for (int a = 0; a < 2; ++a)
#pragma unroll
    for (int b = 0; b < 2; ++b)
#pragma unroll
      for (int m = 0; m < 4; ++m)
#pragma unroll
        for (int n = 0; n < 2; ++n) acc[a][b][m][n] = (f32x4){0.f, 0.f, 0.f, 0.f};
  bf16x8 At[4][2], B0[2][2], B1[2][2];
  const char* cA = (const char*)gA + (size_t)cur.pm * tstep; const char* cB = (const char*)gBt + (size_t)cur.pn * tstep;
  PG8_STAGE(PG8_SB(0, 0), cB); PG8_STAGE(PG8_SA(0, 0), cA); PG8_STAGE(PG8_SB(0, 1), cB + hstep); PG8_STAGE(PG8_SA(0, 1), cA + hstep);
  if (wr == 1) PG8_BAR;
  PG8_WAIT_V(4); PG8_BAR;
  PG8_STAGE(PG8_SB(1, 0), cB + kstep); PG8_STAGE(PG8_SA(1, 0), cA + kstep); PG8_STAGE(PG8_SB(1, 1), cB + hstep + kstep);
  PG8_WAIT_V(6); PG8_BAR;
  for (;;) {
    const bool has_next = S.next(ui + 1, nxt);
    const char* nA = has_next ? (const char*)gA + (size_t)nxt.pm * tstep : cA; const char* nB = has_next ? (const char*)gBt + (size_t)nxt.pn * tstep : cB;
    for (int t = 0; t < nt; t += 2) {
      const bool last = (t == nt - 2);
      const char* a1 = cA + (size_t)(t + 1) * kstep;
      const char* a2 = last ? nA : cA + (size_t)(t + 2) * kstep; const char* b2 = last ? nB : cB + (size_t)(t + 2) * kstep;
      const char* a3 = a2 + kstep; const char* b3 = b2 + kstep;
      PG8_LDB(B0, 0, 0); PG8_SCHED; PG8_LDA(At, 0, 0); PG8_STAGE(PG8_SA(1, 1), a1 + hstep);
      PG8_WAIT_L(8); PG8_BAR; PG8_WAIT_L(0); PG8_MMA(0, 0, At, B0); PG8_BAR; PG8_SCHED;
      PG8_LDB(B1, 0, 1); PG8_STAGE(PG8_SB(0, 0), b2);
      PG8_BAR; PG8_WAIT_L(0); PG8_MMA(0, 1, At, B1); PG8_BAR;
      PG8_LDA(At, 0, 1); PG8_STAGE(PG8_SA(0, 0), a2);
      PG8_BAR; PG8_WAIT_L(0); PG8_MMA(1, 0, At, B0); PG8_BAR; PG8_SCHED;
      PG8_STAGE(PG8_SB(0, 1), b2 + hstep);
      PG8_WAIT_V(6); PG8_BAR; PG8_MMA(1, 1, At, B1); PG8_BAR;
      PG8_LDB(B0, 1, 0); PG8_SCHED; PG8_LDA(At, 1, 0); PG8_STAGE(PG8_SA(0, 1), a2 + hstep);
      PG8_WAIT_L(8); PG8_BAR; PG8_WAIT_L(0); PG8_MMA(0, 0, At, B0); PG8_BAR; PG8_SCHED;
      PG8_LDB(B1, 1, 1); PG8_STAGE(PG8_SB(1, 0), b3);
      PG8_BAR; PG8_WAIT_L(0); PG8_MMA(0, 1, At, B1); PG8_BAR;
      PG8_LDA(At, 1, 1); PG8_STAGE(PG8_SA(1, 0), a3);
      PG8_BAR; PG8_WAIT_L(0); PG8_MMA(1, 0, At, B0); PG8_BAR; PG8_SCHED;
      PG8_STAGE(PG8_SB(1, 1), b3 + hstep);
      PG8_WAIT_V(6); PG8_BAR; PG8_MMA(1, 1, At, B1); PG8_BAR;
    }
    {
      int fr2 = fr, fq2 = fq; Unit cu = cur;
      asm volatile("" : "+v"(fr2), "+v"(fq2), "+s"(cu.pm), "+s"(cu.pn));
      E(acc, cu, wr, wc, fr2, fq2);
    }
    if (!has_next) break;
#pragma unroll
    for (int a = 0; a < 2; ++a)
#pragma unroll
      for (int b = 0; b < 2; ++b)
#pragma unroll
        for (int m = 0; m < 4; ++m)
#pragma unroll
          for (int n = 0; n < 2; ++n) acc[a][b][m][n] = (f32x4){0.f, 0.f, 0.f, 0.f};
    cur = nxt; cA = nA; cB = nB; ++ui;
  }
  PG8_WAIT_V(0);
  if (wr == 0) PG8_BAR;
  PG8_BAR;
#undef PG8_SA
#undef PG8_SB
#undef PG8_STAGE
#undef PG8_LDA
#undef PG8_LDB
#undef PG8_MMA
#undef PG8_WAIT_V
#undef PG8_WAIT_L
#undef PG8_BAR
#undef PG8_SCHED
}
}

typedef f32x4 AccT[2][2][4][2];
DI void st_nt4(float* p_, f32x4 v_) { __builtin_nontemporal_store(v_, (f32x4*)p_); }
DI float dot4(f32x4 a) { return a[0] * a[0] + a[1] * a[1] + a[2] * a[2] + a[3] * a[3]; }
DI float rowsum_q(float v) { v += __shfl_xor(v, 16); v += __shfl_xor(v, 32); return v; }
DI void st_bf8(u16* p, f32x4 a, f32x4 b) {
  u32x4 w; w.x = cvtpk(a[0], a[1]); w.y = cvtpk(a[2], a[3]); w.z = cvtpk(b[0], b[1]); w.w = cvtpk(b[2], b[3]);
  *(u32x4*)p = w;
}

struct EpiIn {
  const Params& p; int l;
  DI void operator()(const AccT& acc, const pg8::Unit& u, int wr, int wc, int fr, int fq) const {
    const int wcb = u.pn * 4 + wc;
    if (wcb > 36) return;
    const bool is_ctx = u.pm < 32;
    const int r0 = u.pm * 256 + wr * 64 + fr;
    int b, s0;
    if (is_ctx) { b = u.pm; s0 = wr * 64 + fr; }
    else { const int tl = r0 - TCTX; b = tl >> 10; s0 = tl & 1023; }
    const int c8 = 8 * fq;
    if (wcb < 4) {
#pragma unroll
      for (int ai = 0; ai < 2; ++ai)
#pragma unroll
        for (int m = 0; m < 4; ++m) {
          asm volatile("" ::: "memory");
          float* rp = p.cq + (size_t)(r0 + ai * 128 + m * 16) * 256 + wcb * 64 + c8;
#pragma unroll
          for (int bj = 0; bj < 2; ++bj)
#pragma unroll
            for (int n = 0; n < 2; ++n) *(f32x4*)(rp + bj * 32 + 4 * n) = acc[ai][bj][m][n];
        }
    } else if (wcb < 6) {
#pragma unroll
      for (int ai = 0; ai < 2; ++ai)
#pragma unroll
        for (int m = 0; m < 4; ++m) {
          asm volatile("" ::: "memory");
          float* rp = p.ckv + (size_t)(r0 + ai * 128 + m * 16) * 128 + (wcb - 4) * 64 + c8;
#pragma unroll
          for (int bj = 0; bj < 2; ++bj)
#pragma unroll
            for (int n = 0; n < 2; ++n) *(f32x4*)(rp + bj * 32 + 4 * n) = acc[ai][bj][m][n];
        }
    } else if (wcb < 18) {
      const bool isq = wcb < 12;
      const int hd = isq ? wcb - 6 : wcb - 12;
      const float* g = (isq ? p.g_na_q : p.g_na_k) + l * 64 + c8;
      f32x4 gv[2][2];
#pragma unroll
      for (int bj = 0; bj < 2; ++bj)
#pragma unroll
        for (int n = 0; n < 2; ++n) gv[bj][n] = *(const f32x4*)(g + bj * 32 + 4 * n);
#pragma unroll
      for (int ai = 0; ai < 2; ++ai)
#pragma unroll
        for (int m = 0; m < 4; ++m) {
          asm volatile("" ::: "memory");
          float ss = dot4(acc[ai][0][m][0]) + dot4(acc[ai][0][m][1]) + dot4(acc[ai][1][m][0]) + dot4(acc[ai][1][m][1]);
          ss = rowsum_q(ss);
          const float rstd = rsqrtf(ss * (1.f / 64.f) + EPS) * (isq ? 0.18033688011112042f : 1.f);
          const int t = r0 + ai * 128 + m * 16, s = s0 + ai * 128 + m * 16;
          f32x4 v[2][2];
#pragma unroll
          for (int bj = 0; bj < 2; ++bj)
#pragma unroll
            for (int n = 0; n < 2; ++n) v[bj][n] = acc[ai][bj][m][n] * rstd * gv[bj][n];
          if (isq) {
            u16* qp = p.qna + (size_t)t * 384 + hd * 64 + c8;
            st_bf8(qp, v[0][0], v[0][1]); st_bf8(qp + 32, v[1][0], v[1][1]);
          } else if (is_ctx) {
            float* op = p.out + OUT_NAK + ((size_t)((b * 2 + l) * 6 + hd) * 256 + s) * 64 + c8;
            st_nt4(op, v[0][0]); st_nt4(op + 4, v[0][1]); st_nt4(op + 32, v[1][0]); st_nt4(op + 36, v[1][1]);
            u16* kp = p.kna_c + (size_t)(b * 6 + hd) * (256 * 64);
            st_bf8(kp + kf_off(s, c8, 4), v[0][0], v[0][1]); st_bf8(kp + kf_off(s, 32 + c8, 4), v[1][0], v[1][1]);
          } else {
            u16* kp = p.kna_l + (size_t)l * (2 * 6 * NKL * 64) + (size_t)(b * 6 + hd) * (NKL * 64);
            st_bf8(kp + kf_off(256 + s, c8, 4), v[0][0], v[0][1]); st_bf8(kp + kf_off(256 + s, 32 + c8, 4), v[1][0], v[1][1]);
          }
        }
    } else if (wcb < 24 || (wcb >= 32 && wcb < 36)) {
      const bool isna = wcb < 24;
      const int hd = isna ? wcb - 18 : wcb - 32;
      const int nh = isna ? 6 : 4;
      const int vh = isna ? hd : 6 + hd;
      float* ob = p.out + (isna ? OUT_NAV : OUT_DFV) + ((size_t)((b * 2 + l) * nh + hd) * 256) * 64 + c8;
      u16* vb = is_ctx ? (isna ? p.vna_c : p.vdf_c) + (size_t)(b * nh + hd) * (64 * 256)
                       : (isna ? p.vna_l : p.vdf_l) + (size_t)l * (2 * nh * 64 * NKL) + (size_t)(b * nh + hd) * (64 * NKL);
      (void)vh;
#pragma unroll
      for (int ai = 0; ai < 2; ++ai)
#pragma unroll
        for (int m = 0; m < 4; ++m) {
          asm volatile("" ::: "memory");
          const int s = s0 + ai * 128 + m * 16;
          u16* vk = vb + vf_off((is_ctx ? 0 : 256) + s, c8);
#pragma unroll
          for (int bj = 0; bj < 2; ++bj)
#pragma unroll
            for (int n = 0; n < 2; ++n) {
              const unsigned lo = cvtpk(acc[ai][bj][m][n][0], acc[ai][bj][m][n][1]), hi = cvtpk(acc[ai][bj][m][n][2], acc[ai][bj][m][n][3]);
              u16* q = vk + bj * 512 + n * 32;
              q[0] = (u16)(lo & 0xffffu); q[8] = (u16)(lo >> 16); q[16] = (u16)(hi & 0xffffu); q[24] = (u16)(hi >> 16);
            }
          if (is_ctx) {
            float* op = ob + (size_t)s * 64;
            st_nt4(op, acc[ai][0][m][0]); st_nt4(op + 4, acc[ai][0][m][1]); st_nt4(op + 32, acc[ai][1][m][0]); st_nt4(op + 36, acc[ai][1][m][1]);
          }
        }
    } else if (wcb < 32) {
      const bool isq = wcb < 28;
      const int hd = isq ? wcb - 24 : wcb - 28;
      const float* g = (isq ? p.g_df_q : p.g_df_k) + l * 32 + c8;
      const f32x4 g0 = *(const f32x4*)(g), g1 = *(const f32x4*)(g + 4);
      const int ra = fq >> 1, half = fq & 1;
#pragma unroll
      for (int ai = 0; ai < 2; ++ai)
#pragma unroll
        for (int m = 0; m < 4; ++m) {
          asm volatile("" ::: "memory");
          const int t = r0 + ai * 128 + m * 16, s = s0 + ai * 128 + m * 16;
          f32x4 v[2][2];
#pragma unroll
          for (int bj = 0; bj < 2; ++bj) {
            float ss = dot4(acc[ai][bj][m][0]) + dot4(acc[ai][bj][m][1]);
            ss = rowsum_q(ss);
            const float rstd = rsqrtf(ss * (1.f / 32.f) + EPS) * (isq ? 0.25503486164919736f : 1.f);
            v[bj][0] = acc[ai][bj][m][0] * rstd * g0;
            v[bj][1] = acc[ai][bj][m][1] * rstd * g1;
          }
          if (!is_ctx) {
            const float pos = ra ? (float)(s & 63) : (float)(s >> 6);
#pragma unroll
            for (int bj = 0; bj < 2; ++bj)
#pragma unroll
              for (int n = 0; n < 2; ++n)
#pragma unroll
                for (int e = 0; e < 4; ++e) {
                  const int i = 4 * n + e;
                  const float inv = (i == 0) ? 1.0f : (i == 1) ? 0.31622776601683794f : (i == 2) ? 0.1f : (i == 3) ? 0.031622776601683794f
                                  : (i == 4) ? 0.01f : (i == 5) ? 0.0031622776601683794f : (i == 6) ? 0.001f : 0.00031622776601683794f;
                  const float ang = pos * inv;
                  const float cs = __cosf(ang), sn = __sinf(ang);
                  const float x = v[bj][n][e];
                  const float partner = __shfl_xor(x, 16);
                  v[bj][n][e] = x * cs + (half ? partner : -partner) * sn;
                }
          }
          if (isq) {
            u16* qp = p.qdf + (size_t)t * 256 + hd * 64 + c8;
            st_bf8(qp, v[0][0], v[0][1]); st_bf8(qp + 32, v[1][0], v[1][1]);
          } else if (is_ctx) {
            float* op = p.out + OUT_DFK + ((size_t)((b * 2 + l) * 4 + hd) * 256 + s) * 64 + c8;
            st_nt4(op, v[0][0]); st_nt4(op + 4, v[0][1]); st_nt4(op + 32, v[1][0]); st_nt4(op + 36, v[1][1]);
            u16* kp = p.kdf_c + (size_t)(b * 4 + hd) * (256 * 64);
            st_bf8(kp + kf_off(s, c8, 4), v[0][0], v[0][1]); st_bf8(kp + kf_off(s, 32 + c8, 4), v[1][0], v[1][1]);
          } else {
            u16* kp = p.kdf_l + (size_t)l * (2 * 4 * NKL * 64) + (size_t)(b * 4 + hd) * (NKL * 64);
            st_bf8(kp + kf_off(256 + s, c8, 4), v[0][0], v[0][1]); st_bf8(kp + kf_off(256 + s, 32 + c8, 4), v[1][0], v[1][1]);
          }
        }
    } else {
#pragma unroll
      for (int ai = 0; ai < 2; ++ai)
#pragma unroll
        for (int m = 0; m < 4; ++m) {
          asm volatile("" ::: "memory");
          const int t = r0 + ai * 128 + m * 16, s = s0 + ai * 128 + m * 16;
          float* kp = p.krope + (size_t)t * 32 + c8;
          *(f32x4*)(kp) = acc[ai][0][m][0]; *(f32x4*)(kp + 4) = acc[ai][0][m][1];
          if (is_ctx) {
            float* op = p.out + OUT_KROPE + ((size_t)(b * 2 + l) * 256 + s) * 32 + c8;
            st_nt4(op, acc[ai][0][m][0]); st_nt4(op + 4, acc[ai][0][m][1]);
          }
        }
    }
  }
};

template <int WHICH  >
struct EpiRes {
  const Params& p; int l;
  DI void operator()(const AccT& acc, const pg8::Unit& u, int wr, int wc, int fr, int fq) const {
    const int cond = u.pm < 32 ? 0 : 1 + ((u.pm - 32) >> 2);
    const int c0 = u.pn * 256 + wc * 64 + 8 * fq;
    const float* gate = p.mod + (size_t)((l * 3 + cond) * 6 + (WHICH == 0 ? 2 : 5)) * D + c0;
    f32x4 gv[2][2];
#pragma unroll
    for (int bj = 0; bj < 2; ++bj)
#pragma unroll
      for (int n = 0; n < 2; ++n) gv[bj][n] = *(const f32x4*)(gate + bj * 32 + 4 * n);
    u16* dsth = (WHICH == 0) ? p.xa : p.xb;
    const bool to_out = (WHICH == 1 && l == 1);
#pragma unroll
    for (int ai = 0; ai < 2; ++ai)
#pragma unroll
      for (int mh = 0; mh < 2; ++mh) {
        f32x4 xi[2][2][2];
#pragma unroll
        for (int mm = 0; mm < 2; ++mm) {
          const int m = mh * 2 + mm;
          const int t = u.pm * 256 + ai * 128 + wr * 64 + m * 16 + fr;
          const ResSrc xin = (WHICH == 0) ? xrow_in(p, l, t) : xa_row(p, t);
#pragma unroll
          for (int bj = 0; bj < 2; ++bj)
#pragma unroll
            for (int n = 0; n < 2; ++n) xi[mm][bj][n] = res_ld4(xin, c0 + bj * 32 + 4 * n);
        }
#pragma unroll
        for (int mm = 0; mm < 2; ++mm) {
          const int m = mh * 2 + mm;
          const int t = u.pm * 256 + ai * 128 + wr * 64 + m * 16 + fr;
          if (to_out) {
            float* xo = p.out + (size_t)t * D + c0;
#pragma unroll
            for (int bj = 0; bj < 2; ++bj)
#pragma unroll
              for (int n = 0; n < 2; ++n) st_nt4(xo + bj * 32 + 4 * n, xi[mm][bj][n] + gv[bj][n] * acc[ai][bj][m][n]);
          } else {
            u16* xo = dsth + (size_t)t * D + c0;
#pragma unroll
            for (int bj = 0; bj < 2; ++bj)
              st_bf8(xo + bj * 32, xi[mm][bj][0] + gv[bj][0] * acc[ai][bj][m][0], xi[mm][bj][1] + gv[bj][1] * acc[ai][bj][m][1]);
          }
        }
      }
  }
};

struct EpiGU {
  const Params& p;
  DI void operator()(const AccT& acc, const pg8::Unit& u, int wr, int wc, int fr, int fq) const {
    const int f0 = u.pn * 128 + wc * 32 + 8 * fq;
#pragma unroll
    for (int ai = 0; ai < 2; ++ai)
#pragma unroll
      for (int m = 0; m < 4; ++m) {
        const int t = u.pm * 256 + ai * 128 + wr * 64 + m * 16 + fr;
        f32x4 o[2];
#pragma unroll
        for (int n = 0; n < 2; ++n)
#pragma unroll
          for (int e = 0; e < 4; ++e) {
            const float gvv = acc[ai][0][m][n][e], uv = acc[ai][1][m][n][e];
            o[n][e] = gvv / (1.f + __expf(-gvv)) * uv;
          }
        st_bf8(p.act + (size_t)t * DFF + f0, o[0], o[1]);
      }
  }
};

DI void mla_q_load(const Params& p, int l, int tb, bf16x8 (&bfr)[16], float& rstd) {
  const int lane = TIDX & 63, l31 = lane & 31, hh = lane >> 5;
  const int tok = tb * 32 + l31;
  const float* cqrow = p.cq + (size_t)tok * 256;
  const float* gq = p.g_qa + l * 256;
  float ss = 0.f;
#pragma unroll
  for (int ks = 0; ks < 16; ++ks) {
    const int k = ks * 16 + 8 * hh;
    const float4 a = *(const float4*)(cqrow + k), b2 = *(const float4*)(cqrow + k + 4);
    const float4 ga = *(const float4*)(gq + k), gb = *(const float4*)(gq + k + 4);
    ss += a.x * a.x + a.y * a.y + a.z * a.z + a.w * a.w + b2.x * b2.x + b2.y * b2.y + b2.z * b2.z + b2.w * b2.w;
    bfr[ks] = pack8(a.x * ga.x, a.y * ga.y, a.z * ga.z, a.w * ga.w, b2.x * gb.x, b2.y * gb.y, b2.z * gb.z, b2.w * gb.w);
  }
  ss += __shfl_xor(ss, 32);
  rstd = rsqrtf(ss * (1.f / 256.f) + EPS);
}

DI void mla_q_compute(const Params& p, int l, int tb, int h, const LAS unsigned char* wl, const bf16x8 (&bfr)[16], float rstd) {
  const int lane = TIDX & 63, l31 = lane & 31, hh = lane >> 5;
  const int tok = tb * 32 + l31;
  float4 gq2[3][4];
#pragma unroll
  for (int nt = 0; nt < 3; ++nt)
#pragma unroll
    for (int gi = 0; gi < 4; ++gi) gq2[nt][gi] = *(const float4*)(p.g_mla_q + l * 96 + nt * 32 + 8 * gi + 4 * hh);
  f32x16 acc[3];
  const LAS unsigned char* W = wl + lane * 16;
#pragma unroll
  for (int nt = 0; nt < 3; ++nt)
#pragma unroll
    for (int r = 0; r < 16; ++r) acc[nt][r] = 0.f;
#pragma unroll
  for (int ks = 0; ks < 16; ++ks) {
    const bf16x8 w0 = *(const LAS bf16x8*)(W + (0 * 16 + ks) * 1024), w1 = *(const LAS bf16x8*)(W + (1 * 16 + ks) * 1024),
                 w2 = *(const LAS bf16x8*)(W + (2 * 16 + ks) * 1024);
    acc[0] = mfma32(w0, bfr[ks], acc[0]);
    acc[1] = mfma32(w1, bfr[ks], acc[1]);
    acc[2] = mfma32(w2, bfr[ks], acc[2]);
  }
  float s2 = 0.f;
#pragma unroll
  for (int nt = 0; nt < 3; ++nt)
#pragma unroll
    for (int r = 0; r < 16; ++r) { acc[nt][r] *= rstd; s2 += acc[nt][r] * acc[nt][r]; }
  s2 += __shfl_xor(s2, 32);
  const float rstd2 = rsqrtf(s2 * (1.f / 96.f) + EPS) * 0.14724444602590306f;
#pragma unroll
  for (int nt = 0; nt < 3; ++nt)
#pragma unroll
    for (int gi = 0; gi < 4; ++gi) {
      const float4 gg = gq2[nt][gi];
      acc[nt][4 * gi + 0] *= rstd2 * gg.x; acc[nt][4 * gi + 1] *= rstd2 * gg.y;
      acc[nt][4 * gi + 2] *= rstd2 * gg.z; acc[nt][4 * gi + 3] *= rstd2 * gg.w;
    }
  if (tok >= TCTX) rope32(acc[2], (tok - TCTX) & 1023, hh);
  u16* qo = p.qmla + (size_t)tok * 576 + h * 96 + 4 * hh;
#pragma unroll
  for (int nt = 0; nt < 3; ++nt)
#pragma unroll
    for (int gi = 0; gi < 4; ++gi)
      st_bf4(qo + nt * 32 + 8 * gi, acc[nt][4 * gi], acc[nt][4 * gi + 1], acc[nt][4 * gi + 2], acc[nt][4 * gi + 3]);
}

struct KvRow { const float* csrc; const float* krsrc; int b, s; bool is_tok, is_ctx; };
DI KvRow kv_row(const Params& p, int l, int rb) {
  const int lane = TIDX & 63, l31 = lane & 31;
  const int row = rb * 32 + l31;
  KvRow r;
  r.is_tok = row < T;
  r.is_ctx = row < TCTX;
  if (r.is_tok) {
    r.csrc = p.ckv + (size_t)row * 128;
    r.krsrc = p.krope + (size_t)row * 32;
    if (r.is_ctx) { r.b = row >> 8; r.s = row & 255; }
    else { r.b = (row - TCTX) >> 10; r.s = (row - TCTX) & 1023; }
  } else {
    const int rr = row - T;
    r.b = rr >> 8; r.s = rr & 255;
    r.csrc = p.cache_mla_ckv + ((size_t)(r.b * 2 + l) * 256 + r.s) * 128;
    r.krsrc = p.cache_mla_krope + ((size_t)(r.b * 2 + l) * 256 + r.s) * 32;
  }
  return r;
}

DI void mla_kv_load(const Params& p, int l, int rb, bf16x8 (&bfr)[8], float& rstd) {
  const int lane = TIDX & 63, hh = lane >> 5;
  const KvRow R = kv_row(p, l, rb);
  const float* gk = p.g_kva + l * 128;
  float ss = 0.f;
#pragma unroll
  for (int ks = 0; ks < 8; ++ks) {
    const int k = ks * 16 + 8 * hh;
    const float4 a = *(const float4*)(R.csrc + k), b2 = *(const float4*)(R.csrc + k + 4);
    float4 ga = make_float4(1.f, 1.f, 1.f, 1.f), gb = ga;
    if (R.is_tok) { ga = *(const float4*)(gk + k); gb = *(const float4*)(gk + k + 4); }
    ss += a.x * a.x + a.y * a.y + a.z * a.z + a.w * a.w + b2.x * b2.x + b2.y * b2.y + b2.z * b2.z + b2.w * b2.w;
    bfr[ks] = pack8(a.x * ga.x, a.y * ga.y, a.z * ga.z, a.w * ga.w, b2.x * gb.x, b2.y * gb.y, b2.z * gb.z, b2.w * gb.w);
  }
  ss += __shfl_xor(ss, 32);
  rstd = R.is_tok ? rsqrtf(ss * (1.f / 128.f) + EPS) : 1.f;
}

DI void mla_kv_compute(const Params& p, int l, int rb, int h, const LAS unsigned char* wl, const bf16x8 (&bfr)[8], float rstd) {
  const int lane = TIDX & 63, hh = lane >> 5;
  const KvRow R = kv_row(p, l, rb);
  const bool is_tok = R.is_tok, is_ctx = R.is_ctx;
  const int b = R.b, s = R.s;
  const float* gk = p.g_kva + l * 128;
  f32x16 kr;
#pragma unroll
  for (int gi = 0; gi < 4; ++gi) {
    const float4 v = *(const float4*)(R.krsrc + 8 * gi + 4 * hh);
    kr[4 * gi] = v.x; kr[4 * gi + 1] = v.y; kr[4 * gi + 2] = v.z; kr[4 * gi + 3] = v.w;
  }
  const float* g = p.g_mla_k + l * 96;
  float4 gk0[4], gk1[4], gk2[4];
#pragma unroll
  for (int gi = 0; gi < 4; ++gi) {
    gk0[gi] = *(const float4*)(g + 8 * gi + 4 * hh); gk1[gi] = *(const float4*)(g + 32 + 8 * gi + 4 * hh); gk2[gi] = *(const float4*)(g + 64 + 8 * gi + 4 * hh);
  }
  f32x16 acc[4];
  const LAS unsigned char* W = wl + lane * 16;
#pragma unroll
  for (int nt = 0; nt < 4; ++nt)
#pragma unroll
    for (int r = 0; r < 16; ++r) acc[nt][r] = 0.f;
#pragma unroll
  for (int ks = 0; ks < 8; ++ks) {
    const bf16x8 w0 = *(const LAS bf16x8*)(W + (0 * 8 + ks) * 1024), w1 = *(const LAS bf16x8*)(W + (1 * 8 + ks) * 1024),
                 w2 = *(const LAS bf16x8*)(W + (2 * 8 + ks) * 1024), w3 = *(const LAS bf16x8*)(W + (3 * 8 + ks) * 1024);
    acc[0] = mfma32(w0, bfr[ks], acc[0]);
    acc[1] = mfma32(w1, bfr[ks], acc[1]);
    acc[2] = mfma32(w2, bfr[ks], acc[2]);
    acc[3] = mfma32(w3, bfr[ks], acc[3]);
  }
  float sk = 0.f;
#pragma unroll
  for (int nt = 0; nt < 4; ++nt)
#pragma unroll
    for (int r = 0; r < 16; ++r) acc[nt][r] *= rstd;
#pragma unroll
  for (int r = 0; r < 16; ++r) sk += acc[0][r] * acc[0][r] + acc[1][r] * acc[1][r] + kr[r] * kr[r];
  sk += __shfl_xor(sk, 32);
  const float rstdk = rsqrtf(sk * (1.f / 96.f) + EPS);
#pragma unroll
  for (int gi = 0; gi < 4; ++gi) {
    const float4 g0 = gk0[gi], g1 = gk1[gi], g2 = gk2[gi];
    acc[0][4 * gi] *= rstdk * g0.x; acc[0][4 * gi + 1] *= rstdk * g0.y; acc[0][4 * gi + 2] *= rstdk * g0.z; acc[0][4 * gi + 3] *= rstdk * g0.w;
    acc[1][4 * gi] *= rstdk * g1.x; acc[1][4 * gi + 1] *= rstdk * g1.y; acc[1][4 * gi + 2] *= rstdk * g1.z; acc[1][4 * gi + 3] *= rstdk * g1.w;
    kr[4 * gi] *= rstdk * g2.x; kr[4 * gi + 1] *= rstdk * g2.y; kr[4 * gi + 2] *= rstdk * g2.z; kr[4 * gi + 3] *= rstdk * g2.w;
  }
  if (is_tok && !is_ctx) rope32(kr, s, hh);
  u16 *kd, *vd;
  int kidx;
  if (is_ctx) {
    kidx = s;
    kd = p.kmla_c + (size_t)(b * 6 + h) * (256 * 96);
    vd = p.vmla_c + (size_t)(b * 6 + h) * (64 * 256);
  } else {
    kidx = is_tok ? 256 + s : s;
    kd = p.kmla_l + (size_t)l * (2 * 6 * NKL * 96) + (size_t)(b * 6 + h) * (NKL * 96);
    vd = p.vmla_l + (size_t)l * (2 * 6 * 64 * NKL) + (size_t)(b * 6 + h) * (64 * NKL);
  }
#pragma unroll
  for (int gi = 0; gi < 4; ++gi) {
    st_bf4(kd + kf_off(kidx, 8 * gi, 6) + 4 * hh, acc[0][4 * gi], acc[0][4 * gi + 1], acc[0][4 * gi + 2], acc[0][4 * gi + 3]);
    st_bf4(kd + kf_off(kidx, 32 + 8 * gi, 6) + 4 * hh, acc[1][4 * gi], acc[1][4 * gi + 1], acc[1][4 * gi + 2], acc[1][4 * gi + 3]);
    st_bf4(kd + kf_off(kidx, 64 + 8 * gi, 6) + 4 * hh, kr[4 * gi], kr[4 * gi + 1], kr[4 * gi + 2], kr[4 * gi + 3]);
  }
#pragma unroll
  for (int nt = 0; nt < 2; ++nt)
#pragma unroll
    for (int r = 0; r < 16; ++r) {
      const int d = nt * 32 + (r & 3) + 8 * (r >> 2) + 4 * hh;
      vd[vf_off(kidx, d)] = f2bf(acc[2 + nt][r]);
    }
  if (is_ctx && h == 0) {
    float* ob = p.out + OUT_CKV + ((size_t)(b * 2 + l) * 256 + s) * 128;
    float4 oa[8], obv[8];
#pragma unroll
    for (int ks = 0; ks < 8; ++ks) {
      const int k = ks * 16 + 8 * hh;
      const float4 a = *(const float4*)(R.csrc + k), b2 = *(const float4*)(R.csrc + k + 4);
      const float4 ga = *(const float4*)(gk + k), gb = *(const float4*)(gk + k + 4);
      oa[ks] = make_float4(a.x * rstd * ga.x, a.y * rstd * ga.y, a.z * rstd * ga.z, a.w * rstd * ga.w);
      obv[ks] = make_float4(b2.x * rstd * gb.x, b2.y * rstd * gb.y, b2.z * rstd * gb.z, b2.w * rstd * gb.w);
    }
#pragma unroll
    for (int ks = 0; ks < 8; ++ks) {
      const int k = ks * 16 + 8 * hh;
      st_nt4(ob + k, (f32x4){oa[ks].x, oa[ks].y, oa[ks].z, oa[ks].w});
      st_nt4(ob + k + 4, (f32x4){obv[ks].x, obv[ks].y, obv[ks].z, obv[ks].w});
    }
  }
}

DI void phase_mla_up(const Params& p, int l, char* lds) {
  const int tid = TIDX, lane = tid & 63, w = __builtin_amdgcn_readfirstlane(tid >> 6);
  LAS unsigned char* ldsl = (LAS unsigned char*)lds;
  const int nslot = ((int)gridDim.x + 7) >> 3;
  for (int it0 = (BIDX & 7) * nslot + (BIDX >> 3); it0 < 252 + 8 * nslot; it0 += 8 * nslot) {
    const int item = it0;
    if (item >= 252 || (BIDX >> 3) >= nslot) break;
    __syncthreads();
    const bool hasq = item < 240;
    const int h = item % 6, grp = item / 6;
    if (hasq) {
      const u16* wsrc = p.wuq_t + (size_t)l * 576 * 256 + (size_t)(h * 3) * (16 * 512) + lane * 8;
#pragma unroll
      for (int i = 0; i < 6; ++i) {
        const int blk = w + 8 * i;
        __builtin_amdgcn_global_load_lds((const unsigned*)(wsrc + blk * 512), (LAS unsigned*)(ldsl + blk * 1024), 16, 0, 0);
      }
    }
    {
      const u16* wsrc = p.wukv_t + (size_t)l * 768 * 128 + (size_t)(h * 4) * (8 * 512) + lane * 8;
#pragma unroll
      for (int i = 0; i < 4; ++i) {
        const int blk = w + 8 * i;
        __builtin_amdgcn_global_load_lds((const unsigned*)(wsrc + blk * 512), (LAS unsigned*)(ldsl + 49152 + blk * 1024), 16, 0, 0);
      }
    }
    bf16x8 bq[16], bk[8];
    float rq = 1.f, rk = 1.f;
    if (hasq) mla_q_load(p, l, grp * 8 + w, bq, rq);
    mla_kv_load(p, l, grp * 8 + w, bk, rk);
    asm volatile("s_waitcnt vmcnt(0)" ::: "memory");
    __syncthreads();
    if (hasq) mla_q_compute(p, l, grp * 8 + w, h, ldsl, bq, rq);
    mla_kv_compute(p, l, grp * 8 + w, h, ldsl + 49152, bk, rk);
  }
}

constexpr int ATT_NST = 8, ATT_STB = 10240, ATT_RPB_OFF = ATT_NST * ATT_STB;
#define ATT_BAR() do { __builtin_amdgcn_s_barrier(); asm volatile("" ::: "memory"); } while (0)

template <int NDK>
DI void att_issue(LAS unsigned char* lds, const u16* Kb, const u16* Vb, int kt, int st, int w, int lane) {
#pragma unroll
  for (int i = 0; i < 2; ++i) {
    const int j = w + 8 * i;
    if (j < NDK + 4) {
      const u16* src = (j < NDK) ? Kb + (size_t)kt * (NDK * 512) + j * 512 : Vb + (size_t)kt * 2048 + (j - NDK) * 512;
      const int dst = st * ATT_STB + ((j < NDK) ? j * 1024 : 6144 + (j - NDK) * 1024);
      __builtin_amdgcn_global_load_lds((const unsigned*)(src + lane * 8), (LAS unsigned*)(lds + dst), 16, 0, 0);
    }
  }
}

template <int DQK, int MODE>
DI void attn_block_single(LAS unsigned char* lds, const u16* __restrict__ Kb, const u16* __restrict__ Vb, const u16* __restrict__ qrow,
                          u16* __restrict__ orow, float scale, int ntiles, int r, int qc, int rs0) {
  const int tid = TIDX, lane = tid & 63, w = __builtin_amdgcn_readfirstlane(tid >> 6), hh = lane >> 5;
  constexpr int NDK = DQK / 16;
  const int nl = (w + 8 < NDK + 4) ? 2 : 1;
#define ATT_KT(t_) ((MODE == 1 && (t_) >= 8) ? 8 + (rs0 + (((t_) - 8) >> 1)) * 2 + (((t_) - 8) & 1) : (t_))
  for (int tt = 0; tt < ATT_NST - 1; ++tt) { const int tc = min(tt, ntiles - 1); att_issue<NDK>(lds, Kb, Vb, ATT_KT(tc), tt, w, lane); }
  bf16x8 qf[NDK];
#pragma unroll
  for (int dk = 0; dk < NDK; ++dk) qf[dk] = *(const bf16x8*)(qrow + dk * 16 + 8 * hh);
#pragma unroll
  for (int dk = 0; dk < NDK; ++dk) asm volatile("" :: "v"(qf[dk]));
  f32x16 o0, o1;
#pragma unroll
  for (int i = 0; i < 16; ++i) { o0[i] = 0.f; o1[i] = 0.f; }
  float mrun = -1e30f, lsum = 0.f;
  int rs = 0, cs = 0;
  if (MODE == 1) { rs = min(max(r - 4, 0), 8); cs = min(max(qc - 8, 0), 48); }
  const LAS float* rpbl = (const LAS float*)(lds + ATT_RPB_OFF);
  for (int t = 0; t < ntiles; ++t) {
    if (nl == 2) asm volatile("s_waitcnt vmcnt(12)" ::: "memory"); else asm volatile("s_waitcnt vmcnt(6)" ::: "memory");
    ATT_BAR();
    { const int tn = min(t + ATT_NST - 1, ntiles - 1); att_issue<NDK>(lds, Kb, Vb, ATT_KT(tn), (t + ATT_NST - 1) & (ATT_NST - 1), w, lane); }
    int jr = 0, ct = 0;
    if (MODE == 1 && t >= 8) {
      jr = rs0 + ((t - 8) >> 1) - rs; ct = (t - 8) & 1;
      if (jr < 0 || jr > 7) continue;
    }
    const LAS unsigned char* sp = lds + (t & (ATT_NST - 1)) * ATT_STB + lane * 16;
    f32x16 s;
#pragma unroll
    for (int i = 0; i < 16; ++i) s[i] = 0.f;
    __builtin_amdgcn_s_setprio(1);
#pragma unroll
    for (int dk = 0; dk < NDK; ++dk) s = mfma32(*(const LAS bf16x8*)(sp + dk * 1024), qf[dk], s);
    __builtin_amdgcn_s_setprio(0);
    const bf16x8 v00 = *(const LAS bf16x8*)(sp + 6144), v01 = *(const LAS bf16x8*)(sp + 6144 + 1024),
                 v10 = *(const LAS bf16x8*)(sp + 6144 + 2048), v11 = *(const LAS bf16x8*)(sp + 6144 + 3072);
    float tmax = -1e30f;
    if (MODE == 1 && t >= 8) {
      const LAS float* rp = rpbl + (rs + jr - r + 7) * 31;
#pragma unroll
      for (int reg = 0; reg < 16; ++reg) {
        const int kc = ct * 32 + (reg & 3) + 8 * (reg >> 2) + 4 * hh;
        const int rc = min(max(kc - qc, -15), 15) + 15;
        const float bias = rp[rc];
        const float v = (kc >= cs && kc < cs + 16) ? s[reg] + bias : -1e30f;
        s[reg] = v;
        tmax = fmaxf(tmax, v);
      }
    } else {
#pragma unroll
      for (int reg = 0; reg < 16; ++reg) tmax = fmaxf(tmax, s[reg]);
    }
    tmax = fmaxf(tmax, __shfl_xor(tmax, 32));
    const float mn = fmaxf(mrun, tmax);
    if (__builtin_amdgcn_ballot_w64(mn != mrun) != 0ull) {
      const float alpha = __builtin_amdgcn_exp2f(mrun - mn);
      lsum *= alpha;
#pragma unroll
      for (int i = 0; i < 16; ++i) { o0[i] *= alpha; o1[i] *= alpha; }
    }
    mrun = mn;
    float ps = 0.f;
#pragma unroll
    for (int reg = 0; reg < 16; ++reg) { const float pv = __builtin_amdgcn_exp2f(s[reg] - mn); s[reg] = pv; ps += pv; }
    lsum += ps;
    const bf16x8 pf0 = pack8(s[0], s[1], s[2], s[3], s[4], s[5], s[6], s[7]);
    const bf16x8 pf1 = pack8(s[8], s[9], s[10], s[11], s[12], s[13], s[14], s[15]);
    __builtin_amdgcn_s_setprio(1);
    o0 = mfma32(v00, pf0, o0);
    o1 = mfma32(v01, pf0, o1);
    o0 = mfma32(v10, pf1, o0);
    o1 = mfma32(v11, pf1, o1);
    __builtin_amdgcn_s_setprio(0);
  }
#undef ATT_KT
  asm volatile("s_waitcnt vmcnt(0)" ::: "memory");
  ATT_BAR();
  lsum += __shfl_xor(lsum, 32);
  const float inv = 1.f / lsum;
  u16* op = orow + 4 * hh;
#pragma unroll
  for (int gi = 0; gi < 4; ++gi) {
    st_bf4(op + 8 * gi, o0[4 * gi] * inv, o0[4 * gi + 1] * inv, o0[4 * gi + 2] * inv, o0[4 * gi + 3] * inv);
    st_bf4(op + 32 + 8 * gi, o1[4 * gi] * inv, o1[4 * gi + 1] * inv, o1[4 * gi + 2] * inv, o1[4 * gi + 3] * inv);
  }
}

template <int DQK>
DI void attn_block_pp(LAS unsigned char* lds, const u16* __restrict__ Kb, const u16* __restrict__ Vb, const u16* __restrict__ qrow,
                      u16* __restrict__ orow, int ntiles) {
  const int tid = TIDX, lane = tid & 63, w = __builtin_amdgcn_readfirstlane(tid >> 6), hh = lane >> 5;
  constexpr int NDK = DQK / 16;
  const int nl = (w + 8 < NDK + 4) ? 2 : 1;
  for (int tt = 0; tt < ATT_NST - 1; ++tt) att_issue<NDK>(lds, Kb, Vb, min(tt, ntiles - 1), tt, w, lane);
  bf16x8 qf[NDK];
#pragma unroll
  for (int dk = 0; dk < NDK; ++dk) qf[dk] = *(const bf16x8*)(qrow + dk * 16 + 8 * hh);
#pragma unroll
  for (int dk = 0; dk < NDK; ++dk) asm volatile("" :: "v"(qf[dk]));
  f32x16 o0, o1;
#pragma unroll
  for (int i = 0; i < 16; ++i) { o0[i] = 0.f; o1[i] = 0.f; }
  float mrun = -1e30f, lsum = 0.f;
  asm volatile("s_waitcnt vmcnt(0)" ::: "memory");
  ATT_BAR();
  f32x16 sn;
#pragma unroll
  for (int i = 0; i < 16; ++i) sn[i] = 0.f;
  {
    const LAS unsigned char* sp0 = lds + lane * 16;
#pragma unroll
    for (int dk = 0; dk < NDK; ++dk) sn = mfma32(*(const LAS bf16x8*)(sp0 + dk * 1024), qf[dk], sn);
  }
  for (int t = 0; t < ntiles; ++t) {
    if (nl == 2) asm volatile("s_waitcnt vmcnt(10)" ::: "memory"); else asm volatile("s_waitcnt vmcnt(5)" ::: "memory");
    ATT_BAR();
    { const int tn = min(t + ATT_NST - 1, ntiles - 1); att_issue<NDK>(lds, Kb, Vb, tn, (t + ATT_NST - 1) & (ATT_NST - 1), w, lane); }
    const LAS unsigned char* sp = lds + (t & (ATT_NST - 1)) * ATT_STB + lane * 16;
    const LAS unsigned char* spn = lds + ((t + 1) & (ATT_NST - 1)) * ATT_STB + lane * 16;
    f32x16 s = sn;
    const bf16x8 v00 = *(const LAS bf16x8*)(sp + 6144), v01 = *(const LAS bf16x8*)(sp + 6144 + 1024),
                 v10 = *(const LAS bf16x8*)(sp + 6144 + 2048), v11 = *(const LAS bf16x8*)(sp + 6144 + 3072);
#pragma unroll
    for (int i = 0; i < 16; ++i) sn[i] = 0.f;
#pragma unroll
    for (int dk = 0; dk < NDK; ++dk) sn = mfma32(*(const LAS bf16x8*)(spn + dk * 1024), qf[dk], sn);
    float tmax = -1e30f;
#pragma unroll
    for (int reg = 0; reg < 16; ++reg) tmax = fmaxf(tmax, s[reg]);
    tmax = fmaxf(tmax, __shfl_xor(tmax, 32));
    const float mn = fmaxf(mrun, tmax);
    {
      const float alpha = __builtin_amdgcn_exp2f(mrun - mn);
      lsum *= alpha;
#pragma unroll
      for (int i = 0; i < 16; ++i) { o0[i] *= alpha; o1[i] *= alpha; }
    }
    mrun = mn;
    float ps = 0.f;
#pragma unroll
    for (int reg = 0; reg < 16; ++reg) { const float pv = __builtin_amdgcn_exp2f(s[reg] - mn); s[reg] = pv; ps += pv; }
    lsum += ps;
    const bf16x8 pf0 = pack8(s[0], s[1], s[2], s[3], s[4], s[5], s[6], s[7]);
    const bf16x8 pf1 = pack8(s[8], s[9], s[10], s[11], s[12], s[13], s[14], s[15]);
    __builtin_amdgcn_s_setprio(1);
    o0 = mfma32(v00, pf0, o0);
    o1 = mfma32(v01, pf0, o1);
    o0 = mfma32(v10, pf1, o0);
    o1 = mfma32(v11, pf1, o1);
    __builtin_amdgcn_s_setprio(0);
  }
  asm volatile("s_waitcnt vmcnt(0)" ::: "memory");
  ATT_BAR();
  lsum += __shfl_xor(lsum, 32);
  const float inv = 1.f / lsum;
  u16* op = orow + 4 * hh;
#pragma unroll
  for (int gi = 0; gi < 4; ++gi) {
    st_bf4(op + 8 * gi, o0[4 * gi] * inv, o0[4 * gi + 1] * inv, o0[4 * gi + 2] * inv, o0[4 * gi + 3] * inv);
    st_bf4(op + 32 + 8 * gi, o1[4 * gi] * inv, o1[4 * gi + 1] * inv, o1[4 * gi + 2] * inv, o1[4 * gi + 3] * inv);
  }
}

DI void attn_block_diff(LAS unsigned char* lds, const u16* __restrict__ Kb, const u16* __restrict__ Vb, const u16* __restrict__ qrow,
                        u16* __restrict__ orow, float scale, int ntiles, float lam, const float* __restrict__ gsub, float outscale) {
  const int tid = TIDX, lane = tid & 63, w = __builtin_amdgcn_readfirstlane(tid >> 6), hh = lane >> 5;
  for (int tt = 0; tt < ATT_NST - 1; ++tt) att_issue<4>(lds, Kb, Vb, min(tt, ntiles - 1), tt, w, lane);
  bf16x8 qf[4];
#pragma unroll
  for (int dk = 0; dk < 4; ++dk) qf[dk] = *(const bf16x8*)(qrow + dk * 16 + 8 * hh);
#pragma unroll
  for (int dk = 0; dk < 4; ++dk) asm volatile("" :: "v"(qf[dk]));
  f32x16 oa0, oa1, ob0, ob1;
#pragma unroll
  for (int i = 0; i < 16; ++i) { oa0[i] = 0.f; oa1[i] = 0.f; ob0[i] = 0.f; ob1[i] = 0.f; }
  float m1 = -1e30f, l1 = 0.f, m2 = -1e30f, l2 = 0.f;
  for (int t = 0; t < ntiles; ++t) {
    asm volatile("s_waitcnt vmcnt(6)" ::: "memory");
    ATT_BAR();
    att_issue<4>(lds, Kb, Vb, min(t + ATT_NST - 1, ntiles - 1), (t + ATT_NST - 1) & (ATT_NST - 1), w, lane);
    const LAS unsigned char* sp = lds + (t & (ATT_NST - 1)) * ATT_STB + lane * 16;
    f32x16 s1, s2;
#pragma unroll
    for (int i = 0; i < 16; ++i) { s1[i] = 0.f; s2[i] = 0.f; }
    __builtin_amdgcn_s_setprio(1);
    s1 = mfma32(*(const LAS bf16x8*)(sp), qf[0], s1); s1 = mfma32(*(const LAS bf16x8*)(sp + 1024), qf[1], s1);
    s2 = mfma32(*(const LAS bf16x8*)(sp + 2048), qf[2], s2); s2 = mfma32(*(const LAS bf16x8*)(sp + 3072), qf[3], s2);
    __builtin_amdgcn_s_setprio(0);
    const bf16x8 v00 = *(const LAS bf16x8*)(sp + 6144), v10 = *(const LAS bf16x8*)(sp + 6144 + 1024),
                 v01 = *(const LAS bf16x8*)(sp + 6144 + 2048), v11 = *(const LAS bf16x8*)(sp + 6144 + 3072);
    float t1 = -1e30f, t2 = -1e30f;
#pragma unroll
    for (int reg = 0; reg < 16; ++reg) {
      t1 = fmaxf(t1, s1[reg]); t2 = fmaxf(t2, s2[reg]);
    }
    t1 = fmaxf(t1, __shfl_xor(t1, 32));
    t2 = fmaxf(t2, __shfl_xor(t2, 32));
    const float mn1 = fmaxf(m1, t1), mn2 = fmaxf(m2, t2);
    if (__builtin_amdgcn_ballot_w64(mn1 != m1) != 0ull) {
      const float a1 = __builtin_amdgcn_exp2f(m1 - mn1);
      l1 *= a1;
#pragma unroll
      for (int i = 0; i < 16; ++i) { oa0[i] *= a1; oa1[i] *= a1; }
    }
    if (__builtin_amdgcn_ballot_w64(mn2 != m2) != 0ull) {
      const float a2 = __builtin_amdgcn_exp2f(m2 - mn2);
      l2 *= a2;
#pragma unroll
      for (int i = 0; i < 16; ++i) { ob0[i] *= a2; ob1[i] *= a2; }
    }
    m1 = mn1; m2 = mn2;
    float p1 = 0.f, p2 = 0.f;
#pragma unroll
    for (int reg = 0; reg < 16; ++reg) {
      const float e1 = __builtin_amdgcn_exp2f(s1[reg] - mn1), e2 = __builtin_amdgcn_exp2f(s2[reg] - mn2);
      s1[reg] = e1; s2[reg] = e2; p1 += e1; p2 += e2;
    }
    l1 += p1; l2 += p2;
    const bf16x8 pa0 = pack8(s1[0], s1[1], s1[2], s1[3], s1[4], s1[5], s1[6], s1[7]);
    const bf16x8 pa1 = pack8(s1[8], s1[9], s1[10], s1[11], s1[12], s1[13], s1[14], s1[15]);
    const bf16x8 pb0 = pack8(s2[0], s2[1], s2[2], s2[3], s2[4], s2[5], s2[6], s2[7]);
    const bf16x8 pb1 = pack8(s2[8], s2[9], s2[10], s2[11], s2[12], s2[13], s2[14], s2[15]);
    __builtin_amdgcn_s_setprio(1);
    oa0 = mfma32(v00, pa0, oa0); oa1 = mfma32(v10, pa0, oa1);
    oa0 = mfma32(v01, pa1, oa0); oa1 = mfma32(v11, pa1, oa1);
    ob0 = mfma32(v00, pb0, ob0); ob1 = mfma32(v10, pb0, ob1);
    ob0 = mfma32(v01, pb1, ob0); ob1 = mfma32(v11, pb1, ob1);
    __builtin_amdgcn_s_setprio(0);
  }
  asm volatile("s_waitcnt vmcnt(0)" ::: "memory");
  ATT_BAR();
  l1 += __shfl_xor(l1, 32);
  l2 += __shfl_xor(l2, 32);
  const float i1 = 1.f / l1, i2 = lam / l2;
  float ss = 0.f;
#pragma unroll
  for (int i = 0; i < 16; ++i) {
    oa0[i] = oa0[i] * i1 - ob0[i] * i2;
    oa1[i] = oa1[i] * i1 - ob1[i] * i2;
    ss += oa0[i] * oa0[i] + oa1[i] * oa1[i];
  }
  ss += __shfl_xor(ss, 32);
  const float rstd = rsqrtf(ss * (1.f / 64.f) + EPS) * outscale;
  u16* op = orow + 4 * hh;
  float4 gs0[4], gs1[4];
#pragma unroll
  for (int gi = 0; gi < 4; ++gi) { gs0[gi] = *(const float4*)(gsub + 8 * gi + 4 * hh); gs1[gi] = *(const float4*)(gsub + 32 + 8 * gi + 4 * hh); }
#pragma unroll
  for (int gi = 0; gi < 4; ++gi) {
    const float4 g0 = gs0[gi], g1 = gs1[gi];
    st_bf4(op + 8 * gi, oa0[4 * gi] * rstd * g0.x, oa0[4 * gi + 1] * rstd * g0.y, oa0[4 * gi + 2] * rstd * g0.z, oa0[4 * gi + 3] * rstd * g0.w);
    st_bf4(op + 32 + 8 * gi, oa1[4 * gi] * rstd * g1.x, oa1[4 * gi + 1] * rstd * g1.y, oa1[4 * gi + 2] * rstd * g1.z, oa1[4 * gi + 3] * rstd * g1.w);
  }
}

constexpr int ATT_ITEMS = 640;
DI void phase_attn(const Params& p, int l, char* ldsg) {
  LAS unsigned char* lds = (LAS unsigned char*)ldsg;
  const int tid = TIDX, lane = tid & 63, l31 = lane & 31, w = __builtin_amdgcn_readfirstlane(tid >> 6);
  const float lam = p.lam[l];
  const float outscale = 1.f - lam_init_of(l);
  volatile LAS unsigned* slot = (volatile LAS unsigned*)(lds + 131072 + 8);
  for (;;) {
    __syncthreads();
    if (tid == 0) *slot = atomicAdd(&p.counters[l], 1u);
    __syncthreads();
    const unsigned it = __builtin_amdgcn_readfirstlane(*slot);
    if (it >= (unsigned)ATT_ITEMS) break;
    int idx = (int)it;
    if (idx < 32) {
      const int b = idx >> 4, h = (idx >> 2) & 3, qb = (idx & 3) * 8 + w;
      const int tok = TCTX + b * 1024 + qb * 32 + l31;
      attn_block_diff(lds, p.kdf_l + (size_t)l * (2 * 4 * NKL * 64) + (size_t)(b * 4 + h) * (NKL * 64),
                      p.vdf_l + (size_t)l * (2 * 4 * 64 * NKL) + (size_t)(b * 4 + h) * (64 * NKL), p.qdf + (size_t)tok * 256 + h * 64,
                      p.o + (size_t)tok * D + 768 + h * 64, 0.17677669529663687f, 40, lam, p.g_df_sub + l * 64, outscale);
      continue;
    }
    idx -= 32;
    if (idx < 48) {
      const int b = idx / 24, h = (idx >> 2) % 6, qb = (idx & 3) * 8 + w;
      const int tok = TCTX + b * 1024 + qb * 32 + l31;
      attn_block_pp<96>(lds, p.kmla_l + (size_t)l * (2 * 6 * NKL * 96) + (size_t)(b * 6 + h) * (NKL * 96),
                               p.vmla_l + (size_t)l * (2 * 6 * 64 * NKL) + (size_t)(b * 6 + h) * (64 * NKL), p.qmla + (size_t)tok * 576 + h * 96,
                               p.o + (size_t)tok * D + h * 64, 40);
      continue;
    }
    idx -= 48;
    if (idx < 48) {
      const int b = idx / 24, h = (idx >> 2) % 6, qt = idx & 3, qb = qt * 8 + w;
      const int tok = TCTX + b * 1024 + qb * 32 + l31;
      {
        const float* rg = p.na_rpb + (size_t)(l * 6 + h) * (15 * 31);
        LAS float* rl = (LAS float*)(lds + ATT_RPB_OFF);
        if (tid < 465) rl[tid] = rg[tid] * 1.4426950408889634f;
      }
      const int r0 = qt * 4;
      const int rs0 = min(max(r0 - 4, 0), 8), rs3 = min(max(r0 + 3 - 4, 0), 8);
      const int ntiles = 8 + 2 * (rs3 + 8 - rs0);
      attn_block_single<64, 1>(lds, p.kna_l + (size_t)l * (2 * 6 * NKL * 64) + (size_t)(b * 6 + h) * (NKL * 64),
                               p.vna_l + (size_t)l * (2 * 6 * 64 * NKL) + (size_t)(b * 6 + h) * (64 * NKL), p.qna + (size_t)tok * 384 + h * 64,
                               p.o + (size_t)tok * D + 384 + h * 64, 0.125f, ntiles, qb >> 1, (qb & 1) * 32 + l31, rs0);
      continue;
    }
    idx -= 48;
    if (idx < 192) {
      const int b = idx / 6, h = idx % 6;
      const int tok = b * 256 + w * 32 + l31;
      attn_block_pp<96>(lds, p.kmla_c + (size_t)(b * 6 + h) * (256 * 96), p.vmla_c + (size_t)(b * 6 + h) * (64 * 256),
                               p.qmla + (size_t)tok * 576 + h * 96, p.o + (size_t)tok * D + h * 64, 8);
      continue;
    }
    idx -= 192;
    if (idx < 192) {
      const int b = idx / 6, h = idx % 6;
      const int tok = b * 256 + w * 32 + l31;
      attn_block_pp<64>(lds, p.kna_c + (size_t)(b * 6 + h) * (256 * 64), p.vna_c + (size_t)(b * 6 + h) * (64 * 256),
                               p.qna + (size_t)tok * 384 + h * 64, p.o + (size_t)tok * D + 384 + h * 64, 8);
      continue;
    }
    idx -= 192;
    {
      const int b = idx >> 2, h = idx & 3;
      const int tok = b * 256 + w * 32 + l31;
      attn_block_diff(lds, p.kdf_c + (size_t)(b * 4 + h) * (256 * 64), p.vdf_c + (size_t)(b * 4 + h) * (64 * 256), p.qdf + (size_t)tok * 256 + h * 64,
                      p.o + (size_t)tok * D + 768 + h * 64, 0.17677669529663687f, 8, lam, p.g_df_sub + l * 64, outscale);
    }
  }
}

__global__ void __launch_bounds__(512, 2) fwd_megakernel(Params p, int ph_begin, int ph_end) {
  __shared__ __attribute__((aligned(16))) char lds[131072 + 16];
  cg::grid_group grid = cg::this_grid();
  if (ph_begin < 0) grid.sync();
  if (threadIdx.x == 0) *(uint4*)(lds + 131072) = make_uint4(0u, 0u, 0u, 0u);
  __syncthreads();
  XcdBarrier xb = xcd_barrier_post(p.bar, (volatile LAS unsigned*)(lds + 131072));
  LAS unsigned char* ldsl = (LAS unsigned char*)lds;
  for (int ph = ph_begin; ph < ph_end; ++ph) {
    if (ph > ph_begin) xcd_barrier(xb);
    if (ph == 0) { phase_prep(p, lds); continue; }
    const int l = (ph - 1) >> 3, s = (ph - 1) & 7;
    switch (s) {
      case 0: if (l == 1) prep_deferred(p, lds, 1 << 20); phase_norm(p, l, 0); break;
      case 1: { EpiIn e{p, l}; pg8::gemm_phase(ldsl, p.h, p.win_t + (size_t)l * NIN * D, T, NIN, D, e); } break;
      case 2: phase_mla_up(p, l, lds); break;
      case 3: phase_attn(p, l, lds); break;
      case 4: { EpiRes<0> e{p, l}; pg8::gemm_phase(ldsl, p.o, p.wout_t + (size_t)l * D * D, T, D, D, e); if (l == 0) prep_deferred(p, lds, BIDX >= 160 ? 4 : 0); } break;
      case 5: phase_norm(p, l, 1); break;
      case 6: { EpiGU e{p}; pg8::gemm_phase(ldsl, p.h, p.wgu_t + (size_t)l * NGU * D, T, NGU, D, e); } break;
      case 7: { EpiRes<1> e{p, l}; pg8::gemm_phase(ldsl, p.act, p.wdn_t + (size_t)l * D * DFF, T, D, DFF, e); if (l == 0) prep_deferred(p, lds, 1 << 20); } break;
    }
  }
}

extern "C" void kernel_launch(void* const* d_in, const int* in_sizes, int n_in, void* d_out, int out_size, void* d_ws, size_t ws_size,
                              hipStream_t stream) {
  static int grid_blocks = 0;
  if (!grid_blocks) {
    int dev = 0, cus = 0, per_cu = 0;
    hipGetDevice(&dev);
    hipDeviceGetAttribute(&cus, hipDeviceAttributeMultiprocessorCount, dev);
    hipOccupancyMaxActiveBlocksPerMultiprocessor(&per_cu, fwd_megakernel, 512, 0);
    if (per_cu > 1) per_cu = 1;
    if (per_cu < 1) per_cu = 1;
    grid_blocks = cus * per_cu;
  }
  Params p{};
  const float** ins = (const float**)&p;
  for (int i = 0; i < 35; ++i) ins[i] = (const float*)d_in[i];
  p.out = (float*)d_out;
  char* w = (char*)d_ws;
  size_t off = 0;
  auto alloc = [&](size_t bytes) { char* r = w + off; off += (bytes + 255) & ~(size_t)255; return r; };
  p.win_t = (u16*)alloc((size_t)2 * NIN * 1024 * 2);
  p.wuq_t = (u16*)alloc((size_t)2 * 576 * 256 * 2);
  p.wukv_t = (u16*)alloc((size_t)2 * 768 * 128 * 2);
  p.wout_t = (u16*)alloc((size_t)2 * 1024 * 1024 * 2);
  p.wgu_t = (u16*)alloc((size_t)2 * NGU * 1024 * 2);
  p.wdn_t = (u16*)alloc((size_t)2 * 1024 * DFF * 2);
  p.mod = (float*)alloc((size_t)2 * 3 * 6144 * 4);
  p.h = (u16*)alloc((size_t)T * D * 2);
  p.cq = (float*)alloc((size_t)T * 256 * 4);
  p.ckv = (float*)alloc((size_t)T * 128 * 4);
  p.krope = (float*)alloc((size_t)T * 32 * 4);
  p.qmla = (u16*)alloc((size_t)T * 576 * 2);
  p.qna = (u16*)alloc((size_t)T * 384 * 2);
  p.qdf = (u16*)alloc((size_t)T * 256 * 2);
  p.kmla_c = (u16*)alloc((size_t)32 * 6 * 256 * 96 * 2);
  p.vmla_c = (u16*)alloc((size_t)32 * 6 * 64 * 256 * 2);
  p.kna_c = (u16*)alloc((size_t)32 * 6 * 256 * 64 * 2);
  p.vna_c = (u16*)alloc((size_t)32 * 6 * 64 * 256 * 2);
  p.kdf_c = (u16*)alloc((size_t)32 * 4 * 256 * 64 * 2);
  p.vdf_c = (u16*)alloc((size_t)32 * 4 * 64 * 256 * 2);
  p.kmla_l = (u16*)alloc((size_t)2 * 2 * 6 * NKL * 96 * 2);
  p.vmla_l = (u16*)alloc((size_t)2 * 2 * 6 * 64 * NKL * 2);
  p.kna_l = (u16*)alloc((size_t)2 * 2 * 6 * NKL * 64 * 2);
  p.vna_l = (u16*)alloc((size_t)2 * 2 * 6 * 64 * NKL * 2);
  p.kdf_l = (u16*)alloc((size_t)2 * 2 * 4 * NKL * 64 * 2);
  p.vdf_l = (u16*)alloc((size_t)2 * 2 * 4 * 64 * NKL * 2);
  p.o = (u16*)alloc((size_t)T * D * 2);
  p.xa = (u16*)alloc((size_t)T * D * 2);
  p.xb = (u16*)alloc((size_t)T * D * 2);
  p.act = (u16*)alloc((size_t)T * DFF * 2);
  p.lam = (float*)alloc(256);
  p.bar = (unsigned*)alloc((size_t)XCD_BAR_WORDS * 4 + 256);
  p.counters = p.bar + XCD_BAR_WORDS;
  if (off > ws_size) { fprintf(stderr, "workspace too small: need %zu have %zu\n", off, ws_size); return; }
  hipMemsetAsync(p.bar, 0, (size_t)XCD_BAR_WORDS * 4 + 256, stream);
  int b = 0, e = 17;
  void* args[] = {&p, &b, &e};
  hipError_t err = hipLaunchCooperativeKernel((void*)fwd_megakernel, dim3(grid_blocks), dim3(512), args, 0, stream);
  if (err != hipSuccess) fprintf(stderr, "cooperative launch failed: %s (grid %d)\n", hipGetErrorString(err), grid_blocks);
}
```

```cpp
#include <hip/hip_runtime.h>
#include <hip/hip_cooperative_groups.h>
#include <cstdio>
#include <cstdint>
namespace cg = cooperative_groups;

typedef unsigned short u16;
typedef __attribute__((ext_vector_type(8))) short bf16x8;
typedef __attribute__((ext_vector_type(4))) float f32x4;
typedef __attribute__((ext_vector_type(16))) float f32x16;
typedef __attribute__((ext_vector_type(4))) unsigned u32x4;

#define DI __device__ __forceinline__

constexpr int D = 1024;
constexpr int TCTX = 8192;
constexpr int TLAT = 2048;
constexpr int T = TCTX + TLAT;
constexpr int NIN = 2560;
constexpr int DFF = 2816;
constexpr int NGU = 2 * DFF;
constexpr float EPS = 1e-6f;
constexpr int NKL = 1280;

constexpr size_t OUT_YP = 0;
constexpr size_t OUT_CKV = 10485760;
constexpr size_t OUT_KROPE = 12582912;
constexpr size_t OUT_NAK = 13107200;
constexpr size_t OUT_NAV = 19398656;
constexpr size_t OUT_DFK = 25690112;
constexpr size_t OUT_DFV = 29884416;

struct Params {
  const float *x_prompt, *x_sample, *cache_mla_ckv, *cache_mla_krope, *cache_na_k, *cache_na_v, *cache_df_k, *cache_df_v, *c, *c_ctx;
  const float *w_mod, *b_mod, *g_mix, *w_in, *g_qa, *w_uq, *g_kva, *w_ukv, *g_mla_q, *g_mla_k, *g_na_q, *g_na_k, *na_rpb, *g_df_q,
      *g_df_k, *df_lq1, *df_lk1, *df_lq2, *df_lk2, *g_df_sub, *w_out, *g_ffn, *w_gate, *w_up, *w_down;
  float* out;
  u16 *win_t, *wuq_t, *wukv_t, *wout_t, *wgu_t, *wdn_t;
  float* mod;
  u16* h;
  float *cq, *ckv, *krope;
  u16 *qmla, *qna, *qdf;
  u16 *kmla_c, *vmla_c, *kna_c, *vna_c, *kdf_c, *vdf_c;
  u16 *kmla_l, *vmla_l, *kna_l, *vna_l, *kdf_l, *vdf_l;
  u16* o;
  u16 *xa, *xb;
  u16* act;
  float* lam;
  unsigned* counters;
  unsigned* bar;
};

DI int opaque_v(int x) { asm volatile("" : "+v"(x)); return x; }
DI int opaque_s(int x) { asm volatile("" : "+s"(x)); return x; }
#define TIDX opaque_v((int)threadIdx.x)
#define BIDX opaque_s((int)blockIdx.x)
DI unsigned cvtpk(float lo, float hi) {
  unsigned r;
  asm volatile("v_cvt_pk_bf16_f32 %0, %1, %2" : "=v"(r) : "v"(lo), "v"(hi));
  return r;
}
DI u16 f2bf(float f) { return (u16)(cvtpk(f, 0.f) & 0xffffu); }
DI bf16x8 pack8(float a0, float a1, float a2, float a3, float a4, float a5, float a6, float a7) {
  uint4 u;
  u.x = cvtpk(a0, a1); u.y = cvtpk(a2, a3); u.z = cvtpk(a4, a5); u.w = cvtpk(a6, a7);
  return __builtin_bit_cast(bf16x8, u);
}
DI void st_bf4(u16* p, float a, float b, float c, float d) {
  uint2 u; u.x = cvtpk(a, b); u.y = cvtpk(c, d);
  *(uint2*)p = u;
}
DI f32x16 mfma32(bf16x8 a, bf16x8 b, f32x16 c) { return __builtin_amdgcn_mfma_f32_32x32x16_bf16(a, b, c, 0, 0, 0); }
DI f32x4 mfma16(bf16x8 a, bf16x8 b, f32x4 c) { return __builtin_amdgcn_mfma_f32_16x16x32_bf16(a, b, c, 0, 0, 0); }
DI float lam_init_of(int l) { return l == 0 ? 0.2f : 0.35550906759f; }
DI f32x4 bf4_to_f32(uint2 u) {
  f32x4 r;
  r[0] = __uint_as_float(u.x << 16); r[1] = __uint_as_float(u.x & 0xffff0000u);
  r[2] = __uint_as_float(u.y << 16); r[3] = __uint_as_float(u.y & 0xffff0000u);
  return r;
}
struct ResSrc { const float* f; const u16* h; };
DI ResSrc xrow_in(const Params& p, int l, int t) {
  ResSrc r; r.f = nullptr; r.h = nullptr;
  if (l == 0) r.f = t < TCTX ? p.x_prompt + (size_t)t * D : p.x_sample + (size_t)(t - TCTX) * D;
  else r.h = p.xb + (size_t)t * D;
  return r;
}
DI ResSrc xa_row(const Params& p, int t) { ResSrc r; r.f = nullptr; r.h = p.xa + (size_t)t * D; return r; }
DI f32x4 res_ld4(const ResSrc& s, int c) { return s.f ? __builtin_nontemporal_load((const f32x4*)(s.f + c)) : bf4_to_f32(*(const uint2*)(s.h + c)); }
DI int cond_of(int t) { return t < TCTX ? 0 : 1 + ((t - TCTX) >> 10); }

DI void rope32(f32x16& x, int s, int hh) {
  const float prow = (float)(s >> 6), pcol = (float)(s & 63);
  const float hs = hh ? 0.01f : 1.0f;
  f32x16 y;
#pragma unroll
  for (int reg = 0; reg < 16; ++reg) {
    const int a = reg >> 3, half = (reg >> 2) & 1, i3 = reg & 3;
    const float base = (i3 == 0) ? 1.0f : (i3 == 1) ? 0.31622776601683794f : (i3 == 2) ? 0.1f : 0.031622776601683794f;
    const float ang = (a ? pcol : prow) * (base * hs);
    const float cs = __cosf(ang), sn = __sinf(ang);
    const float partner = x[reg ^ 4];
    y[reg] = x[reg] * cs + (half ? partner : -partner) * sn;
  }
  x = y;
}


#define XB_TMO      128
#define XB_XCNT(j)  (256  + 64 * (j))
#define XB_XSUB(j)  (1280 + 64 * (j))
#define XB_XGEN(j)  (2304 + 64 * (j))
#define XB_TOP      3328
#define XB_TOPGEN   3392
#define XCD_BAR_WORDS 3456
#define XB_SPIN_CAP (1u << 22)
#define LAS __attribute__((address_space(3)))
DI unsigned xb_ld(unsigned* p) { return __hip_atomic_load(p, __ATOMIC_RELAXED, __HIP_MEMORY_SCOPE_AGENT); }
DI unsigned xb_add(unsigned* p, unsigned v) { return __hip_atomic_fetch_add(p, v, __ATOMIC_RELAXED, __HIP_MEMORY_SCOPE_AGENT); }
DI unsigned xb_xcc_id() { return (unsigned)__builtin_amdgcn_s_getreg((3 << 11) | 20) & 0xFu; }
#define XB_SPIN(cond, bar) do { unsigned _sp = 0; while (cond) { __builtin_amdgcn_s_sleep(1); \
    if ((++_sp & 255u) == 0u) { if (xb_ld(&(bar)[XB_TMO])) break; if (_sp > XB_SPIN_CAP) { atomicAdd(&(bar)[XB_TMO], 1u); break; } } } } while (0)
struct XcdBarrier { unsigned* bar; unsigned x; volatile LAS unsigned* st; };
DI XcdBarrier xcd_barrier_post(unsigned* bar, volatile LAS unsigned* st) {
  XcdBarrier b; b.bar = bar; b.x = xb_xcc_id(); b.st = st;
  if (threadIdx.x == 0) (void)xb_add(&bar[XB_XCNT(b.x)], 1u);
  return b;
}
DI void xcd_barrier_complete(unsigned* bar, unsigned x, unsigned& nloc, unsigned& nx) {
  const unsigned G = gridDim.x * gridDim.y * gridDim.z;
  unsigned sum, cnt, mine, sp = 0u;
  for (;;) {
    sum = 0u; cnt = 0u; mine = 0u;
#pragma unroll
    for (unsigned j = 0; j < 16; ++j) { const unsigned c = xb_ld(&bar[XB_XCNT(j)]); sum += c; cnt += (c > 0u) ? 1u : 0u; mine = (j == x) ? c : mine; }
    if (sum == G) break;
    __builtin_amdgcn_s_sleep(1);
    if ((++sp & 255u) == 0u) { if (xb_ld(&bar[XB_TMO])) break; if (sp > XB_SPIN_CAP) { atomicAdd(&bar[XB_TMO], 1u); break; } }
  }
  nloc = mine > 0u ? mine : 1u; nx = cnt > 0u ? cnt : 1u;
}
DI void xcd_barrier(const XcdBarrier& b) {
  asm volatile("s_waitcnt vmcnt(0)" ::: "memory");
  __syncthreads();
  if (threadIdx.x == 0) {
    unsigned* bar = b.bar;
    __builtin_amdgcn_s_waitcnt(0);
    unsigned nloc = b.st[0], nx = b.st[1];
    if (nloc == 0u) { xcd_barrier_complete(bar, b.x, nloc, nx); b.st[0] = nloc; b.st[1] = nx; }
    const unsigned old = xb_add(&bar[XB_XSUB(b.x)], 1u);
    const unsigned gen = old / nloc;
    if (old + 1u == (gen + 1u) * nloc) {
      __builtin_amdgcn_fence(__ATOMIC_RELEASE, "agent");
      asm volatile("s_waitcnt vmcnt(0)" ::: "memory");
      const unsigned og = xb_add(&bar[XB_TOP], 1u);
      const unsigned tg = og / nx;
      if (og + 1u == (tg + 1u) * nx) xb_add(&bar[XB_TOPGEN], 1u);
      else XB_SPIN(xb_ld(&bar[XB_TOPGEN]) == tg, bar);
      __builtin_amdgcn_fence(__ATOMIC_ACQUIRE, "agent");
      xb_add(&bar[XB_XGEN(b.x)], 1u);
      asm volatile("s_waitcnt vmcnt(0)" ::: "memory");
    } else {
      XB_SPIN(xb_ld(&bar[XB_XGEN(b.x)]) == gen, bar);
      __builtin_amdgcn_fence(__ATOMIC_ACQUIRE, "agent");
      asm volatile("s_waitcnt vmcnt(0)" ::: "memory");
    }
  }
  __syncthreads();
}

DI size_t kf_off(int kidx, int d8  , int ndk) { return ((size_t)((kidx >> 5) * ndk + (d8 >> 4)) * 64 + ((d8 >> 3) & 1) * 32 + (kidx & 31)) * 8; }
DI size_t vf_off(int kidx, int d) {
  const int kin = kidx & 31, q = kin & 15;
  return ((size_t)(((kidx >> 5) * 2 + (kin >> 4)) * 2 + (d >> 5)) * 64 + ((q >> 2) & 1) * 32 + (d & 31)) * 8 + 4 * (q >> 3) + (q & 3);
}

DI int phys_row(int L) {
  const int cl = L & 31;
  const int rho = 16 * ((cl >> 2) & 1) + 4 * (cl >> 3) + (cl & 3);
  return (L & ~255) + ((L >> 5) & 1) * 128 + ((L >> 6) & 3) * 32 + rho;
}
DI int map_row(int type, int n) {
  if (type == 1) {
    const int L = (n < 384) ? n : (n < 416) ? 2304 + (n - 384) : n - 32;
    return phys_row(L);
  }
  if (type == 2 || type == 3) {
    const int cl = n & 31;
    const int rho = 16 * ((cl >> 2) & 1) + 4 * (cl >> 3) + (cl & 3);
    return (n >> 7) * 256 + (type == 3 ? 128 : 0) + ((n >> 5) & 3) * 32 + rho;
  }
  if (type == 0) return phys_row(n);
  return n;
}
DI void transpose_tile(const float* __restrict__ src, int ld_src, int N, int k0, int n0, u16* __restrict__ dst, int ld_dst,
                       int type, int mode, u16* tile, int ng) {
  const int tid = TIDX;
  {
    const int c4 = tid & 15, r0 = tid >> 4;
    float4 v[4][2];
#pragma unroll
    for (int j = 0; j < 4; ++j)
#pragma unroll
      for (int ps = 0; ps < 2; ++ps) {
        v[j][ps] = make_float4(0.f, 0.f, 0.f, 0.f);
        if (j < ng && n0 + j * 64 + c4 * 4 < N) {
          const f32x4 t4 = __builtin_nontemporal_load((const f32x4*)(src + (size_t)(k0 + r0 + ps * 32) * ld_src + n0 + j * 64 + c4 * 4));
          v[j][ps] = make_float4(t4[0], t4[1], t4[2], t4[3]);
        }
      }
#pragma unroll
    for (int j = 0; j < 4; ++j)
      if (j < ng) {
#pragma unroll
        for (int ps = 0; ps < 2; ++ps) {
          unsigned* tp = (unsigned*)(tile + j * 4224 + (r0 + ps * 32) * 66 + c4 * 4);
          tp[0] = cvtpk(v[j][ps].x, v[j][ps].y);
          tp[1] = cvtpk(v[j][ps].z, v[j][ps].w);
        }
      }
  }
  __syncthreads();
  {
    const int kc = tid & 7, nrow = tid >> 3;
    const int k = k0 + kc * 8;
#pragma unroll
    for (int j = 0; j < 4; ++j) {
      const int n = n0 + j * 64 + nrow;
      if (j < ng && n < N) {
        const u16* tj = tile + j * 4224;
        unsigned w[4];
#pragma unroll
        for (int q = 0; q < 4; ++q) {
          const unsigned lo = tj[(kc * 8 + 2 * q) * 66 + nrow];
          const unsigned hi = tj[(kc * 8 + 2 * q + 1) * 66 + nrow];
          w[q] = lo | (hi << 16);
        }
        size_t off;
        if (mode == 0) {
          if (type == 4) {
            off = ((size_t)((n >> 5) * (ld_dst >> 4) + (k >> 4)) * 64 + ((k >> 3) & 1) * 32 + (n & 31)) * 8;
          } else off = (size_t)map_row(type, n) * ld_dst + k;
          *(uint4*)(dst + off) = make_uint4(w[0], w[1], w[2], w[3]);
        } else {
          const size_t o0 = vf_off(k, n);
          *(uint2*)(dst + o0) = make_uint2(w[0], w[1]);
          *(uint2*)(dst + o0 + 32 * 8) = make_uint2(w[2], w[3]);
        }
      }
    }
  }
  __syncthreads();
}

DI void mod_item(const Params& p, int l, int chunk, float* lds) {
  const int tid = TIDX;
  float* sv = lds;
  float* red = lds + 3072;
  for (int i = tid; i < 3072; i += 512) {
    const int n = i >> 10, k = i & 1023;
    const float v = (n == 0) ? p.c_ctx[k] : p.c[(n - 1) * 1024 + k];
    sv[i] = v / (1.f + expf(-v));
  }
  __syncthreads();
  const int c4 = tid & 15, kg = tid >> 4;
  const int c0 = chunk * 64;
  float acc[3][4];
#pragma unroll
  for (int n = 0; n < 3; ++n)
#pragma unroll
    for (int e = 0; e < 4; ++e) acc[n][e] = 0.f;
  const float* wp = p.w_mod + ((size_t)l * 1024 + kg * 32) * 6144 + c0 + c4 * 4;
#pragma unroll 8
  for (int kk = 0; kk < 32; ++kk) {
    const f32x4 w4 = __builtin_nontemporal_load((const f32x4*)(wp + (size_t)kk * 6144));
    const float4 w = make_float4(w4[0], w4[1], w4[2], w4[3]);
    const int k = kg * 32 + kk;
#pragma unroll
    for (int n = 0; n < 3; ++n) {
      const float s = sv[n * 1024 + k];
      acc[n][0] += s * w.x; acc[n][1] += s * w.y; acc[n][2] += s * w.z; acc[n][3] += s * w.w;
    }
  }
#pragma unroll
  for (int n = 0; n < 3; ++n)
#pragma unroll
    for (int e = 0; e < 4; ++e) red[(kg * 12 + n * 4 + e) * 16 + c4] = acc[n][e];
  __syncthreads();
  if (tid < 192) {
    const int n = tid >> 6, cc = tid & 63, cc4 = cc >> 2, e = cc & 3;
    float s = 0.f;
#pragma unroll
    for (int g = 0; g < 32; ++g) s += red[(g * 12 + n * 4 + e) * 16 + cc4];
    p.mod[(size_t)(l * 3 + n) * 6144 + c0 + cc] = s + p.b_mod[(size_t)l * 6144 + c0 + cc];
  }
  __syncthreads();
}

constexpr int P0_TR_PER_LAYER = 160 + 12 + 6 + 64 + 176 + 176 + 176 + 48 + 32;
constexpr int P0_MOD_PER_LAYER = 96;
constexpr int P0_KC_PER_LAYER = 20;
constexpr int P0_PER_LAYER = P0_TR_PER_LAYER + P0_MOD_PER_LAYER + P0_KC_PER_LAYER;

DI void prep_item(const Params& p, int l, int r, char* lds) {
  const int tid = TIDX;
    if (r < P0_MOD_PER_LAYER) { mod_item(p, l, r, (float*)lds); return; }
    r -= P0_MOD_PER_LAYER;
    u16* tile = (u16*)lds;
    if (r < 160) {
      const int kt = r / 10, g = r % 10;
      transpose_tile(p.w_in + (size_t)l * 1024 * 2336, 2336, 2336, kt * 64, g * 256, p.win_t + (size_t)l * NIN * 1024, 1024, 1, 0, tile, min(4, 37 - 4 * g));
      return;
    }
    r -= 160;
    if (r < 12) {
      const int kt = r / 3, g = r % 3;
      transpose_tile(p.w_uq + (size_t)l * 256 * 576, 576, 576, kt * 64, g * 256, p.wuq_t + (size_t)l * 576 * 256, 256, 4, 0, tile, min(4, 9 - 4 * g));
      return;
    }
    r -= 12;
    if (r < 6) {
      const int kt = r / 3, g = r % 3;
      transpose_tile(p.w_ukv + (size_t)l * 128 * 768, 768, 768, kt * 64, g * 256, p.wukv_t + (size_t)l * 768 * 128, 128, 4, 0, tile, 4);
      return;
    }
    r -= 6;
    if (r < 64) {
      const int kt = r / 4, g = r % 4;
      transpose_tile(p.w_out + (size_t)l * 1024 * 1024, 1024, 1024, kt * 64, g * 256, p.wout_t + (size_t)l * 1024 * 1024, 1024, 0, 0, tile, 4);
      return;
    }
    r -= 64;
    if (r < 176) {
      const int kt = r / 11, g = r % 11;
      transpose_tile(p.w_gate + (size_t)l * 1024 * DFF, DFF, DFF, kt * 64, g * 256, p.wgu_t + (size_t)l * NGU * 1024, 1024, 2, 0, tile, 4);
      return;
    }
    r -= 176;
    if (r < 176) {
      const int kt = r / 11, g = r % 11;
      transpose_tile(p.w_up + (size_t)l * 1024 * DFF, DFF, DFF, kt * 64, g * 256, p.wgu_t + (size_t)l * NGU * 1024, 1024, 3, 0, tile, 4);
      return;
    }
    r -= 176;
    if (r < 176) {
      const int kt = r / 4, g = r % 4;
      transpose_tile(p.w_down + (size_t)l * DFF * 1024, 1024, 1024, kt * 64, g * 256, p.wdn_t + (size_t)l * 1024 * DFF, DFF, 0, 0, tile, 4);
      return;
    }
    r -= 176;
    if (r < 48) {
      const int bh = r >> 2, kt = r & 3, b = bh / 6, hh = bh % 6;
      transpose_tile(p.cache_na_v + ((size_t)((b * 2 + l) * 6 + hh) * 256) * 64, 64, 64, kt * 64, 0,
                     p.vna_l + (size_t)l * (2 * 6 * 64 * NKL) + (size_t)bh * (64 * NKL), 0, 0, 1, tile, 1);
      return;
    }
    r -= 48;
    if (r < 32) {
      const int bh = r >> 2, kt = r & 3, b = bh / 4, hh = bh % 4;
      transpose_tile(p.cache_df_v + ((size_t)((b * 2 + l) * 4 + hh) * 256) * 64, 64, 64, kt * 64, 0,
                     p.vdf_l + (size_t)l * (2 * 4 * 64 * NKL) + (size_t)bh * (64 * NKL), 0, 0, 1, tile, 1);
      return;
    }
    r -= 32;
    {
      const float* src;
      u16* dst;
      if (r < 12) {
        const int b = r / 6, hh = r % 6;
        src = p.cache_na_k + ((size_t)((b * 2 + l) * 6 + hh) * 256) * 64;
        dst = p.kna_l + (size_t)l * (2 * 6 * NKL * 64) + (size_t)(b * 6 + hh) * (NKL * 64);
      } else {
        const int q = r - 12, b = q / 4, hh = q % 4;
        src = p.cache_df_k + ((size_t)((b * 2 + l) * 4 + hh) * 256) * 64;
        dst = p.kdf_l + (size_t)l * (2 * 4 * NKL * 64) + (size_t)(b * 4 + hh) * (NKL * 64);
      }
      float4 v[8];
#pragma unroll
      for (int i = 0; i < 8; ++i) v[i] = *(const float4*)(src + (tid + 512 * i) * 4);
#pragma unroll
      for (int i = 0; i < 8; ++i) {
        const int e = (tid + 512 * i) * 4;
        const int key = e >> 6, d4 = e & 63;
        st_bf4(dst + kf_off(key, d4 & ~7, 4) + (d4 & 7), v[i].x, v[i].y, v[i].z, v[i].w);
      }
    }
}

constexpr int P0_W_ITEMS = 160 + 12 + 6 + 64 + 176 + 176 + 176;
DI void phase_prep(const Params& p, char* lds) {
  const int tid = TIDX;
  if (BIDX == 0 && tid == 0) {
    for (int l = 0; l < 2; ++l) {
      float s1 = 0.f, s2 = 0.f;
      for (int i = 0; i < 32; ++i) {
        s1 += p.df_lq1[l * 32 + i] * p.df_lk1[l * 32 + i];
        s2 += p.df_lq2[l * 32 + i] * p.df_lk2[l * 32 + i];
      }
      p.lam[l] = expf(s1) - expf(s2) + lam_init_of(l);
    }
  }
  constexpr int NREST0 = P0_PER_LAYER - P0_MOD_PER_LAYER;
  constexpr int NREST1 = P0_PER_LAYER - P0_MOD_PER_LAYER - P0_W_ITEMS;
  for (int item = BIDX; item < 2 * P0_MOD_PER_LAYER + NREST0 + NREST1; item += gridDim.x) {
    int l, r;
    if (item < 2 * P0_MOD_PER_LAYER) { l = item / P0_MOD_PER_LAYER; r = item % P0_MOD_PER_LAYER; }
    else if (item < 2 * P0_MOD_PER_LAYER + NREST0) { l = 0; r = P0_MOD_PER_LAYER + (item - 2 * P0_MOD_PER_LAYER); }
    else { l = 1; r = P0_MOD_PER_LAYER + P0_W_ITEMS + (item - 2 * P0_MOD_PER_LAYER - NREST0); }
    prep_item(p, l, r, lds);
  }
}

DI void prep_deferred(const Params& p, char* lds, int cap) {
  const int tid = TIDX;
  volatile LAS unsigned* slot = (volatile LAS unsigned*)((LAS unsigned char*)lds + 131072 + 8);
  for (int n = 0; n < cap; ++n) {
    __syncthreads();
    if (tid == 0) *slot = atomicAdd(&p.counters[8], 1u);
    __syncthreads();
    const unsigned it = __builtin_amdgcn_readfirstlane(*slot);
    if (it >= (unsigned)P0_W_ITEMS) break;
    prep_item(p, 1, P0_MOD_PER_LAYER + (int)it, lds);
  }
}

DI void phase_norm(const Params& p, int l, int which  ) {
  const int lane = TIDX & 63, wid = TIDX >> 6;
  const float* g = (which == 0 ? p.g_mix : p.g_ffn) + l * D;
  const int nw = gridDim.x * 8;
  for (int t = BIDX * 8 + wid; t < T; t += 2 * nw) {
    const int t1 = t + nw;
    const bool has1 = t1 < T;
    const int tb = has1 ? t1 : t;
    const ResSrc xr0 = (which == 0) ? xrow_in(p, l, t) : xa_row(p, t);
    const ResSrc xr1 = (which == 0) ? xrow_in(p, l, tb) : xa_row(p, tb);
    const float* sh0 = p.mod + (size_t)((l * 3 + cond_of(t)) * 6 + (which == 0 ? 0 : 3)) * D;
    const float* sh1 = p.mod + (size_t)((l * 3 + cond_of(tb)) * 6 + (which == 0 ? 0 : 3)) * D;
    float4 v0[4], v1[4], gg[4], sa0[4], sb0[4], sa1[4], sb1[4];
#pragma unroll
    for (int i = 0; i < 4; ++i) {
      const int c = i * 256 + lane * 4;
      { const f32x4 a = res_ld4(xr0, c), b2 = res_ld4(xr1, c); v0[i] = make_float4(a[0], a[1], a[2], a[3]); v1[i] = make_float4(b2[0], b2[1], b2[2], b2[3]); }
      gg[i] = *(const float4*)(g + c);
      sb0[i] = *(const float4*)(sh0 + c); sa0[i] = *(const float4*)(sh0 + D + c);
      sb1[i] = *(const float4*)(sh1 + c); sa1[i] = *(const float4*)(sh1 + D + c);
    }
    float ss0 = 0.f, ss1 = 0.f;
#pragma unroll
    for (int i = 0; i < 4; ++i) {
      ss0 += v0[i].x * v0[i].x + v0[i].y * v0[i].y + v0[i].z * v0[i].z + v0[i].w * v0[i].w;
      ss1 += v1[i].x * v1[i].x + v1[i].y * v1[i].y + v1[i].z * v1[i].z + v1[i].w * v1[i].w;
    }
#pragma unroll
    for (int m = 1; m < 64; m <<= 1) { ss0 += __shfl_xor(ss0, m); ss1 += __shfl_xor(ss1, m); }
    const float r0 = rsqrtf(ss0 * (1.f / D) + EPS), r1 = rsqrtf(ss1 * (1.f / D) + EPS);
#pragma unroll
    for (int i = 0; i < 4; ++i) {
      const int c = i * 256 + lane * 4;
      st_bf4(p.h + (size_t)t * D + c, v0[i].x * r0 * gg[i].x * (1.f + sa0[i].x) + sb0[i].x, v0[i].y * r0 * gg[i].y * (1.f + sa0[i].y) + sb0[i].y,
             v0[i].z * r0 * gg[i].z * (1.f + sa0[i].z) + sb0[i].z, v0[i].w * r0 * gg[i].w * (1.f + sa0[i].w) + sb0[i].w);
    }
    if (has1) {
#pragma unroll
      for (int i = 0; i < 4; ++i) {
        const int c = i * 256 + lane * 4;
        st_bf4(p.h + (size_t)t1 * D + c, v1[i].x * r1 * gg[i].x * (1.f + sa1[i].x) + sb1[i].x, v1[i].y * r1 * gg[i].y * (1.f + sa1[i].y) + sb1[i].y,
               v1[i].z * r1 * gg[i].z * (1.f + sa1[i].z) + sb1[i].z, v1[i].w * r1 * gg[i].w * (1.f + sa1[i].w) + sb1[i].w);
      }
    }
  }
}

namespace pg8 {
typedef unsigned short bf16_t;
constexpr int BM = 256, BK = 64, HALF = 128, HTB = HALF * BK * 2, STAGE_BYTES = 8 * HTB, NXCD = 8, WGM = 8;
DI int lds_byte(int r, int c) { const int st = (r >> 4) * 2 + (c >> 5), rr = r & 15, cc = c & 31, ob = rr * 64 + cc * 2; return st * 1024 + (ob ^ (((ob >> 9) & 1) << 5)); }
DI void stage_rc(int b, int& R, int& C) { const int st = b / 1024, sb = b % 1024, swz = sb ^ (((sb >> 9) & 1) << 5); R = (st >> 1) * 16 + swz / 64; C = (st & 1) * 32 + (swz % 64) / 2; }
struct Unit { int pm, pn; };
struct StaticOrder {
  int nM, nN, nwg, G, c;
  DI void init(int M, int N, int G_, int c_) { nM = M / BM; nN = N / BM; nwg = nM * nN; G = G_; c = c_; }
  DI bool next(int i, Unit& u) const {
    const long L = (long)i * G + c; if (L >= nwg) return false;
    int wgid = (int)L; { const int q = nwg / NXCD, r = nwg % NXCD, xcd = wgid % NXCD, off = wgid / NXCD; wgid = (xcd < r ? xcd * (q + 1) : r * (q + 1) + (xcd - r) * q) + off; }
    const int nig = WGM * nN, gid = wgid / nig, fm = gid * WGM, gsz = (nM - fm) < WGM ? (nM - fm) : WGM;
    u.pm = fm + ((wgid % nig) % gsz); u.pn = (wgid % nig) / gsz; return true;
  }
};

template <class Epi>
DI void gemm_phase(LAS unsigned char* lds, const bf16_t* gA, const bf16_t* gBt, int M, int N, int K, const Epi& E) {
  const int tid = TIDX, wid = __builtin_amdgcn_readfirstlane(tid >> 6), lane = tid & 63, wr = wid >> 2, wc = wid & 3, fr = lane & 15, fq = lane >> 4;
  const int nt = K / BK;
  StaticOrder S; S.init(M, N, (int)gridDim.x, BIDX);
  unsigned voffA[2];
#pragma unroll
  for (int i = 0; i < 2; ++i) { int R, C; stage_rc(tid * 16 + i * 8192, R, C); voffA[i] = (unsigned)(R * K + C) * 2u; }
  const size_t kstep = (size_t)(BK * 2);
  const size_t hstep = (size_t)HALF * K * 2;
  const size_t tstep = 2 * hstep;
  const unsigned ldsw = (unsigned)wid * 1024u;
  const int aoff = lds_byte(wr * 64 + fr, fq * 8), boff = lds_byte(wc * 32 + fr, fq * 8);
#define PG8_SA(b, h) (((b) * 2 + (h)) * HTB)
#define PG8_SB(b, h) ((4 + (b) * 2 + (h)) * HTB)
#define PG8_STAGE(bufoff, gbase) do { _Pragma("unroll") for (int _i = 0; _i < 2; ++_i) \
    __builtin_amdgcn_global_load_lds((const unsigned*)((const char*)(gbase) + voffA[_i]), (LAS unsigned*)(lds + (bufoff) + ldsw + _i * 8192), 16, 0, 0); } while (0)
#define PG8_LDA(dst, b, h) do { _Pragma("unroll") for (int m = 0; m < 4; ++m) _Pragma("unroll") for (int k = 0; k < 2; ++k) dst[m][k] = *(const LAS bf16x8*)(lds + PG8_SA(b, h) + aoff + m * 2048 + k * 1024); } while (0)
#define PG8_LDB(dst, b, h) do { _Pragma("unroll") for (int n = 0; n < 2; ++n) _Pragma("unroll") for (int k = 0; k < 2; ++k) dst[n][k] = *(const LAS bf16x8*)(lds + PG8_SB(b, h) + boff + n * 2048 + k * 1024); } while (0)
#define PG8_MMA(ai, bj, At, Bt) do { __builtin_amdgcn_s_setprio(1); _Pragma("unroll") for (int m = 0; m < 4; ++m) _Pragma("unroll") for (int n = 0; n < 2; ++n) _Pragma("unroll") for (int k = 0; k < 2; ++k) \
    acc[ai][bj][m][n] = __builtin_amdgcn_mfma_f32_16x16x32_bf16(Bt[n][k], At[m][k], acc[ai][bj][m][n], 0, 0, 0); __builtin_amdgcn_s_setprio(0); } while (0)
#define PG8_WAIT_V(n) asm volatile("s_waitcnt vmcnt(" #n ")" ::: "memory")
#define PG8_WAIT_L(n) asm volatile("s_waitcnt lgkmcnt(" #n ")" ::: "memory")
#define PG8_BAR __builtin_amdgcn_s_barrier()
#define PG8_SCHED __builtin_amdgcn_sched_barrier(0)
  Unit cur, nxt; int ui = 0;
  if (!S.next(0, cur)) return;
  f32x4 acc[2][2][4][2];
#pragma unroll
  for (int a = 0; a < 2; ++a)
#pragma unroll
    for (int b = 0; b < 2; ++b)
#pragma unroll
      for (int m = 0; m < 4; ++m)
#pragma unroll
        for (int n = 0; n < 2; ++n) acc[a][b][m][n] = (f32x4){0.f, 0.f, 0.f, 0.f};
  bf16x8 At[4][2], B0[2][2], B1[2][2];
  const char* cA = (const char*)gA + (size_t)cur.pm * tstep; const char* cB = (const char*)gBt + (size_t)cur.pn * tstep;
  PG8_STAGE(PG8_SB(0, 0), cB); PG8_STAGE(PG8_SA(0, 0), cA); PG8_STAGE(PG8_SB(0, 1), cB + hstep); PG8_STAGE(PG8_SA(0, 1), cA + hstep);
  if (wr == 1) PG8_BAR;
  PG8_WAIT_V(4); PG8_BAR;
  PG8_STAGE(PG8_SB(1, 0), cB + kstep); PG8_STAGE(PG8_SA(1, 0), cA + kstep); PG8_STAGE(PG8_SB(1, 1), cB + hstep + kstep);
  PG8_WAIT_V(6); PG8_BAR;
  for (;;) {
    const bool has_next = S.next(ui + 1, nxt);
    const char* nA = has_next ? (const char*)gA + (size_t)nxt.pm * tstep : cA; const char* nB = has_next ? (const char*)gBt + (size_t)nxt.pn * tstep : cB;
    for (int t = 0; t < nt; t += 2) {
      const bool last = (t == nt - 2);
      const char* a1 = cA + (size_t)(t + 1) * kstep;
      const char* a2 = last ? nA : cA + (size_t)(t + 2) * kstep; const char* b2 = last ? nB : cB + (size_t)(t + 2) * kstep;
      const char* a3 = a2 + kstep; const char* b3 = b2 + kstep;
      PG8_LDB(B0, 0, 0); PG8_SCHED; PG8_LDA(At, 0, 0); PG8_STAGE(PG8_SA(1, 1), a1 + hstep);
      PG8_WAIT_L(8); PG8_BAR; PG8_WAIT_L(0); PG8_MMA(0, 0, At, B0); PG8_BAR; PG8_SCHED;
      PG8_LDB(B1, 0, 1); PG8_STAGE(PG8_SB(0, 0), b2);
      PG8_BAR; PG8_WAIT_L(0); PG8_MMA(0, 1, At, B1); PG8_BAR;
      PG8_LDA(At, 0, 1); PG8_STAGE(PG8_SA(0, 0), a2);
      PG8_BAR; PG8_WAIT_L(0); PG8_MMA(1, 0, At, B0); PG8_BAR; PG8_SCHED;
      PG8_STAGE(PG8_SB(0, 1), b2 + hstep);
      PG8_WAIT_V(6); PG8_BAR; PG8_MMA(1, 1, At, B1); PG8_BAR;
      PG8_LDB(B0, 1, 0); PG8_SCHED; PG8_LDA(At, 1, 0); PG8_STAGE(PG8_SA(0, 1), a2 + hstep);
      PG8_WAIT_L(8); PG8_BAR; PG8_WAIT_L(0); PG8_MMA(0, 0, At, B0); PG8_BAR; PG8_SCHED;
      PG8_LDB(B1, 1, 1); PG8_STAGE(PG8_SB(1, 0), b3);
      PG8_BAR; PG8_WAIT_L(0); PG8_MMA(0, 1, At, B1); PG8_BAR;
      PG8_LDA(At, 1, 1); PG8_STAGE(PG8_SA(1, 0), a3);
      PG8_BAR; PG8_WAIT_L(0); PG8_MMA(1, 0, At, B0); PG8_BAR; PG8_SCHED;
      PG8_STAGE(PG8_SB(1, 1), b3 + hstep);
      PG8_WAIT_V(6); PG8_BAR; PG8_MMA(1, 1, At, B1); PG8_BAR;
    }
    {
      int fr2 = fr, fq2 = fq; Unit cu = cur;
      asm volatile("" : "+v"(fr2), "+v"(fq2), "+s"(cu.pm), "+s"(cu.pn));
      E(acc, cu, wr, wc, fr2, fq2);
    }
    if (!has_next) break;
#pragma unroll
    for (int a = 0; a < 2; ++a)
#pragma unroll
      for (int b = 0; b < 2; ++b)
#pragma unroll
        for (int m = 0; m < 4; ++m)
#pragma unroll
          for (int n = 0; n < 2; ++n) acc[a][b][m][n] = (f32x4){0.f, 0.f, 0.f, 0.f};
    cur = nxt; cA = nA; cB = nB; ++ui;
  }
  PG8_WAIT_V(0);
  if (wr == 0) PG8_BAR;
  PG8_BAR;
#undef PG8_SA
#undef PG8_SB
#undef PG8_STAGE
#undef PG8_LDA
#undef PG8_LDB
#undef PG8_MMA
#undef PG8_WAIT_V
#undef PG8_WAIT_L
#undef PG8_BAR
#undef PG8_SCHED
}
}

typedef f32x4 AccT[2][2][4][2];
DI void st_nt4(float* p_, f32x4 v_) { __builtin_nontemporal_store(v_, (f32x4*)p_); }
DI float dot4(f32x4 a) { return a[0] * a[0] + a[1] * a[1] + a[2] * a[2] + a[3] * a[3]; }
DI float rowsum_q(float v) { v += __shfl_xor(v, 16); v += __shfl_xor(v, 32); return v; }
DI void st_bf8(u16* p, f32x4 a, f32x4 b) {
  u32x4 w; w.x = cvtpk(a[0], a[1]); w.y = cvtpk(a[2], a[3]); w.z = cvtpk(b[0], b[1]); w.w = cvtpk(b[2], b[3]);
  *(u32x4*)p = w;
}

struct EpiIn {
  const Params& p; int l;
  DI void operator()(const AccT& acc, const pg8::Unit& u, int wr, int wc, int fr, int fq) const {
    const int wcb = u.pn * 4 + wc;
    if (wcb > 36) return;
    const bool is_ctx = u.pm < 32;
    const int r0 = u.pm * 256 + wr * 64 + fr;
    int b, s0;
    if (is_ctx) { b = u.pm; s0 = wr * 64 + fr; }
    else { const int tl = r0 - TCTX; b = tl >> 10; s0 = tl & 1023; }
    const int c8 = 8 * fq;
    if (wcb < 4) {
#pragma unroll
      for (int ai = 0; ai < 2; ++ai)
#pragma unroll
        for (int m = 0; m < 4; ++m) {
          asm volatile("" ::: "memory");
          float* rp = p.cq + (size_t)(r0 + ai * 128 + m * 16) * 256 + wcb * 64 + c8;
#pragma unroll
          for (int bj = 0; bj < 2; ++bj)
#pragma unroll
            for (int n = 0; n < 2; ++n) *(f32x4*)(rp + bj * 32 + 4 * n) = acc[ai][bj][m][n];
        }
    } else if (wcb < 6) {
#pragma unroll
      for (int ai = 0; ai < 2; ++ai)
#pragma unroll
        for (int m = 0; m < 4; ++m) {
          asm volatile("" ::: "memory");
          float* rp = p.ckv + (size_t)(r0 + ai * 128 + m * 16) * 128 + (wcb - 4) * 64 + c8;
#pragma unroll
          for (int bj = 0; bj < 2; ++bj)
#pragma unroll
            for (int n = 0; n < 2; ++n) *(f32x4*)(rp + bj * 32 + 4 * n) = acc[ai][bj][m][n];
        }
    } else if (wcb < 18) {
      const bool isq = wcb < 12;
      const int hd = isq ? wcb - 6 : wcb - 12;
      const float* g = (isq ? p.g_na_q : p.g_na_k) + l * 64 + c8;
      f32x4 gv[2][2];
#pragma unroll
      for (int bj = 0; bj < 2; ++bj)
#pragma unroll
        for (int n = 0; n < 2; ++n) gv[bj][n] = *(const f32x4*)(g + bj * 32 + 4 * n);
#pragma unroll
      for (int ai = 0; ai < 2; ++ai)
#pragma unroll
        for (int m = 0; m < 4; ++m) {
          asm volatile("" ::: "memory");
          float ss = dot4(acc[ai][0][m][0]) + dot4(acc[ai][0][m][1]) + dot4(acc[ai][1][m][0]) + dot4(acc[ai][1][m][1]);
          ss = rowsum_q(ss);
          const float rstd = rsqrtf(ss * (1.f / 64.f) + EPS) * (isq ? 0.18033688011112042f : 1.f);
          const int t = r0 + ai * 128 + m * 16, s = s0 + ai * 128 + m * 16;
          f32x4 v[2][2];
#pragma unroll
          for (int bj = 0; bj < 2; ++bj)
#pragma unroll
            for (int n = 0; n < 2; ++n) v[bj][n] = acc[ai][bj][m][n] * rstd * gv[bj][n];
          if (isq) {
            u16* qp = p.qna + (size_t)t * 384 + hd * 64 + c8;
            st_bf8(qp, v[0][0], v[0][1]); st_bf8(qp + 32, v[1][0], v[1][1]);
          } else if (is_ctx) {
            float* op = p.out + OUT_NAK + ((size_t)((b * 2 + l) * 6 + hd) * 256 + s) * 64 + c8;
            st_nt4(op, v[0][0]); st_nt4(op + 4, v[0][1]); st_nt4(op + 32, v[1][0]); st_nt4(op + 36, v[1][1]);
            u16* kp = p.kna_c + (size_t)(b * 6 + hd) * (256 * 64);
            st_bf8(kp + kf_off(s, c8, 4), v[0][0], v[0][1]); st_bf8(kp + kf_off(s, 32 + c8, 4), v[1][0], v[1][1]);
          } else {
            u16* kp = p.kna_l + (size_t)l * (2 * 6 * NKL * 64) + (size_t)(b * 6 + hd) * (NKL * 64);
            st_bf8(kp + kf_off(256 + s, c8, 4), v[0][0], v[0][1]); st_bf8(kp + kf_off(256 + s, 32 + c8, 4), v[1][0], v[1][1]);
          }
        }
    } else if (wcb < 24 || (wcb >= 32 && wcb < 36)) {
      const bool isna = wcb < 24;
      const int hd = isna ? wcb - 18 : wcb - 32;
      const int nh = isna ? 6 : 4;
      const int vh = isna ? hd : 6 + hd;
      float* ob = p.out + (isna ? OUT_NAV : OUT_DFV) + ((size_t)((b * 2 + l) * nh + hd) * 256) * 64 + c8;
      u16* vb = is_ctx ? (isna ? p.vna_c : p.vdf_c) + (size_t)(b * nh + hd) * (64 * 256)
                       : (isna ? p.vna_l : p.vdf_l) + (size_t)l * (2 * nh * 64 * NKL) + (size_t)(b * nh + hd) * (64 * NKL);
      (void)vh;
#pragma unroll
      for (int ai = 0; ai < 2; ++ai)
#pragma unroll
        for (int m = 0; m < 4; ++m) {
          asm volatile("" ::: "memory");
          const int s = s0 + ai * 128 + m * 16;
          u16* vk = vb + vf_off((is_ctx ? 0 : 256) + s, c8);
#pragma unroll
          for (int bj = 0; bj < 2; ++bj)
#pragma unroll
            for (int n = 0; n < 2; ++n) {
              const unsigned lo = cvtpk(acc[ai][bj][m][n][0], acc[ai][bj][m][n][1]), hi = cvtpk(acc[ai][bj][m][n][2], acc[ai][bj][m][n][3]);
              u16* q = vk + bj * 512 + n * 32;
              q[0] = (u16)(lo & 0xffffu); q[8] = (u16)(lo >> 16); q[16] = (u16)(hi & 0xffffu); q[24] = (u16)(hi >> 16);
            }
          if (is_ctx) {
            float* op = ob + (size_t)s * 64;
            st_nt4(op, acc[ai][0][m][0]); st_nt4(op + 4, acc[ai][0][m][1]); st_nt4(op + 32, acc[ai][1][m][0]); st_nt4(op + 36, acc[ai][1][m][1]);
          }
        }
    } else if (wcb < 32) {
      const bool isq = wcb < 28;
      const int hd = isq ? wcb - 24 : wcb - 28;
      const float* g = (isq ? p.g_df_q : p.g_df_k) + l * 32 + c8;
      const f32x4 g0 = *(const f32x4*)(g), g1 = *(const f32x4*)(g + 4);
      const int ra = fq >> 1, half = fq & 1;
#pragma unroll
      for (int ai = 0; ai < 2; ++ai)
#pragma unroll
        for (int m = 0; m < 4; ++m) {
          asm volatile("" ::: "memory");
          const int t = r0 + ai * 128 + m * 16, s = s0 + ai * 128 + m * 16;
          f32x4 v[2][2];
#pragma unroll
          for (int bj = 0; bj < 2; ++bj) {
            float ss = dot4(acc[ai][bj][m][0]) + dot4(acc[ai][bj][m][1]);
            ss = rowsum_q(ss);
            const float rstd = rsqrtf(ss * (1.f / 32.f) + EPS) * (isq ? 0.25503486164919736f : 1.f);
            v[bj][0] = acc[ai][bj][m][0] * rstd * g0;
            v[bj][1] = acc[ai][bj][m][1] * rstd * g1;
          }
          if (!is_ctx) {
            const float pos = ra ? (float)(s & 63) : (float)(s >> 6);
#pragma unroll
            for (int bj = 0; bj < 2; ++bj)
#pragma unroll
              for (int n = 0; n < 2; ++n)
#pragma unroll
                for (int e = 0; e < 4; ++e) {
                  const int i = 4 * n + e;
                  const float inv = (i == 0) ? 1.0f : (i == 1) ? 0.31622776601683794f : (i == 2) ? 0.1f : (i == 3) ? 0.031622776601683794f
                                  : (i == 4) ? 0.01f : (i == 5) ? 0.0031622776601683794f : (i == 6) ? 0.001f : 0.00031622776601683794f;
                  const float ang = pos * inv;
                  const float cs = __cosf(ang), sn = __sinf(ang);
                  const float x = v[bj][n][e];
                  const float partner = __shfl_xor(x, 16);
                  v[bj][n][e] = x * cs + (half ? partner : -partner) * sn;
                }
          }
          if (isq) {
            u16* qp = p.qdf + (size_t)t * 256 + hd * 64 + c8;
            st_bf8(qp, v[0][0], v[0][1]); st_bf8(qp + 32, v[1][0], v[1][1]);
          } else if (is_ctx) {
            float* op = p.out + OUT_DFK + ((size_t)((b * 2 + l) * 4 + hd) * 256 + s) * 64 + c8;
            st_nt4(op, v[0][0]); st_nt4(op + 4, v[0][1]); st_nt4(op + 32, v[1][0]); st_nt4(op + 36, v[1][1]);
            u16* kp = p.kdf_c + (size_t)(b * 4 + hd) * (256 * 64);
            st_bf8(kp + kf_off(s, c8, 4), v[0][0], v[0][1]); st_bf8(kp + kf_off(s, 32 + c8, 4), v[1][0], v[1][1]);
          } else {
            u16* kp = p.kdf_l + (size_t)l * (2 * 4 * NKL * 64) + (size_t)(b * 4 + hd) * (NKL * 64);
            st_bf8(kp + kf_off(256 + s, c8, 4), v[0][0], v[0][1]); st_bf8(kp + kf_off(256 + s, 32 + c8, 4), v[1][0], v[1][1]);
          }
        }
    } else {
#pragma unroll
      for (int ai = 0; ai < 2; ++ai)
#pragma unroll
        for (int m = 0; m < 4; ++m) {
          asm volatile("" ::: "memory");
          const int t = r0 + ai * 128 + m * 16, s = s0 + ai * 128 + m * 16;
          float* kp = p.krope + (size_t)t * 32 + c8;
          *(f32x4*)(kp) = acc[ai][0][m][0]; *(f32x4*)(kp + 4) = acc[ai][0][m][1];
          if (is_ctx) {
            float* op = p.out + OUT_KROPE + ((size_t)(b * 2 + l) * 256 + s) * 32 + c8;
            st_nt4(op, acc[ai][0][m][0]); st_nt4(op + 4, acc[ai][0][m][1]);
          }
        }
    }
  }
};

template <int WHICH  >
struct EpiRes {
  const Params& p; int l;
  DI void operator()(const AccT& acc, const pg8::Unit& u, int wr, int wc, int fr, int fq) const {
    const int cond = u.pm < 32 ? 0 : 1 + ((u.pm - 32) >> 2);
    const int c0 = u.pn * 256 + wc * 64 + 8 * fq;
    const float* gate = p.mod + (size_t)((l * 3 + cond) * 6 + (WHICH == 0 ? 2 : 5)) * D + c0;
    f32x4 gv[2][2];
#pragma unroll
    for (int bj = 0; bj < 2; ++bj)
#pragma unroll
      for (int n = 0; n < 2; ++n) gv[bj][n] = *(const f32x4*)(gate + bj * 32 + 4 * n);
    u16* dsth = (WHICH == 0) ? p.xa : p.xb;
    const bool to_out = (WHICH == 1 && l == 1);
#pragma unroll
    for (int ai = 0; ai < 2; ++ai)
#pragma unroll
      for (int mh = 0; mh < 2; ++mh) {
        f32x4 xi[2][2][2];
#pragma unroll
        for (int mm = 0; mm < 2; ++mm) {
          const int m = mh * 2 + mm;
          const int t = u.pm * 256 + ai * 128 + wr * 64 + m * 16 + fr;
          const ResSrc xin = (WHICH == 0) ? xrow_in(p, l, t) : xa_row(p, t);
#pragma unroll
          for (int bj = 0; bj < 2; ++bj)
#pragma unroll
            for (int n = 0; n < 2; ++n) xi[mm][bj][n] = res_ld4(xin, c0 + bj * 32 + 4 * n);
        }
#pragma unroll
        for (int mm = 0; mm < 2; ++mm) {
          const int m = mh * 2 + mm;
          const int t = u.pm * 256 + ai * 128 + wr * 64 + m * 16 + fr;
          if (to_out) {
            float* xo = p.out + (size_t)t * D + c0;
#pragma unroll
            for (int bj = 0; bj < 2; ++bj)
#pragma unroll
              for (int n = 0; n < 2; ++n) st_nt4(xo + bj * 32 + 4 * n, xi[mm][bj][n] + gv[bj][n] * acc[ai][bj][m][n]);
          } else {
            u16* xo = dsth + (size_t)t * D + c0;
#pragma unroll
            for (int bj = 0; bj < 2; ++bj)
              st_bf8(xo + bj * 32, xi[mm][bj][0] + gv[bj][0] * acc[ai][bj][m][0], xi[mm][bj][1] + gv[bj][1] * acc[ai][bj][m][1]);
          }
        }
      }
  }
};

struct EpiGU {
  const Params& p;
  DI void operator()(const AccT& acc, const pg8::Unit& u, int wr, int wc, int fr, int fq) const {
    const int f0 = u.pn * 128 + wc * 32 + 8 * fq;
#pragma unroll
    for (int ai = 0; ai < 2; ++ai)
#pragma unroll
      for (int m = 0; m < 4; ++m) {
        const int t = u.pm * 256 + ai * 128 + wr * 64 + m * 16 + fr;
        f32x4 o[2];
#pragma unroll
        for (int n = 0; n < 2; ++n)
#pragma unroll
          for (int e = 0; e < 4; ++e) {
            const float gvv = acc[ai][0][m][n][e], uv = acc[ai][1][m][n][e];
            o[n][e] = gvv / (1.f + __expf(-gvv)) * uv;
          }
        st_bf8(p.act + (size_t)t * DFF + f0, o[0], o[1]);
      }
  }
};

DI void mla_q_load(const Params& p, int l, int tb, bf16x8 (&bfr)[16], float& rstd) {
  const int lane = TIDX & 63, l31 = lane & 31, hh = lane >> 5;
  const int tok = tb * 32 + l31;
  const float* cqrow = p.cq + (size_t)tok * 256;
  const float* gq = p.g_qa + l * 256;
  float ss = 0.f;
#pragma unroll
  for (int ks = 0; ks < 16; ++ks) {
    const int k = ks * 16 + 8 * hh;
    const float4 a = *(const float4*)(cqrow + k), b2 = *(const float4*)(cqrow + k + 4);
    const float4 ga = *(const float4*)(gq + k), gb = *(const float4*)(gq + k + 4);
    ss += a.x * a.x + a.y * a.y + a.z * a.z + a.w * a.w + b2.x * b2.x + b2.y * b2.y + b2.z * b2.z + b2.w * b2.w;
    bfr[ks] = pack8(a.x * ga.x, a.y * ga.y, a.z * ga.z, a.w * ga.w, b2.x * gb.x, b2.y * gb.y, b2.z * gb.z, b2.w * gb.w);
  }
  ss += __shfl_xor(ss, 32);
  rstd = rsqrtf(ss * (1.f / 256.f) + EPS);
}

DI void mla_q_compute(const Params& p, int l, int tb, int h, const LAS unsigned char* wl, const bf16x8 (&bfr)[16], float rstd) {
  const int lane = TIDX & 63, l31 = lane & 31, hh = lane >> 5;
  const int tok = tb * 32 + l31;
  float4 gq2[3][4];
#pragma unroll
  for (int nt = 0; nt < 3; ++nt)
#pragma unroll
    for (int gi = 0; gi < 4; ++gi) gq2[nt][gi] = *(const float4*)(p.g_mla_q + l * 96 + nt * 32 + 8 * gi + 4 * hh);
  f32x16 acc[3];
  const LAS unsigned char* W = wl + lane * 16;
#pragma unroll
  for (int nt = 0; nt < 3; ++nt) {
#pragma unroll
    for (int r = 0; r < 16; ++r) acc[nt][r] = 0.f;
#pragma unroll
    for (int ks = 0; ks < 16; ++ks) {
      const bf16x8 wf = *(const LAS bf16x8*)(W + (nt * 16 + ks) * 1024);
      acc[nt] = mfma32(wf, bfr[ks], acc[nt]);
    }
  }
  float s2 = 0.f;
#pragma unroll
  for (int nt = 0; nt < 3; ++nt)
#pragma unroll
    for (int r = 0; r < 16; ++r) { acc[nt][r] *= rstd; s2 += acc[nt][r] * acc[nt][r]; }
  s2 += __shfl_xor(s2, 32);
  const float rstd2 = rsqrtf(s2 * (1.f / 96.f) + EPS) * 0.14724444602590306f;
#pragma unroll
  for (int nt = 0; nt < 3; ++nt)
#pragma unroll
    for (int gi = 0; gi < 4; ++gi) {
      const float4 gg = gq2[nt][gi];
      acc[nt][4 * gi + 0] *= rstd2 * gg.x; acc[nt][4 * gi + 1] *= rstd2 * gg.y;
      acc[nt][4 * gi + 2] *= rstd2 * gg.z; acc[nt][4 * gi + 3] *= rstd2 * gg.w;
    }
  if (tok >= TCTX) rope32(acc[2], (tok - TCTX) & 1023, hh);
  u16* qo = p.qmla + (size_t)tok * 576 + h * 96 + 4 * hh;
#pragma unroll
  for (int nt = 0; nt < 3; ++nt)
#pragma unroll
    for (int gi = 0; gi < 4; ++gi)
      st_bf4(qo + nt * 32 + 8 * gi, acc[nt][4 * gi], acc[nt][4 * gi + 1], acc[nt][4 * gi + 2], acc[nt][4 * gi + 3]);
}

struct KvRow { const float* csrc; const float* krsrc; int b, s; bool is_tok, is_ctx; };
DI KvRow kv_row(const Params& p, int l, int rb) {
  const int lane = TIDX & 63, l31 = lane & 31;
  const int row = rb * 32 + l31;
  KvRow r;
  r.is_tok = row < T;
  r.is_ctx = row < TCTX;
  if (r.is_tok) {
    r.csrc = p.ckv + (size_t)row * 128;
    r.krsrc = p.krope + (size_t)row * 32;
    if (r.is_ctx) { r.b = row >> 8; r.s = row & 255; }
    else { r.b = (row - TCTX) >> 10; r.s = (row - TCTX) & 1023; }
  } else {
    const int rr = row - T;
    r.b = rr >> 8; r.s = rr & 255;
    r.csrc = p.cache_mla_ckv + ((size_t)(r.b * 2 + l) * 256 + r.s) * 128;
    r.krsrc = p.cache_mla_krope + ((size_t)(r.b * 2 + l) * 256 + r.s) * 32;
  }
  return r;
}

DI void mla_kv_load(const Params& p, int l, int rb, bf16x8 (&bfr)[8], float& rstd) {
  const int lane = TIDX & 63, hh = lane >> 5;
  const KvRow R = kv_row(p, l, rb);
  const float* gk = p.g_kva + l * 128;
  float ss = 0.f;
#pragma unroll
  for (int ks = 0; ks < 8; ++ks) {
    const int k = ks * 16 + 8 * hh;
    const float4 a = *(const float4*)(R.csrc + k), b2 = *(const float4*)(R.csrc + k + 4);
    float4 ga = make_float4(1.f, 1.f, 1.f, 1.f), gb = ga;
    if (R.is_tok) { ga = *(const float4*)(gk + k); gb = *(const float4*)(gk + k + 4); }
    ss += a.x * a.x + a.y * a.y + a.z * a.z + a.w * a.w + b2.x * b2.x + b2.y * b2.y + b2.z * b2.z + b2.w * b2.w;
    bfr[ks] = pack8(a.x * ga.x, a.y * ga.y, a.z * ga.z, a.w * ga.w, b2.x * gb.x, b2.y * gb.y, b2.z * gb.z, b2.w * gb.w);
  }
  ss += __shfl_xor(ss, 32);
  rstd = R.is_tok ? rsqrtf(ss * (1.f / 128.f) + EPS) : 1.f;
}

DI void mla_kv_compute(const Params& p, int l, int rb, int h, const LAS unsigned char* wl, const bf16x8 (&bfr)[8], float rstd) {
  const int lane = TIDX & 63, hh = lane >> 5;
  const KvRow R = kv_row(p, l, rb);
  const bool is_tok = R.is_tok, is_ctx = R.is_ctx;
  const int b = R.b, s = R.s;
  const float* gk = p.g_kva + l * 128;
  f32x16 kr;
#pragma unroll
  for (int gi = 0; gi < 4; ++gi) {
    const float4 v = *(const float4*)(R.krsrc + 8 * gi + 4 * hh);
    kr[4 * gi] = v.x; kr[4 * gi + 1] = v.y; kr[4 * gi + 2] = v.z; kr[4 * gi + 3] = v.w;
  }
  const float* g = p.g_mla_k + l * 96;
  float4 gk0[4], gk1[4], gk2[4];
#pragma unroll
  for (int gi = 0; gi < 4; ++gi) {
    gk0[gi] = *(const float4*)(g + 8 * gi + 4 * hh); gk1[gi] = *(const float4*)(g + 32 + 8 * gi + 4 * hh); gk2[gi] = *(const float4*)(g + 64 + 8 * gi + 4 * hh);
  }
  f32x16 acc[4];
  const LAS unsigned char* W = wl + lane * 16;
#pragma unroll
  for (int nt = 0; nt < 4; ++nt) {
#pragma unroll
    for (int r = 0; r < 16; ++r) acc[nt][r] = 0.f;
#pragma unroll
    for (int ks = 0; ks < 8; ++ks) {
      const bf16x8 wf = *(const LAS bf16x8*)(W + (nt * 8 + ks) * 1024);
      acc[nt] = mfma32(wf, bfr[ks], acc[nt]);
    }
  }
  float sk = 0.f;
#pragma unroll
  for (int nt = 0; nt < 4; ++nt)
#pragma unroll
    for (int r = 0; r < 16; ++r) acc[nt][r] *= rstd;
#pragma unroll
  for (int r = 0; r < 16; ++r) sk += acc[0][r] * acc[0][r] + acc[1][r] * acc[1][r] + kr[r] * kr[r];
  sk += __shfl_xor(sk, 32);
  const float rstdk = rsqrtf(sk * (1.f / 96.f) + EPS);
#pragma unroll
  for (int gi = 0; gi < 4; ++gi) {
    const float4 g0 = gk0[gi], g1 = gk1[gi], g2 = gk2[gi];
    acc[0][4 * gi] *= rstdk * g0.x; acc[0][4 * gi + 1] *= rstdk * g0.y; acc[0][4 * gi + 2] *= rstdk * g0.z; acc[0][4 * gi + 3] *= rstdk * g0.w;
    acc[1][4 * gi] *= rstdk * g1.x; acc[1][4 * gi + 1] *= rstdk * g1.y; acc[1][4 * gi + 2] *= rstdk * g1.z; acc[1][4 * gi + 3] *= rstdk * g1.w;
    kr[4 * gi] *= rstdk * g2.x; kr[4 * gi + 1] *= rstdk * g2.y; kr[4 * gi + 2] *= rstdk * g2.z; kr[4 * gi + 3] *= rstdk * g2.w;
  }
  if (is_tok && !is_ctx) rope32(kr, s, hh);
  u16 *kd, *vd;
  int kidx;
  if (is_ctx) {
    kidx = s;
    kd = p.kmla_c + (size_t)(b * 6 + h) * (256 * 96);
    vd = p.vmla_c + (size_t)(b * 6 + h) * (64 * 256);
  } else {
    kidx = is_tok ? 256 + s : s;
    kd = p.kmla_l + (size_t)l * (2 * 6 * NKL * 96) + (size_t)(b * 6 + h) * (NKL * 96);
    vd = p.vmla_l + (size_t)l * (2 * 6 * 64 * NKL) + (size_t)(b * 6 + h) * (64 * NKL);
  }
#pragma unroll
  for (int gi = 0; gi < 4; ++gi) {
    st_bf4(kd + kf_off(kidx, 8 * gi, 6) + 4 * hh, acc[0][4 * gi], acc[0][4 * gi + 1], acc[0][4 * gi + 2], acc[0][4 * gi + 3]);
    st_bf4(kd + kf_off(kidx, 32 + 8 * gi, 6) + 4 * hh, acc[1][4 * gi], acc[1][4 * gi + 1], acc[1][4 * gi + 2], acc[1][4 * gi + 3]);
    st_bf4(kd + kf_off(kidx, 64 + 8 * gi, 6) + 4 * hh, kr[4 * gi], kr[4 * gi + 1], kr[4 * gi + 2], kr[4 * gi + 3]);
  }
#pragma unroll
  for (int nt = 0; nt < 2; ++nt)
#pragma unroll
    for (int r = 0; r < 16; ++r) {
      const int d = nt * 32 + (r & 3) + 8 * (r >> 2) + 4 * hh;
      vd[vf_off(kidx, d)] = f2bf(acc[2 + nt][r]);
    }
  if (is_ctx && h == 0) {
    float* ob = p.out + OUT_CKV + ((size_t)(b * 2 + l) * 256 + s) * 128;
    float4 oa[8], obv[8];
#pragma unroll
    for (int ks = 0; ks < 8; ++ks) {
      const int k = ks * 16 + 8 * hh;
      const float4 a = *(const float4*)(R.csrc + k), b2 = *(const float4*)(R.csrc + k + 4);
      const float4 ga = *(const float4*)(gk + k), gb = *(const float4*)(gk + k + 4);
      oa[ks] = make_float4(a.x * rstd * ga.x, a.y * rstd * ga.y, a.z * rstd * ga.z, a.w * rstd * ga.w);
      obv[ks] = make_float4(b2.x * rstd * gb.x, b2.y * rstd * gb.y, b2.z * rstd * gb.z, b2.w * rstd * gb.w);
    }
#pragma unroll
    for (int ks = 0; ks < 8; ++ks) {
      const int k = ks * 16 + 8 * hh;
      st_nt4(ob + k, (f32x4){oa[ks].x, oa[ks].y, oa[ks].z, oa[ks].w});
      st_nt4(ob + k + 4, (f32x4){obv[ks].x, obv[ks].y, obv[ks].z, obv[ks].w});
    }
  }
}

DI void phase_mla_up(const Params& p, int l, char* lds) {
  const int tid = TIDX, lane = tid & 63, w = __builtin_amdgcn_readfirstlane(tid >> 6);
  LAS unsigned char* ldsl = (LAS unsigned char*)lds;
  const int nslot = ((int)gridDim.x + 7) >> 3;
  for (int it0 = (BIDX & 7) * nslot + (BIDX >> 3); it0 < 252 + 8 * nslot; it0 += 8 * nslot) {
    const int item = it0;
    if (item >= 252 || (BIDX >> 3) >= nslot) break;
    __syncthreads();
    const bool hasq = item < 240;
    const int h = item % 6, grp = item / 6;
    if (hasq) {
      const u16* wsrc = p.wuq_t + (size_t)l * 576 * 256 + (size_t)(h * 3) * (16 * 512) + lane * 8;
#pragma unroll
      for (int i = 0; i < 6; ++i) {
        const int blk = w + 8 * i;
        __builtin_amdgcn_global_load_lds((const unsigned*)(wsrc + blk * 512), (LAS unsigned*)(ldsl + blk * 1024), 16, 0, 0);
      }
    }
    {
      const u16* wsrc = p.wukv_t + (size_t)l * 768 * 128 + (size_t)(h * 4) * (8 * 512) + lane * 8;
#pragma unroll
      for (int i = 0; i < 4; ++i) {
        const int blk = w + 8 * i;
        __builtin_amdgcn_global_load_lds((const unsigned*)(wsrc + blk * 512), (LAS unsigned*)(ldsl + 49152 + blk * 1024), 16, 0, 0);
      }
    }
    bf16x8 bq[16], bk[8];
    float rq = 1.f, rk = 1.f;
    if (hasq) mla_q_load(p, l, grp * 8 + w, bq, rq);
    mla_kv_load(p, l, grp * 8 + w, bk, rk);
    asm volatile("s_waitcnt vmcnt(0)" ::: "memory");
    __syncthreads();
    if (hasq) mla_q_compute(p, l, grp * 8 + w, h, ldsl, bq, rq);
    mla_kv_compute(p, l, grp * 8 + w, h, ldsl + 49152, bk, rk);
  }
}

constexpr int ATT_NST = 8, ATT_STB = 10240, ATT_RPB_OFF = ATT_NST * ATT_STB;
#define ATT_BAR() do { __builtin_amdgcn_s_barrier(); asm volatile("" ::: "memory"); } while (0)

template <int NDK>
DI void att_issue(LAS unsigned char* lds, const u16* Kb, const u16* Vb, int kt, int st, int w, int lane) {
#pragma unroll
  for (int i = 0; i < 2; ++i) {
    const int j = w + 8 * i;
    if (j < NDK + 4) {
      const u16* src = (j < NDK) ? Kb + (size_t)kt * (NDK * 512) + j * 512 : Vb + (size_t)kt * 2048 + (j - NDK) * 512;
      const int dst = st * ATT_STB + ((j < NDK) ? j * 1024 : 6144 + (j - NDK) * 1024);
      __builtin_amdgcn_global_load_lds((const unsigned*)(src + lane * 8), (LAS unsigned*)(lds + dst), 16, 0, 0);
    }
  }
}

template <int DQK, int MODE>
DI void attn_block_single(LAS unsigned char* lds, const u16* __restrict__ Kb, const u16* __restrict__ Vb, const u16* __restrict__ qrow,
                          u16* __restrict__ orow, float scale, int ntiles, int r, int qc, int rs0) {
  const int tid = TIDX, lane = tid & 63, w = __builtin_amdgcn_readfirstlane(tid >> 6), hh = lane >> 5;
  constexpr int NDK = DQK / 16;
  const int nl = (w + 8 < NDK + 4) ? 2 : 1;
#define ATT_KT(t_) ((MODE == 1 && (t_) >= 8) ? 8 + (rs0 + (((t_) - 8) >> 1)) * 2 + (((t_) - 8) & 1) : (t_))
  for (int tt = 0; tt < ATT_NST - 1; ++tt) { const int tc = min(tt, ntiles - 1); att_issue<NDK>(lds, Kb, Vb, ATT_KT(tc), tt, w, lane); }
  bf16x8 qf[NDK];
#pragma unroll
  for (int dk = 0; dk < NDK; ++dk) qf[dk] = *(const bf16x8*)(qrow + dk * 16 + 8 * hh);
#pragma unroll
  for (int dk = 0; dk < NDK; ++dk) asm volatile("" :: "v"(qf[dk]));
  f32x16 o0, o1;
#pragma unroll
  for (int i = 0; i < 16; ++i) { o0[i] = 0.f; o1[i] = 0.f; }
  float mrun = -1e30f, lsum = 0.f;
  int rs = 0, cs = 0;
  if (MODE == 1) { rs = min(max(r - 4, 0), 8); cs = min(max(qc - 8, 0), 48); }
  const LAS float* rpbl = (const LAS float*)(lds + ATT_RPB_OFF);
  for (int t = 0; t < ntiles; ++t) {
    if (nl == 2) asm volatile("s_waitcnt vmcnt(12)" ::: "memory"); else asm volatile("s_waitcnt vmcnt(6)" ::: "memory");
    ATT_BAR();
    { const int tn = min(t + ATT_NST - 1, ntiles - 1); att_issue<NDK>(lds, Kb, Vb, ATT_KT(tn), (t + ATT_NST - 1) & (ATT_NST - 1), w, lane); }
    int jr = 0, ct = 0;
    if (MODE == 1 && t >= 8) {
      jr = rs0 + ((t - 8) >> 1) - rs; ct = (t - 8) & 1;
      if (jr < 0 || jr > 7) continue;
    }
    const LAS unsigned char* sp = lds + (t & (ATT_NST - 1)) * ATT_STB + lane * 16;
    f32x16 s;
#pragma unroll
    for (int i = 0; i < 16; ++i) s[i] = 0.f;
    __builtin_amdgcn_s_setprio(1);
#pragma unroll
    for (int dk = 0; dk < NDK; ++dk) s = mfma32(*(const LAS bf16x8*)(sp + dk * 1024), qf[dk], s);
    __builtin_amdgcn_s_setprio(0);
    const bf16x8 v00 = *(const LAS bf16x8*)(sp + 6144), v01 = *(const LAS bf16x8*)(sp + 6144 + 1024),
                 v10 = *(const LAS bf16x8*)(sp + 6144 + 2048), v11 = *(const LAS bf16x8*)(sp + 6144 + 3072);
    float tmax = -1e30f;
    if (MODE == 1 && t >= 8) {
      const LAS float* rp = rpbl + (rs + jr - r + 7) * 31;
#pragma unroll
      for (int reg = 0; reg < 16; ++reg) {
        const int kc = ct * 32 + (reg & 3) + 8 * (reg >> 2) + 4 * hh;
        const int rc = min(max(kc - qc, -15), 15) + 15;
        const float bias = rp[rc];
        const float v = (kc >= cs && kc < cs + 16) ? s[reg] + bias : -1e30f;
        s[reg] = v;
        tmax = fmaxf(tmax, v);
      }
    } else {
#pragma unroll
      for (int reg = 0; reg < 16; ++reg) tmax = fmaxf(tmax, s[reg]);
    }
    tmax = fmaxf(tmax, __shfl_xor(tmax, 32));
    const float mn = fmaxf(mrun, tmax);
    if (__builtin_amdgcn_ballot_w64(mn != mrun) != 0ull) {
      const float alpha = __builtin_amdgcn_exp2f(mrun - mn);
      lsum *= alpha;
#pragma unroll
      for (int i = 0; i < 16; ++i) { o0[i] *= alpha; o1[i] *= alpha; }
    }
    mrun = mn;
    float ps = 0.f;
#pragma unroll
    for (int reg = 0; reg < 16; ++reg) { const float pv = __builtin_amdgcn_exp2f(s[reg] - mn); s[reg] = pv; ps += pv; }
    lsum += ps;
    const bf16x8 pf0 = pack8(s[0], s[1], s[2], s[3], s[4], s[5], s[6], s[7]);
    const bf16x8 pf1 = pack8(s[8], s[9], s[10], s[11], s[12], s[13], s[14], s[15]);
    __builtin_amdgcn_s_setprio(1);
    o0 = mfma32(v00, pf0, o0);
    o1 = mfma32(v01, pf0, o1);
    o0 = mfma32(v10, pf1, o0);
    o1 = mfma32(v11, pf1, o1);
    __builtin_amdgcn_s_setprio(0);
  }
#undef ATT_KT
  asm volatile("s_waitcnt vmcnt(0)" ::: "memory");
  ATT_BAR();
  lsum += __shfl_xor(lsum, 32);
  const float inv = 1.f / lsum;
  u16* op = orow + 4 * hh;
#pragma unroll
  for (int gi = 0; gi < 4; ++gi) {
    st_bf4(op + 8 * gi, o0[4 * gi] * inv, o0[4 * gi + 1] * inv, o0[4 * gi + 2] * inv, o0[4 * gi + 3] * inv);
    st_bf4(op + 32 + 8 * gi, o1[4 * gi] * inv, o1[4 * gi + 1] * inv, o1[4 * gi + 2] * inv, o1[4 * gi + 3] * inv);
  }
}

template <int DQK>
DI void attn_block_pp(LAS unsigned char* lds, const u16* __restrict__ Kb, const u16* __restrict__ Vb, const u16* __restrict__ qrow,
                      u16* __restrict__ orow, int ntiles) {
  const int tid = TIDX, lane = tid & 63, w = __builtin_amdgcn_readfirstlane(tid >> 6), hh = lane >> 5;
  constexpr int NDK = DQK / 16;
  const int nl = (w + 8 < NDK + 4) ? 2 : 1;
  for (int tt = 0; tt < ATT_NST - 1; ++tt) att_issue<NDK>(lds, Kb, Vb, min(tt, ntiles - 1), tt, w, lane);
  bf16x8 qf[NDK];
#pragma unroll
  for (int dk = 0; dk < NDK; ++dk) qf[dk] = *(const bf16x8*)(qrow + dk * 16 + 8 * hh);
#pragma unroll
  for (int dk = 0; dk < NDK; ++dk) asm volatile("" :: "v"(qf[dk]));
  f32x16 o0, o1;
#pragma unroll
  for (int i = 0; i < 16; ++i) { o0[i] = 0.f; o1[i] = 0.f; }
  float mrun = -1e30f, lsum = 0.f;
  asm volatile("s_waitcnt vmcnt(0)" ::: "memory");
  ATT_BAR();
  f32x16 sn;
#pragma unroll
  for (int i = 0; i < 16; ++i) sn[i] = 0.f;
  {
    const LAS unsigned char* sp0 = lds + lane * 16;
#pragma unroll
    for (int dk = 0; dk < NDK; ++dk) sn = mfma32(*(const LAS bf16x8*)(sp0 + dk * 1024), qf[dk], sn);
  }
  for (int t = 0; t < ntiles; ++t) {
    if (nl == 2) asm volatile("s_waitcnt vmcnt(10)" ::: "memory"); else asm volatile("s_waitcnt vmcnt(5)" ::: "memory");
    ATT_BAR();
    { const int tn = min(t + ATT_NST - 1, ntiles - 1); att_issue<NDK>(lds, Kb, Vb, tn, (t + ATT_NST - 1) & (ATT_NST - 1), w, lane); }
    const LAS unsigned char* sp = lds + (t & (ATT_NST - 1)) * ATT_STB + lane * 16;
    const LAS unsigned char* spn = lds + ((t + 1) & (ATT_NST - 1)) * ATT_STB + lane * 16;
    f32x16 s = sn;
    const bf16x8 v00 = *(const LAS bf16x8*)(sp + 6144), v01 = *(const LAS bf16x8*)(sp + 6144 + 1024),
                 v10 = *(const LAS bf16x8*)(sp + 6144 + 2048), v11 = *(const LAS bf16x8*)(sp + 6144 + 3072);
#pragma unroll
    for (int i = 0; i < 16; ++i) sn[i] = 0.f;
#pragma unroll
    for (int dk = 0; dk < NDK; ++dk) sn = mfma32(*(const LAS bf16x8*)(spn + dk * 1024), qf[dk], sn);
    float tmax = -1e30f;
#pragma unroll
    for (int reg = 0; reg < 16; ++reg) tmax = fmaxf(tmax, s[reg]);
    tmax = fmaxf(tmax, __shfl_xor(tmax, 32));
    const float mn = fmaxf(mrun, tmax);
    {
      const float alpha = __builtin_amdgcn_exp2f(mrun - mn);
      lsum *= alpha;
#pragma unroll
      for (int i = 0; i < 16; ++i) { o0[i] *= alpha; o1[i] *= alpha; }
    }
    mrun = mn;
    float ps = 0.f;
#pragma unroll
    for (int reg = 0; reg < 16; ++reg) { const float pv = __builtin_amdgcn_exp2f(s[reg] - mn); s[reg] = pv; ps += pv; }
    lsum += ps;
    const bf16x8 pf0 = pack8(s[0], s[1], s[2], s[3], s[4], s[5], s[6], s[7]);
    const bf16x8 pf1 = pack8(s[8], s[9], s[10], s[11], s[12], s[13], s[14], s[15]);
    __builtin_amdgcn_s_setprio(1);
    o0 = mfma32(v00, pf0, o0);
    o1 = mfma32(v01, pf0, o1);
    o0 = mfma32(v10, pf1, o0);
    o1 = mfma32(v11, pf1, o1);
    __builtin_amdgcn_s_setprio(0);
  }
  asm volatile("s_waitcnt vmcnt(0)" ::: "memory");
  ATT_BAR();
  lsum += __shfl_xor(lsum, 32);
  const float inv = 1.f / lsum;
  u16* op = orow + 4 * hh;
#pragma unroll
  for (int gi = 0; gi < 4; ++gi) {
    st_bf4(op + 8 * gi, o0[4 * gi] * inv, o0[4 * gi + 1] * inv, o0[4 * gi + 2] * inv, o0[4 * gi + 3] * inv);
    st_bf4(op + 32 + 8 * gi, o1[4 * gi] * inv, o1[4 * gi + 1] * inv, o1[4 * gi + 2] * inv, o1[4 * gi + 3] * inv);
  }
}

DI void attn_block_diff(LAS unsigned char* lds, const u16* __restrict__ Kb, const u16* __restrict__ Vb, const u16* __restrict__ qrow,
                        u16* __restrict__ orow, float scale, int ntiles, float lam, const float* __restrict__ gsub, float outscale) {
  const int tid = TIDX, lane = tid & 63, w = __builtin_amdgcn_readfirstlane(tid >> 6), hh = lane >> 5;
  for (int tt = 0; tt < ATT_NST - 1; ++tt) att_issue<4>(lds, Kb, Vb, min(tt, ntiles - 1), tt, w, lane);
  bf16x8 qf[4];
#pragma unroll
  for (int dk = 0; dk < 4; ++dk) qf[dk] = *(const bf16x8*)(qrow + dk * 16 + 8 * hh);
#pragma unroll
  for (int dk = 0; dk < 4; ++dk) asm volatile("" :: "v"(qf[dk]));
  f32x16 oa0, oa1, ob0, ob1;
#pragma unroll
  for (int i = 0; i < 16; ++i) { oa0[i] = 0.f; oa1[i] = 0.f; ob0[i] = 0.f; ob1[i] = 0.f; }
  float m1 = -1e30f, l1 = 0.f, m2 = -1e30f, l2 = 0.f;
  for (int t = 0; t < ntiles; ++t) {
    asm volatile("s_waitcnt vmcnt(6)" ::: "memory");
    ATT_BAR();
    att_issue<4>(lds, Kb, Vb, min(t + ATT_NST - 1, ntiles - 1), (t + ATT_NST - 1) & (ATT_NST - 1), w, lane);
    const LAS unsigned char* sp = lds + (t & (ATT_NST - 1)) * ATT_STB + lane * 16;
    f32x16 s1, s2;
#pragma unroll
    for (int i = 0; i < 16; ++i) { s1[i] = 0.f; s2[i] = 0.f; }
    __builtin_amdgcn_s_setprio(1);
    s1 = mfma32(*(const LAS bf16x8*)(sp), qf[0], s1); s1 = mfma32(*(const LAS bf16x8*)(sp + 1024), qf[1], s1);
    s2 = mfma32(*(const LAS bf16x8*)(sp + 2048), qf[2], s2); s2 = mfma32(*(const LAS bf16x8*)(sp + 3072), qf[3], s2);
    __builtin_amdgcn_s_setprio(0);
    const bf16x8 v00 = *(const LAS bf16x8*)(sp + 6144), v10 = *(const LAS bf16x8*)(sp + 6144 + 1024),
                 v01 = *(const LAS bf16x8*)(sp + 6144 + 2048), v11 = *(const LAS bf16x8*)(sp + 6144 + 3072);
    float t1 = -1e30f, t2 = -1e30f;
#pragma unroll
    for (int reg = 0; reg < 16; ++reg) {
      t1 = fmaxf(t1, s1[reg]); t2 = fmaxf(t2, s2[reg]);
    }
    t1 = fmaxf(t1, __shfl_xor(t1, 32));
    t2 = fmaxf(t2, __shfl_xor(t2, 32));
    const float mn1 = fmaxf(m1, t1), mn2 = fmaxf(m2, t2);
    if (__builtin_amdgcn_ballot_w64(mn1 != m1) != 0ull) {
      const float a1 = __builtin_amdgcn_exp2f(m1 - mn1);
      l1 *= a1;
#pragma unroll
      for (int i = 0; i < 16; ++i) { oa0[i] *= a1; oa1[i] *= a1; }
    }
    if (__builtin_amdgcn_ballot_w64(mn2 != m2) != 0ull) {
      const float a2 = __builtin_amdgcn_exp2f(m2 - mn2);
      l2 *= a2;
#pragma unroll
      for (int i = 0; i < 16; ++i) { ob0[i] *= a2; ob1[i] *= a2; }
    }
    m1 = mn1; m2 = mn2;
    float p1 = 0.f, p2 = 0.f;
#pragma unroll
    for (int reg = 0; reg < 16; ++reg) {
      const float e1 = __builtin_amdgcn_exp2f(s1[reg] - mn1), e2 = __builtin_amdgcn_exp2f(s2[reg] - mn2);
      s1[reg] = e1; s2[reg] = e2; p1 += e1; p2 += e2;
    }
    l1 += p1; l2 += p2;
    const bf16x8 pa0 = pack8(s1[0], s1[1], s1[2], s1[3], s1[4], s1[5], s1[6], s1[7]);
    const bf16x8 pa1 = pack8(s1[8], s1[9], s1[10], s1[11], s1[12], s1[13], s1[14], s1[15]);
    const bf16x8 pb0 = pack8(s2[0], s2[1], s2[2], s2[3], s2[4], s2[5], s2[6], s2[7]);
    const bf16x8 pb1 = pack8(s2[8], s2[9], s2[10], s2[11], s2[12], s2[13], s2[14], s2[15]);
    __builtin_amdgcn_s_setprio(1);
    oa0 = mfma32(v00, pa0, oa0); oa1 = mfma32(v10, pa0, oa1);
    oa0 = mfma32(v01, pa1, oa0); oa1 = mfma32(v11, pa1, oa1);
    ob0 = mfma32(v00, pb0, ob0); ob1 = mfma32(v10, pb0, ob1);
    ob0 = mfma32(v01, pb1, ob0); ob1 = mfma32(v11, pb1, ob1);
    __builtin_amdgcn_s_setprio(0);
  }
  asm volatile("s_waitcnt vmcnt(0)" ::: "memory");
  ATT_BAR();
  l1 += __shfl_xor(l1, 32);
  l2 += __shfl_xor(l2, 32);
  const float i1 = 1.f / l1, i2 = lam / l2;
  float ss = 0.f;
#pragma unroll
  for (int i = 0; i < 16; ++i) {
    oa0[i] = oa0[i] * i1 - ob0[i] * i2;
    oa1[i] = oa1[i] * i1 - ob1[i] * i2;
    ss += oa0[i] * oa0[i] + oa1[i] * oa1[i];
  }
  ss += __shfl_xor(ss, 32);
  const float rstd = rsqrtf(ss * (1.f / 64.f) + EPS) * outscale;
  u16* op = orow + 4 * hh;
  float4 gs0[4], gs1[4];
#pragma unroll
  for (int gi = 0; gi < 4; ++gi) { gs0[gi] = *(const float4*)(gsub + 8 * gi + 4 * hh); gs1[gi] = *(const float4*)(gsub + 32 + 8 * gi + 4 * hh); }
#pragma unroll
  for (int gi = 0; gi < 4; ++gi) {
    const float4 g0 = gs0[gi], g1 = gs1[gi];
    st_bf4(op + 8 * gi, oa0[4 * gi] * rstd * g0.x, oa0[4 * gi + 1] * rstd * g0.y, oa0[4 * gi + 2] * rstd * g0.z, oa0[4 * gi + 3] * rstd * g0.w);
    st_bf4(op + 32 + 8 * gi, oa1[4 * gi] * rstd * g1.x, oa1[4 * gi + 1] * rstd * g1.y, oa1[4 * gi + 2] * rstd * g1.z, oa1[4 * gi + 3] * rstd * g1.w);
  }
}

constexpr int ATT_ITEMS = 640;
DI void phase_attn(const Params& p, int l, char* ldsg) {
  LAS unsigned char* lds = (LAS unsigned char*)ldsg;
  const int tid = TIDX, lane = tid & 63, l31 = lane & 31, w = __builtin_amdgcn_readfirstlane(tid >> 6);
  const float lam = p.lam[l];
  const float outscale = 1.f - lam_init_of(l);
  volatile LAS unsigned* slot = (volatile LAS unsigned*)(lds + 131072 + 8);
  for (;;) {
    __syncthreads();
    if (tid == 0) *slot = atomicAdd(&p.counters[l], 1u);
    __syncthreads();
    const unsigned it = __builtin_amdgcn_readfirstlane(*slot);
    if (it >= (unsigned)ATT_ITEMS) break;
    int idx = (int)it;
    if (idx < 32) {
      const int b = idx >> 4, h = (idx >> 2) & 3, qb = (idx & 3) * 8 + w;
      const int tok = TCTX + b * 1024 + qb * 32 + l31;
      attn_block_diff(lds, p.kdf_l + (size_t)l * (2 * 4 * NKL * 64) + (size_t)(b * 4 + h) * (NKL * 64),
                      p.vdf_l + (size_t)l * (2 * 4 * 64 * NKL) + (size_t)(b * 4 + h) * (64 * NKL), p.qdf + (size_t)tok * 256 + h * 64,
                      p.o + (size_t)tok * D + 768 + h * 64, 0.17677669529663687f, 40, lam, p.g_df_sub + l * 64, outscale);
      continue;
    }
    idx -= 32;
    if (idx < 48) {
      const int b = idx / 24, h = (idx >> 2) % 6, qb = (idx & 3) * 8 + w;
      const int tok = TCTX + b * 1024 + qb * 32 + l31;
      attn_block_pp<96>(lds, p.kmla_l + (size_t)l * (2 * 6 * NKL * 96) + (size_t)(b * 6 + h) * (NKL * 96),
                               p.vmla_l + (size_t)l * (2 * 6 * 64 * NKL) + (size_t)(b * 6 + h) * (64 * NKL), p.qmla + (size_t)tok * 576 + h * 96,
                               p.o + (size_t)tok * D + h * 64, 40);
      continue;
    }
    idx -= 48;
    if (idx < 48) {
      const int b = idx / 24, h = (idx >> 2) % 6, qt = idx & 3, qb = qt * 8 + w;
      const int tok = TCTX + b * 1024 + qb * 32 + l31;
      {
        const float* rg = p.na_rpb + (size_t)(l * 6 + h) * (15 * 31);
        LAS float* rl = (LAS float*)(lds + ATT_RPB_OFF);
        if (tid < 465) rl[tid] = rg[tid] * 1.4426950408889634f;
      }
      const int r0 = qt * 4;
      const int rs0 = min(max(r0 - 4, 0), 8), rs3 = min(max(r0 + 3 - 4, 0), 8);
      const int ntiles = 8 + 2 * (rs3 + 8 - rs0);
      attn_block_single<64, 1>(lds, p.kna_l + (size_t)l * (2 * 6 * NKL * 64) + (size_t)(b * 6 + h) * (NKL * 64),
                               p.vna_l + (size_t)l * (2 * 6 * 64 * NKL) + (size_t)(b * 6 + h) * (64 * NKL), p.qna + (size_t)tok * 384 + h * 64,
                               p.o + (size_t)tok * D + 384 + h * 64, 0.125f, ntiles, qb >> 1, (qb & 1) * 32 + l31, rs0);
      continue;
    }
    idx -= 48;
    if (idx < 192) {
      const int b = idx / 6, h = idx % 6;
      const int tok = b * 256 + w * 32 + l31;
      attn_block_pp<96>(lds, p.kmla_c + (size_t)(b * 6 + h) * (256 * 96), p.vmla_c + (size_t)(b * 6 + h) * (64 * 256),
                               p.qmla + (size_t)tok * 576 + h * 96, p.o + (size_t)tok * D + h * 64, 8);
      continue;
    }
    idx -= 192;
    if (idx < 192) {
      const int b = idx / 6, h = idx % 6;
      const int tok = b * 256 + w * 32 + l31;
      attn_block_pp<64>(lds, p.kna_c + (size_t)(b * 6 + h) * (256 * 64), p.vna_c + (size_t)(b * 6 + h) * (64 * 256),
                               p.qna + (size_t)tok * 384 + h * 64, p.o + (size_t)tok * D + 384 + h * 64, 8);
      continue;
    }
    idx -= 192;
    {
      const int b = idx >> 2, h = idx & 3;
      const int tok = b * 256 + w * 32 + l31;
      attn_block_diff(lds, p.kdf_c + (size_t)(b * 4 + h) * (256 * 64), p.vdf_c + (size_t)(b * 4 + h) * (64 * 256), p.qdf + (size_t)tok * 256 + h * 64,
                      p.o + (size_t)tok * D + 768 + h * 64, 0.17677669529663687f, 8, lam, p.g_df_sub + l * 64, outscale);
    }
  }
}

__global__ void __launch_bounds__(512, 2) fwd_megakernel(Params p, int ph_begin, int ph_end) {
  __shared__ __attribute__((aligned(16))) char lds[131072 + 16];
  cg::grid_group grid = cg::this_grid();
  if (ph_begin < 0) grid.sync();
  if (threadIdx.x == 0) *(uint4*)(lds + 131072) = make_uint4(0u, 0u, 0u, 0u);
  __syncthreads();
  XcdBarrier xb = xcd_barrier_post(p.bar, (volatile LAS unsigned*)(lds + 131072));
  LAS unsigned char* ldsl = (LAS unsigned char*)lds;
  for (int ph = ph_begin; ph < ph_end; ++ph) {
    if (ph > ph_begin) xcd_barrier(xb);
    if (ph == 0) { phase_prep(p, lds); continue; }
    const int l = (ph - 1) >> 3, s = (ph - 1) & 7;
    switch (s) {
      case 0: if (l == 1) prep_deferred(p, lds, 1 << 20); phase_norm(p, l, 0); break;
      case 1: { EpiIn e{p, l}; pg8::gemm_phase(ldsl, p.h, p.win_t + (size_t)l * NIN * D, T, NIN, D, e); } break;
      case 2: phase_mla_up(p, l, lds); break;
      case 3: phase_attn(p, l, lds); break;
      case 4: { EpiRes<0> e{p, l}; pg8::gemm_phase(ldsl, p.o, p.wout_t + (size_t)l * D * D, T, D, D, e); if (l == 0) prep_deferred(p, lds, BIDX >= 160 ? 4 : 0); } break;
      case 5: phase_norm(p, l, 1); break;
      case 6: { EpiGU e{p}; pg8::gemm_phase(ldsl, p.h, p.wgu_t + (size_t)l * NGU * D, T, NGU, D, e); } break;
      case 7: { EpiRes<1> e{p, l}; pg8::gemm_phase(ldsl, p.act, p.wdn_t + (size_t)l * D * DFF, T, D, DFF, e); if (l == 0) prep_deferred(p, lds, 1 << 20); } break;
    }
  }
}

extern "C" void kernel_launch(void* const* d_in, const int* in_sizes, int n_in, void* d_out, int out_size, void* d_ws, size_t ws_size,
                              hipStream_t stream) {
  static int grid_blocks = 0;
  if (!grid_blocks) {
    int dev = 0, cus = 0, per_cu = 0;
    hipGetDevice(&dev);
    hipDeviceGetAttribute(&cus, hipDeviceAttributeMultiprocessorCount, dev);
    hipOccupancyMaxActiveBlocksPerMultiprocessor(&per_cu, fwd_megakernel, 512, 0);
    if (per_cu > 1) per_cu = 1;
    if (per_cu < 1) per_cu = 1;
    grid_blocks = cus * per_cu;
  }
  Params p{};
  const float** ins = (const float**)&p;
  for (int i = 0; i < 35; ++i) ins[i] = (const float*)d_in[i];
  p.out = (float*)d_out;
  char* w = (char*)d_ws;
  size_t off = 0;
  auto alloc = [&](size_t bytes) { char* r = w + off; off += (bytes + 255) & ~(size_t)255; return r; };
  p.win_t = (u16*)alloc((size_t)2 * NIN * 1024 * 2);
  p.wuq_t = (u16*)alloc((size_t)2 * 576 * 256 * 2);
  p.wukv_t = (u16*)alloc((size_t)2 * 768 * 128 * 2);
  p.wout_t = (u16*)alloc((size_t)2 * 1024 * 1024 * 2);
  p.wgu_t = (u16*)alloc((size_t)2 * NGU * 1024 * 2);
  p.wdn_t = (u16*)alloc((size_t)2 * 1024 * DFF * 2);
  p.mod = (float*)alloc((size_t)2 * 3 * 6144 * 4);
  p.h = (u16*)alloc((size_t)T * D * 2);
  p.cq = (float*)alloc((size_t)T * 256 * 4);
  p.ckv = (float*)alloc((size_t)T * 128 * 4);
  p.krope = (float*)alloc((size_t)T * 32 * 4);
  p.qmla = (u16*)alloc((size_t)T * 576 * 2);
  p.qna = (u16*)alloc((size_t)T * 384 * 2);
  p.qdf = (u16*)alloc((size_t)T * 256 * 2);
  p.kmla_c = (u16*)alloc((size_t)32 * 6 * 256 * 96 * 2);
  p.vmla_c = (u16*)alloc((size_t)32 * 6 * 64 * 256 * 2);
  p.kna_c = (u16*)alloc((size_t)32 * 6 * 256 * 64 * 2);
  p.vna_c = (u16*)alloc((size_t)32 * 6 * 64 * 256 * 2);
  p.kdf_c = (u16*)alloc((size_t)32 * 4 * 256 * 64 * 2);
  p.vdf_c = (u16*)alloc((size_t)32 * 4 * 64 * 256 * 2);
  p.kmla_l = (u16*)alloc((size_t)2 * 2 * 6 * NKL * 96 * 2);
  p.vmla_l = (u16*)alloc((size_t)2 * 2 * 6 * 64 * NKL * 2);
  p.kna_l = (u16*)alloc((size_t)2 * 2 * 6 * NKL * 64 * 2);
  p.vna_l = (u16*)alloc((size_t)2 * 2 * 6 * 64 * NKL * 2);
  p.kdf_l = (u16*)alloc((size_t)2 * 2 * 4 * NKL * 64 * 2);
  p.vdf_l = (u16*)alloc((size_t)2 * 2 * 4 * 64 * NKL * 2);
  p.o = (u16*)alloc((size_t)T * D * 2);
  p.xa = (u16*)alloc((size_t)T * D * 2);
  p.xb = (u16*)alloc((size_t)T * D * 2);
  p.act = (u16*)alloc((size_t)T * DFF * 2);
  p.lam = (float*)alloc(256);
  p.bar = (unsigned*)alloc((size_t)XCD_BAR_WORDS * 4 + 256);
  p.counters = p.bar + XCD_BAR_WORDS;
  if (off > ws_size) { fprintf(stderr, "workspace too small: need %zu have %zu\n", off, ws_size); return; }
  hipMemsetAsync(p.bar, 0, (size_t)XCD_BAR_WORDS * 4 + 256, stream);
  int b = 0, e = 17;
  void* args[] = {&p, &b, &e};
  hipError_t err = hipLaunchCooperativeKernel((void*)fwd_megakernel, dim3(grid_blocks), dim3(512), args, 0, stream);
  if (err != hipSuccess) fprintf(stderr, "cooperative launch failed: %s (grid %d)\n", hipGetErrorString(err), grid_blocks);
}
```

```cpp
#include <hip/hip_runtime.h>
#include <hip/hip_cooperative_groups.h>
#include <cstdio>
#include <cstdint>
namespace cg = cooperative_groups;

typedef unsigned short u16;
typedef __attribute__((ext_vector_type(8))) short bf16x8;
typedef __attribute__((ext_vector_type(4))) float f32x4;
typedef __attribute__((ext_vector_type(16))) float f32x16;
typedef __attribute__((ext_vector_type(4))) unsigned u32x4;

#define DI __device__ __forceinline__

constexpr int D = 1024;
constexpr int TCTX = 8192;
constexpr int TLAT = 2048;
constexpr int T = TCTX + TLAT;
constexpr int NIN = 2560;
constexpr int DFF = 2816;
constexpr int NGU = 2 * DFF;
constexpr float EPS = 1e-6f;
constexpr int NKL = 1280;

constexpr size_t OUT_YP = 0;
constexpr size_t OUT_CKV = 10485760;
constexpr size_t OUT_KROPE = 12582912;
constexpr size_t OUT_NAK = 13107200;
constexpr size_t OUT_NAV = 19398656;
constexpr size_t OUT_DFK = 25690112;
constexpr size_t OUT_DFV = 29884416;

struct Params {
  const float *x_prompt, *x_sample, *cache_mla_ckv, *cache_mla_krope, *cache_na_k, *cache_na_v, *cache_df_k, *cache_df_v, *c, *c_ctx;
  const float *w_mod, *b_mod, *g_mix, *w_in, *g_qa, *w_uq, *g_kva, *w_ukv, *g_mla_q, *g_mla_k, *g_na_q, *g_na_k, *na_rpb, *g_df_q,
      *g_df_k, *df_lq1, *df_lk1, *df_lq2, *df_lk2, *g_df_sub, *w_out, *g_ffn, *w_gate, *w_up, *w_down;
  float* out;
  u16 *win_t, *wuq_t, *wukv_t, *wout_t, *wgu_t, *wdn_t;
  float* mod;
  u16* h;
  float *cq, *ckv, *krope;
  u16 *qmla, *qna, *qdf;
  u16 *kmla_c, *vmla_c, *kna_c, *vna_c, *kdf_c, *vdf_c;
  u16 *kmla_l, *vmla_l, *kna_l, *vna_l, *kdf_l, *vdf_l;
  u16* o;
  u16 *xa, *xb;
  u16* act;
  float* lam;
  unsigned* counters;
  unsigned* bar;
};

DI int opaque_v(int x) { asm volatile("" : "+v"(x)); return x; }
DI int opaque_s(int x) { asm volatile("" : "+s"(x)); return x; }
#define TIDX opaque_v((int)threadIdx.x)
#define BIDX opaque_s((int)blockIdx.x)
DI unsigned cvtpk(float lo, float hi) {
  unsigned r;
  asm volatile("v_cvt_pk_bf16_f32 %0, %1, %2" : "=v"(r) : "v"(lo), "v"(hi));
  return r;
}
DI u16 f2bf(float f) { return (u16)(cvtpk(f, 0.f) & 0xffffu); }
DI bf16x8 pack8(float a0, float a1, float a2, float a3, float a4, float a5, float a6, float a7) {
  uint4 u;
  u.x = cvtpk(a0, a1); u.y = cvtpk(a2, a3); u.z = cvtpk(a4, a5); u.w = cvtpk(a6, a7);
  return __builtin_bit_cast(bf16x8, u);
}
DI void st_bf4(u16* p, float a, float b, float c, float d) {
  uint2 u; u.x = cvtpk(a, b); u.y = cvtpk(c, d);
  *(uint2*)p = u;
}
DI f32x16 mfma32(bf16x8 a, bf16x8 b, f32x16 c) { return __builtin_amdgcn_mfma_f32_32x32x16_bf16(a, b, c, 0, 0, 0); }
DI f32x4 mfma16(bf16x8 a, bf16x8 b, f32x4 c) { return __builtin_amdgcn_mfma_f32_16x16x32_bf16(a, b, c, 0, 0, 0); }
DI float lam_init_of(int l) { return l == 0 ? 0.2f : 0.35550906759f; }
DI f32x4 bf4_to_f32(uint2 u) {
  f32x4 r;
  r[0] = __uint_as_float(u.x << 16); r[1] = __uint_as_float(u.x & 0xffff0000u);
  r[2] = __uint_as_float(u.y << 16); r[3] = __uint_as_float(u.y & 0xffff0000u);
  return r;
}
struct ResSrc { const float* f; const u16* h; };
DI ResSrc xrow_in(const Params& p, int l, int t) {
  ResSrc r; r.f = nullptr; r.h = nullptr;
  if (l == 0) r.f = t < TCTX ? p.x_prompt + (size_t)t * D : p.x_sample + (size_t)(t - TCTX) * D;
  else r.h = p.xb + (size_t)t * D;
  return r;
}
DI ResSrc xa_row(const Params& p, int t) { ResSrc r; r.f = nullptr; r.h = p.xa + (size_t)t * D; return r; }
DI f32x4 res_ld4(const ResSrc& s, int c) { return s.f ? __builtin_nontemporal_load((const f32x4*)(s.f + c)) : bf4_to_f32(*(const uint2*)(s.h + c)); }
DI int cond_of(int t) { return t < TCTX ? 0 : 1 + ((t - TCTX) >> 10); }

DI void rope32(f32x16& x, int s, int hh) {
  const float prow = (float)(s >> 6), pcol = (float)(s & 63);
  const float hs = hh ? 0.01f : 1.0f;
  f32x16 y;
#pragma unroll
  for (int reg = 0; reg < 16; ++reg) {
    const int a = reg >> 3, half = (reg >> 2) & 1, i3 = reg & 3;
    const float base = (i3 == 0) ? 1.0f : (i3 == 1) ? 0.31622776601683794f : (i3 == 2) ? 0.1f : 0.031622776601683794f;
    const float ang = (a ? pcol : prow) * (base * hs);
    const float cs = __cosf(ang), sn = __sinf(ang);
    const float partner = x[reg ^ 4];
    y[reg] = x[reg] * cs + (half ? partner : -partner) * sn;
  }
  x = y;
}


#define XB_TMO      128
#define XB_XCNT(j)  (256  + 64 * (j))
#define XB_XSUB(j)  (1280 + 64 * (j))
#define XB_XGEN(j)  (2304 + 64 * (j))
#define XB_TOP      3328
#define XB_TOPGEN   3392
#define XCD_BAR_WORDS 3456
#define XB_SPIN_CAP (1u << 22)
#define LAS __attribute__((address_space(3)))
DI unsigned xb_ld(unsigned* p) { return __hip_atomic_load(p, __ATOMIC_RELAXED, __HIP_MEMORY_SCOPE_AGENT); }
DI unsigned xb_add(unsigned* p, unsigned v) { return __hip_atomic_fetch_add(p, v, __ATOMIC_RELAXED, __HIP_MEMORY_SCOPE_AGENT); }
DI unsigned xb_xcc_id() { return (unsigned)__builtin_amdgcn_s_getreg((3 << 11) | 20) & 0xFu; }
#define XB_SPIN(cond, bar) do { unsigned _sp = 0; while (cond) { __builtin_amdgcn_s_sleep(1); \
    if ((++_sp & 255u) == 0u) { if (xb_ld(&(bar)[XB_TMO])) break; if (_sp > XB_SPIN_CAP) { atomicAdd(&(bar)[XB_TMO], 1u); break; } } } } while (0)
struct XcdBarrier { unsigned* bar; unsigned x; volatile LAS unsigned* st; };
DI XcdBarrier xcd_barrier_post(unsigned* bar, volatile LAS unsigned* st) {
  XcdBarrier b; b.bar = bar; b.x = xb_xcc_id(); b.st = st;
  if (threadIdx.x == 0) (void)xb_add(&bar[XB_XCNT(b.x)], 1u);
  return b;
}
DI void xcd_barrier_complete(unsigned* bar, unsigned x, unsigned& nloc, unsigned& nx) {
  const unsigned G = gridDim.x * gridDim.y * gridDim.z;
  unsigned sum, cnt, mine, sp = 0u;
  for (;;) {
    sum = 0u; cnt = 0u; mine = 0u;
#pragma unroll
    for (unsigned j = 0; j < 16; ++j) { const unsigned c = xb_ld(&bar[XB_XCNT(j)]); sum += c; cnt += (c > 0u) ? 1u : 0u; mine = (j == x) ? c : mine; }
    if (sum == G) break;
    __builtin_amdgcn_s_sleep(1);
    if ((++sp & 255u) == 0u) { if (xb_ld(&bar[XB_TMO])) break; if (sp > XB_SPIN_CAP) { atomicAdd(&bar[XB_TMO], 1u); break; } }
  }
  nloc = mine > 0u ? mine : 1u; nx = cnt > 0u ? cnt : 1u;
}
DI void xcd_barrier(const XcdBarrier& b) {
  asm volatile("s_waitcnt vmcnt(0)" ::: "memory");
  __syncthreads();
  if (threadIdx.x == 0) {
    unsigned* bar = b.bar;
    __builtin_amdgcn_s_waitcnt(0);
    unsigned nloc = b.st[0], nx = b.st[1];
    if (nloc == 0u) { xcd_barrier_complete(bar, b.x, nloc, nx); b.st[0] = nloc; b.st[1] = nx; }
    const unsigned old = xb_add(&bar[XB_XSUB(b.x)], 1u);
    const unsigned gen = old / nloc;
    if (old + 1u == (gen + 1u) * nloc) {
      __builtin_amdgcn_fence(__ATOMIC_RELEASE, "agent");
      asm volatile("s_waitcnt vmcnt(0)" ::: "memory");
      const unsigned og = xb_add(&bar[XB_TOP], 1u);
      const unsigned tg = og / nx;
      if (og + 1u == (tg + 1u) * nx) xb_add(&bar[XB_TOPGEN], 1u);
      else XB_SPIN(xb_ld(&bar[XB_TOPGEN]) == tg, bar);
      __builtin_amdgcn_fence(__ATOMIC_ACQUIRE, "agent");
      xb_add(&bar[XB_XGEN(b.x)], 1u);
      asm volatile("s_waitcnt vmcnt(0)" ::: "memory");
    } else {
      XB_SPIN(xb_ld(&bar[XB_XGEN(b.x)]) == gen, bar);
      __builtin_amdgcn_fence(__ATOMIC_ACQUIRE, "agent");
      asm volatile("s_waitcnt vmcnt(0)" ::: "memory");
    }
  }
  __syncthreads();
}

DI size_t kf_off(int kidx, int d8  , int ndk) { return ((size_t)((kidx >> 5) * ndk + (d8 >> 4)) * 64 + ((d8 >> 3) & 1) * 32 + (kidx & 31)) * 8; }
DI size_t vf_off(int kidx, int d) {
  const int kin = kidx & 31, q = kin & 15;
  return ((size_t)(((kidx >> 5) * 2 + (kin >> 4)) * 2 + (d >> 5)) * 64 + ((q >> 2) & 1) * 32 + (d & 31)) * 8 + 4 * (q >> 3) + (q & 3);
}

DI int phys_row(int L) {
  const int cl = L & 31;
  const int rho = 16 * ((cl >> 2) & 1) + 4 * (cl >> 3) + (cl & 3);
  return (L & ~255) + ((L >> 5) & 1) * 128 + ((L >> 6) & 3) * 32 + rho;
}
DI int map_row(int type, int n) {
  if (type == 1) {
    const int L = (n < 384) ? n : (n < 416) ? 2304 + (n - 384) : n - 32;
    return phys_row(L);
  }
  if (type == 2 || type == 3) {
    const int cl = n & 31;
    const int rho = 16 * ((cl >> 2) & 1) + 4 * (cl >> 3) + (cl & 3);
    return (n >> 7) * 256 + (type == 3 ? 128 : 0) + ((n >> 5) & 3) * 32 + rho;
  }
  if (type == 0) return phys_row(n);
  return n;
}
DI void transpose_tile(const float* __restrict__ src, int ld_src, int N, int k0, int n0, u16* __restrict__ dst, int ld_dst,
                       int type, int mode, u16* tile, int ng) {
  const int tid = TIDX;
  {
    const int c4 = tid & 15, r0 = tid >> 4;
    float4 v[4][2];
#pragma unroll
    for (int j = 0; j < 4; ++j)
#pragma unroll
      for (int ps = 0; ps < 2; ++ps) {
        v[j][ps] = make_float4(0.f, 0.f, 0.f, 0.f);
        if (j < ng && n0 + j * 64 + c4 * 4 < N) {
          const f32x4 t4 = __builtin_nontemporal_load((const f32x4*)(src + (size_t)(k0 + r0 + ps * 32) * ld_src + n0 + j * 64 + c4 * 4));
          v[j][ps] = make_float4(t4[0], t4[1], t4[2], t4[3]);
        }
      }
#pragma unroll
    for (int j = 0; j < 4; ++j)
      if (j < ng) {
#pragma unroll
        for (int ps = 0; ps < 2; ++ps) {
          unsigned* tp = (unsigned*)(tile + j * 4224 + (r0 + ps * 32) * 66 + c4 * 4);
          tp[0] = cvtpk(v[j][ps].x, v[j][ps].y);
          tp[1] = cvtpk(v[j][ps].z, v[j][ps].w);
        }
      }
  }
  __syncthreads();
  {
    const int kc = tid & 7, nrow = tid >> 3;
    const int k = k0 + kc * 8;
#pragma unroll
    for (int j = 0; j < 4; ++j) {
      const int n = n0 + j * 64 + nrow;
      if (j < ng && n < N) {
        const u16* tj = tile + j * 4224;
        unsigned w[4];
#pragma unroll
        for (int q = 0; q < 4; ++q) {
          const unsigned lo = tj[(kc * 8 + 2 * q) * 66 + nrow];
          const unsigned hi = tj[(kc * 8 + 2 * q + 1) * 66 + nrow];
          w[q] = lo | (hi << 16);
        }
        size_t off;
        if (mode == 0) {
          if (type == 4) {
            off = ((size_t)((n >> 5) * (ld_dst >> 4) + (k >> 4)) * 64 + ((k >> 3) & 1) * 32 + (n & 31)) * 8;
          } else off = (size_t)map_row(type, n) * ld_dst + k;
          *(uint4*)(dst + off) = make_uint4(w[0], w[1], w[2], w[3]);
        } else {
          const size_t o0 = vf_off(k, n);
          *(uint2*)(dst + o0) = make_uint2(w[0], w[1]);
          *(uint2*)(dst + o0 + 32 * 8) = make_uint2(w[2], w[3]);
        }
      }
    }
  }
  __syncthreads();
}

DI void mod_item(const Params& p, int l, int chunk, float* lds) {
  const int tid = TIDX;
  float* sv = lds;
  float* red = lds + 3072;
  for (int i = tid; i < 3072; i += 512) {
    const int n = i >> 10, k = i & 1023;
    const float v = (n == 0) ? p.c_ctx[k] : p.c[(n - 1) * 1024 + k];
    sv[i] = v / (1.f + expf(-v));
  }
  __syncthreads();
  const int c4 = tid & 15, kg = tid >> 4;
  const int c0 = chunk * 64;
  float acc[3][4];
#pragma unroll
  for (int n = 0; n < 3; ++n)
#pragma unroll
    for (int e = 0; e < 4; ++e) acc[n][e] = 0.f;
  const float* wp = p.w_mod + ((size_t)l * 1024 + kg * 32) * 6144 + c0 + c4 * 4;
#pragma unroll 8
  for (int kk = 0; kk < 32; ++kk) {
    const f32x4 w4 = __builtin_nontemporal_load((const f32x4*)(wp + (size_t)kk * 6144));
    const float4 w = make_float4(w4[0], w4[1], w4[2], w4[3]);
    const int k = kg * 32 + kk;
#pragma unroll
    for (int n = 0; n < 3; ++n) {
      const float s = sv[n * 1024 + k];
      acc[n][0] += s * w.x; acc[n][1] += s * w.y; acc[n][2] += s * w.z; acc[n][3] += s * w.w;
    }
  }
#pragma unroll
  for (int n = 0; n < 3; ++n)
#pragma unroll
    for (int e = 0; e < 4; ++e) red[(kg * 12 + n * 4 + e) * 16 + c4] = acc[n][e];
  __syncthreads();
  if (tid < 192) {
    const int n = tid >> 6, cc = tid & 63, cc4 = cc >> 2, e = cc & 3;
    float s = 0.f;
#pragma unroll
    for (int g = 0; g < 32; ++g) s += red[(g * 12 + n * 4 + e) * 16 + cc4];
    p.mod[(size_t)(l * 3 + n) * 6144 + c0 + cc] = s + p.b_mod[(size_t)l * 6144 + c0 + cc];
  }
  __syncthreads();
}

constexpr int P0_TR_PER_LAYER = 160 + 12 + 6 + 64 + 176 + 176 + 176 + 48 + 32;
constexpr int P0_MOD_PER_LAYER = 96;
constexpr int P0_KC_PER_LAYER = 20;
constexpr int P0_PER_LAYER = P0_TR_PER_LAYER + P0_MOD_PER_LAYER + P0_KC_PER_LAYER;

DI void prep_item(const Params& p, int l, int r, char* lds) {
  const int tid = TIDX;
    if (r < P0_MOD_PER_LAYER) { mod_item(p, l, r, (float*)lds); return; }
    r -= P0_MOD_PER_LAYER;
    u16* tile = (u16*)lds;
    if (r < 160) {
      const int kt = r / 10, g = r % 10;
      transpose_tile(p.w_in + (size_t)l * 1024 * 2336, 2336, 2336, kt * 64, g * 256, p.win_t + (size_t)l * NIN * 1024, 1024, 1, 0, tile, min(4, 37 - 4 * g));
      return;
    }
    r -= 160;
    if (r < 12) {
      const int kt = r / 3, g = r % 3;
      transpose_tile(p.w_uq + (size_t)l * 256 * 576, 576, 576, kt * 64, g * 256, p.wuq_t + (size_t)l * 576 * 256, 256, 4, 0, tile, min(4, 9 - 4 * g));
      return;
    }
    r -= 12;
    if (r < 6) {
      const int kt = r / 3, g = r % 3;
      transpose_tile(p.w_ukv + (size_t)l * 128 * 768, 768, 768, kt * 64, g * 256, p.wukv_t + (size_t)l * 768 * 128, 128, 4, 0, tile, 4);
      return;
    }
    r -= 6;
    if (r < 64) {
      const int kt = r / 4, g = r % 4;
      transpose_tile(p.w_out + (size_t)l * 1024 * 1024, 1024, 1024, kt * 64, g * 256, p.wout_t + (size_t)l * 1024 * 1024, 1024, 0, 0, tile, 4);
      return;
    }
    r -= 64;
    if (r < 176) {
      const int kt = r / 11, g = r % 11;
      transpose_tile(p.w_gate + (size_t)l * 1024 * DFF, DFF, DFF, kt * 64, g * 256, p.wgu_t + (size_t)l * NGU * 1024, 1024, 2, 0, tile, 4);
      return;
    }
    r -= 176;
    if (r < 176) {
      const int kt = r / 11, g = r % 11;
      transpose_tile(p.w_up + (size_t)l * 1024 * DFF, DFF, DFF, kt * 64, g * 256, p.wgu_t + (size_t)l * NGU * 1024, 1024, 3, 0, tile, 4);
      return;
    }
    r -= 176;
    if (r < 176) {
      const int kt = r / 4, g = r % 4;
      transpose_tile(p.w_down + (size_t)l * DFF * 1024, 1024, 1024, kt * 64, g * 256, p.wdn_t + (size_t)l * 1024 * DFF, DFF, 0, 0, tile, 4);
      return;
    }
    r -= 176;
    if (r < 48) {
      const int bh = r >> 2, kt = r & 3, b = bh / 6, hh = bh % 6;
      transpose_tile(p.cache_na_v + ((size_t)((b * 2 + l) * 6 + hh) * 256) * 64, 64, 64, kt * 64, 0,
                     p.vna_l + (size_t)l * (2 * 6 * 64 * NKL) + (size_t)bh * (64 * NKL), 0, 0, 1, tile, 1);
      return;
    }
    r -= 48;
    if (r < 32) {
      const int bh = r >> 2, kt = r & 3, b = bh / 4, hh = bh % 4;
      transpose_tile(p.cache_df_v + ((size_t)((b * 2 + l) * 4 + hh) * 256) * 64, 64, 64, kt * 64, 0,
                     p.vdf_l + (size_t)l * (2 * 4 * 64 * NKL) + (size_t)bh * (64 * NKL), 0, 0, 1, tile, 1);
      return;
    }
    r -= 32;
    {
      const float* src;
      u16* dst;
      if (r < 12) {
        const int b = r / 6, hh = r % 6;
        src = p.cache_na_k + ((size_t)((b * 2 + l) * 6 + hh) * 256) * 64;
        dst = p.kna_l + (size_t)l * (2 * 6 * NKL * 64) + (size_t)(b * 6 + hh) * (NKL * 64);
      } else {
        const int q = r - 12, b = q / 4, hh = q % 4;
        src = p.cache_df_k + ((size_t)((b * 2 + l) * 4 + hh) * 256) * 64;
        dst = p.kdf_l + (size_t)l * (2 * 4 * NKL * 64) + (size_t)(b * 4 + hh) * (NKL * 64);
      }
      float4 v[8];
#pragma unroll
      for (int i = 0; i < 8; ++i) v[i] = *(const float4*)(src + (tid + 512 * i) * 4);
#pragma unroll
      for (int i = 0; i < 8; ++i) {
        const int e = (tid + 512 * i) * 4;
        const int key = e >> 6, d4 = e & 63;
        st_bf4(dst + kf_off(key, d4 & ~7, 4) + (d4 & 7), v[i].x, v[i].y, v[i].z, v[i].w);
      }
    }
}

constexpr int P0_W_ITEMS = 160 + 12 + 6 + 64 + 176 + 176 + 176;
DI void phase_prep(const Params& p, char* lds) {
  const int tid = TIDX;
  if (BIDX == 0 && tid == 0) {
    for (int l = 0; l < 2; ++l) {
      float s1 = 0.f, s2 = 0.f;
      for (int i = 0; i < 32; ++i) {
        s1 += p.df_lq1[l * 32 + i] * p.df_lk1[l * 32 + i];
        s2 += p.df_lq2[l * 32 + i] * p.df_lk2[l * 32 + i];
      }
      p.lam[l] = expf(s1) - expf(s2) + lam_init_of(l);
    }
  }
  constexpr int NREST0 = P0_PER_LAYER - P0_MOD_PER_LAYER;
  constexpr int NREST1 = P0_PER_LAYER - P0_MOD_PER_LAYER - P0_W_ITEMS;
  for (int item = BIDX; item < 2 * P0_MOD_PER_LAYER + NREST0 + NREST1; item += gridDim.x) {
    int l, r;
    if (item < 2 * P0_MOD_PER_LAYER) { l = item / P0_MOD_PER_LAYER; r = item % P0_MOD_PER_LAYER; }
    else if (item < 2 * P0_MOD_PER_LAYER + NREST0) { l = 0; r = P0_MOD_PER_LAYER + (item - 2 * P0_MOD_PER_LAYER); }
    else { l = 1; r = P0_MOD_PER_LAYER + P0_W_ITEMS + (item - 2 * P0_MOD_PER_LAYER - NREST0); }
    prep_item(p, l, r, lds);
  }
}

DI void prep_deferred(const Params& p, char* lds, int cap) {
  const int tid = TIDX;
  volatile LAS unsigned* slot = (volatile LAS unsigned*)((LAS unsigned char*)lds + 131072 + 8);
  for (int n = 0; n < cap; ++n) {
    __syncthreads();
    if (tid == 0) *slot = atomicAdd(&p.counters[8], 1u);
    __syncthreads();
    const unsigned it = __builtin_amdgcn_readfirstlane(*slot);
    if (it >= (unsigned)P0_W_ITEMS) break;
    prep_item(p, 1, P0_MOD_PER_LAYER + (int)it, lds);
  }
}

DI void phase_norm(const Params& p, int l, int which  ) {
  const int lane = TIDX & 63, wid = TIDX >> 6;
  const float* g = (which == 0 ? p.g_mix : p.g_ffn) + l * D;
  const int nw = gridDim.x * 8;
  for (int t = BIDX * 8 + wid; t < T; t += 2 * nw) {
    const int t1 = t + nw;
    const bool has1 = t1 < T;
    const int tb = has1 ? t1 : t;
    const ResSrc xr0 = (which == 0) ? xrow_in(p, l, t) : xa_row(p, t);
    const ResSrc xr1 = (which == 0) ? xrow_in(p, l, tb) : xa_row(p, tb);
    const float* sh0 = p.mod + (size_t)((l * 3 + cond_of(t)) * 6 + (which == 0 ? 0 : 3)) * D;
    const float* sh1 = p.mod + (size_t)((l * 3 + cond_of(tb)) * 6 + (which == 0 ? 0 : 3)) * D;
    float4 v0[4], v1[4], gg[4], sa0[4], sb0[4], sa1[4], sb1[4];
#pragma unroll
    for (int i = 0; i < 4; ++i) {
      const int c = i * 256 + lane * 4;
      { const f32x4 a = res_ld4(xr0, c), b2 = res_ld4(xr1, c); v0[i] = make_float4(a[0], a[1], a[2], a[3]); v1[i] = make_float4(b2[0], b2[1], b2[2], b2[3]); }
      gg[i] = *(const float4*)(g + c);
      sb0[i] = *(const float4*)(sh0 + c); sa0[i] = *(const float4*)(sh0 + D + c);
      sb1[i] = *(const float4*)(sh1 + c); sa1[i] = *(const float4*)(sh1 + D + c);
    }
    float ss0 = 0.f, ss1 = 0.f;
#pragma unroll
    for (int i = 0; i < 4; ++i) {
      ss0 += v0[i].x * v0[i].x + v0[i].y * v0[i].y + v0[i].z * v0[i].z + v0[i].w * v0[i].w;
      ss1 += v1[i].x * v1[i].x + v1[i].y * v1[i].y + v1[i].z * v1[i].z + v1[i].w * v1[i].w;
    }
#pragma unroll
    for (int m = 1; m < 64; m <<= 1) { ss0 += __shfl_xor(ss0, m); ss1 += __shfl_xor(ss1, m); }
    const float r0 = rsqrtf(ss0 * (1.f / D) + EPS), r1 = rsqrtf(ss1 * (1.f / D) + EPS);
#pragma unroll
    for (int i = 0; i < 4; ++i) {
      const int c = i * 256 + lane * 4;
      st_bf4(p.h + (size_t)t * D + c, v0[i].x * r0 * gg[i].x * (1.f + sa0[i].x) + sb0[i].x, v0[i].y * r0 * gg[i].y * (1.f + sa0[i].y) + sb0[i].y,
             v0[i].z * r0 * gg[i].z * (1.f + sa0[i].z) + sb0[i].z, v0[i].w * r0 * gg[i].w * (1.f + sa0[i].w) + sb0[i].w);
    }
    if (has1) {
#pragma unroll
      for (int i = 0; i < 4; ++i) {
        const int c = i * 256 + lane * 4;
        st_bf4(p.h + (size_t)t1 * D + c, v1[i].x * r1 * gg[i].x * (1.f + sa1[i].x) + sb1[i].x, v1[i].y * r1 * gg[i].y * (1.f + sa1[i].y) + sb1[i].y,
               v1[i].z * r1 * gg[i].z * (1.f + sa1[i].z) + sb1[i].z, v1[i].w * r1 * gg[i].w * (1.f + sa1[i].w) + sb1[i].w);
      }
    }
  }
}

namespace pg8 {
typedef unsigned short bf16_t;
constexpr int BM = 256, BK = 64, HALF = 128, HTB = HALF * BK * 2, STAGE_BYTES = 8 * HTB, NXCD = 8, WGM = 8;
DI int lds_byte(int r, int c) { const int st = (r >> 4) * 2 + (c >> 5), rr = r & 15, cc = c & 31, ob = rr * 64 + cc * 2; return st * 1024 + (ob ^ (((ob >> 9) & 1) << 5)); }
DI void stage_rc(int b, int& R, int& C) { const int st = b / 1024, sb = b % 1024, swz = sb ^ (((sb >> 9) & 1) << 5); R = (st >> 1) * 16 + swz / 64; C = (st & 1) * 32 + (swz % 64) / 2; }
struct Unit { int pm, pn; };
struct StaticOrder {
  int nM, nN, nwg, G, c;
  DI void init(int M, int N, int G_, int c_) { nM = M / BM; nN = N / BM; nwg = nM * nN; G = G_; c = c_; }
  DI bool next(int i, Unit& u) const {
    const long L = (long)i * G + c; if (L >= nwg) return false;
    int wgid = (int)L; { const int q = nwg / NXCD, r = nwg % NXCD, xcd = wgid % NXCD, off = wgid / NXCD; wgid = (xcd < r ? xcd * (q + 1) : r * (q + 1) + (xcd - r) * q) + off; }
    const int nig = WGM * nN, gid = wgid / nig, fm = gid * WGM, gsz = (nM - fm) < WGM ? (nM - fm) : WGM;
    u.pm = fm + ((wgid % nig) % gsz); u.pn = (wgid % nig) / gsz; return true;
  }
};

template <class Epi>
DI void gemm_phase(LAS unsigned char* lds, const bf16_t* gA, const bf16_t* gBt, int M, int N, int K, const Epi& E) {
  const int tid = TIDX, wid = __builtin_amdgcn_readfirstlane(tid >> 6), lane = tid & 63, wr = wid >> 2, wc = wid & 3, fr = lane & 15, fq = lane >> 4;
  const int nt = K / BK;
  StaticOrder S; S.init(M, N, (int)gridDim.x, BIDX);
  unsigned voffA[2];
#pragma unroll
  for (int i = 0; i < 2; ++i) { int R, C; stage_rc(tid * 16 + i * 8192, R, C); voffA[i] = (unsigned)(R * K + C) * 2u; }
  const size_t kstep = (size_t)(BK * 2);
  const size_t hstep = (size_t)HALF * K * 2;
  const size_t tstep = 2 * hstep;
  const unsigned ldsw = (unsigned)wid * 1024u;
  const int aoff = lds_byte(wr * 64 + fr, fq * 8), boff = lds_byte(wc * 32 + fr, fq * 8);
#define PG8_SA(b, h) (((b) * 2 + (h)) * HTB)
#define PG8_SB(b, h) ((4 + (b) * 2 + (h)) * HTB)
#define PG8_STAGE(bufoff, gbase) do { _Pragma("unroll") for (int _i = 0; _i < 2; ++_i) \
    __builtin_amdgcn_global_load_lds((const unsigned*)((const char*)(gbase) + voffA[_i]), (LAS unsigned*)(lds + (bufoff) + ldsw + _i * 8192), 16, 0, 0); } while (0)
#define PG8_LDA(dst, b, h) do { _Pragma("unroll") for (int m = 0; m < 4; ++m) _Pragma("unroll") for (int k = 0; k < 2; ++k) dst[m][k] = *(const LAS bf16x8*)(lds + PG8_SA(b, h) + aoff + m * 2048 + k * 1024); } while (0)
#define PG8_LDB(dst, b, h) do { _Pragma("unroll") for (int n = 0; n < 2; ++n) _Pragma("unroll") for (int k = 0; k < 2; ++k) dst[n][k] = *(const LAS bf16x8*)(lds + PG8_SB(b, h) + boff + n * 2048 + k * 1024); } while (0)
#define PG8_MMA(ai, bj, At, Bt) do { __builtin_amdgcn_s_setprio(1); _Pragma("unroll") for (int m = 0; m < 4; ++m) _Pragma("unroll") for (int n = 0; n < 2; ++n) _Pragma("unroll") for (int k = 0; k < 2; ++k) \
    acc[ai][bj][m][n] = __builtin_amdgcn_mfma_f32_16x16x32_bf16(Bt[n][k], At[m][k], acc[ai][bj][m][n], 0, 0, 0); __builtin_amdgcn_s_setprio(0); } while (0)
#define PG8_WAIT_V(n) asm volatile("s_waitcnt vmcnt(" #n ")" ::: "memory")
#define PG8_WAIT_L(n) asm volatile("s_waitcnt lgkmcnt(" #n ")" ::: "memory")
#define PG8_BAR __builtin_amdgcn_s_barrier()
#define PG8_SCHED __builtin_amdgcn_sched_barrier(0)
  Unit cur, nxt; int ui = 0;
  if (!S.next(0, cur)) return;
  f32x4 acc[2][2][4][2];
#pragma unroll
  for (int a = 0; a < 2; ++a)
#pragma unroll
    for (int b = 0; b < 2; ++b)
#pragma unroll
      for (int m = 0; m < 4; ++m)
#pragma unroll
        for (int n = 0; n < 2; ++n) acc[a][b][m][n] = (f32x4){0.f, 0.f, 0.f, 0.f};
  bf16x8 At[4][2], B0[2][2], B1[2][2];
  const char* cA = (const char*)gA + (size_t)cur.pm * tstep; const char* cB = (const char*)gBt + (size_t)cur.pn * tstep;
  PG8_STAGE(PG8_SB(0, 0), cB); PG8_STAGE(PG8_SA(0, 0), cA); PG8_STAGE(PG8_SB(0, 1), cB + hstep); PG8_STAGE(PG8_SA(0, 1), cA + hstep);
  if (wr == 1) PG8_BAR;
  PG8_WAIT_V(4); PG8_BAR;
  PG8_STAGE(PG8_SB(1, 0), cB + kstep); PG8_STAGE(PG8_SA(1, 0), cA + kstep); PG8_STAGE(PG8_SB(1, 1), cB + hstep + kstep);
  PG8_WAIT_V(6); PG8_BAR;
  for (;;) {
    const bool has_next = S.next(ui + 1, nxt);
    const char* nA = has_next ? (const char*)gA + (size_t)nxt.pm * tstep : cA; const char* nB = has_next ? (const char*)gBt + (size_t)nxt.pn * tstep : cB;
    for (int t = 0; t < nt; t += 2) {
      const bool last = (t == nt - 2);
      const char* a1 = cA + (size_t)(t + 1) * kstep;
      const char* a2 = last ? nA : cA + (size_t)(t + 2) * kstep; const char* b2 = last ? nB : cB + (size_t)(t + 2) * kstep;
      const char* a3 = a2 + kstep; const char* b3 = b2 + kstep;
      PG8_LDB(B0, 0, 0); PG8_SCHED; PG8_LDA(At, 0, 0); PG8_STAGE(PG8_SA(1, 1), a1 + hstep);
      PG8_WAIT_L(8); PG8_BAR; PG8_WAIT_L(0); PG8_MMA(0, 0, At, B0); PG8_BAR; PG8_SCHED;
      PG8_LDB(B1, 0, 1); PG8_STAGE(PG8_SB(0, 0), b2);
      PG8_BAR; PG8_WAIT_L(0); PG8_MMA(0, 1, At, B1); PG8_BAR;
      PG8_LDA(At, 0, 1); PG8_STAGE(PG8_SA(0, 0), a2);
      PG8_BAR; PG8_WAIT_L(0); PG8_MMA(1, 0, At, B0); PG8_BAR; PG8_SCHED;
      PG8_STAGE(PG8_SB(0, 1), b2 + hstep);
      PG8_WAIT_V(6); PG8_BAR; PG8_MMA(1, 1, At, B1); PG8_BAR;
      PG8_LDB(B0, 1, 0); PG8_SCHED; PG8_LDA(At, 1, 0); PG8_STAGE(PG8_SA(0, 1), a2 + hstep);
      PG8_WAIT_L(8); PG8_BAR; PG8_WAIT_L(0); PG8_MMA(0, 0, At, B0); PG8_BAR; PG8_SCHED;
      PG8_LDB(B1, 1, 1); PG8_STAGE(PG8_SB(1, 0), b3);
      PG8_BAR; PG8_WAIT_L(0); PG8_MMA(0, 1, At, B1); PG8_BAR;
      PG8_LDA(At, 1, 1); PG8_STAGE(PG8_SA(1, 0), a3);
      PG8_BAR; PG8_WAIT_L(0); PG8_MMA(1, 0, At, B0); PG8_BAR; PG8_SCHED;
      PG8_STAGE(PG8_SB(1, 1), b3 + hstep);
      PG8_WAIT_V(6); PG8_BAR; PG8_MMA(1, 1, At, B1); PG8_BAR;
    }
    {
      int fr2 = fr, fq2 = fq; Unit cu = cur;
      asm volatile("" : "+v"(fr2), "+v"(fq2), "+s"(cu.pm), "+s"(cu.pn));
      E(acc, cu, wr, wc, fr2, fq2);
    }
    if (!has_next) break;
#pragma unroll
    for (int a = 0; a < 2; ++a)
#pragma unroll
      for (int b = 0; b < 2; ++b)
#pragma unroll
        for (int m = 0; m < 4; ++m)
#pragma unroll
          for (int n = 0; n < 2; ++n) acc[a][b][m][n] = (f32x4){0.f, 0.f, 0.f, 0.f};
    cur = nxt; cA = nA; cB = nB; ++ui;
  }
  PG8_WAIT_V(0);
  if (wr == 0) PG8_BAR;
  PG8_BAR;
#undef PG8_SA
#undef PG8_SB
#undef PG8_STAGE
#undef PG8_LDA
#undef PG8_LDB
#undef PG8_MMA
#undef PG8_WAIT_V
#undef PG8_WAIT_L
#undef PG8_BAR
#undef PG8_SCHED
}
}

typedef f32x4 AccT[2][2][4][2];
DI void st_nt4(float* p_, f32x4 v_) { __builtin_nontemporal_store(v_, (f32x4*)p_); }
DI float dot4(f32x4 a) { return a[0] * a[0] + a[1] * a[1] + a[2] * a[2] + a[3] * a[3]; }
DI float rowsum_q(float v) { v += __shfl_xor(v, 16); v += __shfl_xor(v, 32); return v; }
DI void st_bf8(u16* p, f32x4 a, f32x4 b) {
  u32x4 w; w.x = cvtpk(a[0], a[1]); w.y = cvtpk(a[2], a[3]); w.z = cvtpk(b[0], b[1]); w.w = cvtpk(b[2], b[3]);
  *(u32x4*)p = w;
}

struct EpiIn {
  const Params& p; int l;
  DI void operator()(const AccT& acc, const pg8::Unit& u, int wr, int wc, int fr, int fq) const {
    const int wcb = u.pn * 4 + wc;
    if (wcb > 36) return;
    const bool is_ctx = u.pm < 32;
    const int r0 = u.pm * 256 + wr * 64 + fr;
    int b, s0;
    if (is_ctx) { b = u.pm; s0 = wr * 64 + fr; }
    else { const int tl = r0 - TCTX; b = tl >> 10; s0 = tl & 1023; }
    const int c8 = 8 * fq;
    if (wcb < 4) {
#pragma unroll
      for (int ai = 0; ai < 2; ++ai)
#pragma unroll
        for (int m = 0; m < 4; ++m) {
          asm volatile("" ::: "memory");
          float* rp = p.cq + (size_t)(r0 + ai * 128 + m * 16) * 256 + wcb * 64 + c8;
#pragma unroll
          for (int bj = 0; bj < 2; ++bj)
#pragma unroll
            for (int n = 0; n < 2; ++n) *(f32x4*)(rp + bj * 32 + 4 * n) = acc[ai][bj][m][n];
        }
    } else if (wcb < 6) {
#pragma unroll
      for (int ai = 0; ai < 2; ++ai)
#pragma unroll
        for (int m = 0; m < 4; ++m) {
          asm volatile("" ::: "memory");
          float* rp = p.ckv + (size_t)(r0 + ai * 128 + m * 16) * 128 + (wcb - 4) * 64 + c8;
#pragma unroll
          for (int bj = 0; bj < 2; ++bj)
#pragma unroll
            for (int n = 0; n < 2; ++n) *(f32x4*)(rp + bj * 32 + 4 * n) = acc[ai][bj][m][n];
        }
    } else if (wcb < 18) {
      const bool isq = wcb < 12;
      const int hd = isq ? wcb - 6 : wcb - 12;
      const float* g = (isq ? p.g_na_q : p.g_na_k) + l * 64 + c8;
      f32x4 gv[2][2];
#pragma unroll
      for (int bj = 0; bj < 2; ++bj)
#pragma unroll
        for (int n = 0; n < 2; ++n) gv[bj][n] = *(const f32x4*)(g + bj * 32 + 4 * n);
#pragma unroll
      for (int ai = 0; ai < 2; ++ai)
#pragma unroll
        for (int m = 0; m < 4; ++m) {
          asm volatile("" ::: "memory");
          float ss = dot4(acc[ai][0][m][0]) + dot4(acc[ai][0][m][1]) + dot4(acc[ai][1][m][0]) + dot4(acc[ai][1][m][1]);
          ss = rowsum_q(ss);
          const float rstd = rsqrtf(ss * (1.f / 64.f) + EPS) * (isq ? 0.18033688011112042f : 1.f);
          const int t = r0 + ai * 128 + m * 16, s = s0 + ai * 128 + m * 16;
          f32x4 v[2][2];
#pragma unroll
          for (int bj = 0; bj < 2; ++bj)
#pragma unroll
            for (int n = 0; n < 2; ++n) v[bj][n] = acc[ai][bj][m][n] * rstd * gv[bj][n];
          if (isq) {
            u16* qp = p.qna + (size_t)t * 384 + hd * 64 + c8;
            st_bf8(qp, v[0][0], v[0][1]); st_bf8(qp + 32, v[1][0], v[1][1]);
          } else if (is_ctx) {
            float* op = p.out + OUT_NAK + ((size_t)((b * 2 + l) * 6 + hd) * 256 + s) * 64 + c8;
            st_nt4(op, v[0][0]); st_nt4(op + 4, v[0][1]); st_nt4(op + 32, v[1][0]); st_nt4(op + 36, v[1][1]);
            u16* kp = p.kna_c + (size_t)(b * 6 + hd) * (256 * 64);
            st_bf8(kp + kf_off(s, c8, 4), v[0][0], v[0][1]); st_bf8(kp + kf_off(s, 32 + c8, 4), v[1][0], v[1][1]);
          } else {
            u16* kp = p.kna_l + (size_t)l * (2 * 6 * NKL * 64) + (size_t)(b * 6 + hd) * (NKL * 64);
            st_bf8(kp + kf_off(256 + s, c8, 4), v[0][0], v[0][1]); st_bf8(kp + kf_off(256 + s, 32 + c8, 4), v[1][0], v[1][1]);
          }
        }
    } else if (wcb < 24 || (wcb >= 32 && wcb < 36)) {
      const bool isna = wcb < 24;
      const int hd = isna ? wcb - 18 : wcb - 32;
      const int nh = isna ? 6 : 4;
      const int vh = isna ? hd : 6 + hd;
      float* ob = p.out + (isna ? OUT_NAV : OUT_DFV) + ((size_t)((b * 2 + l) * nh + hd) * 256) * 64 + c8;
      u16* vb = is_ctx ? (isna ? p.vna_c : p.vdf_c) + (size_t)(b * nh + hd) * (64 * 256)
                       : (isna ? p.vna_l : p.vdf_l) + (size_t)l * (2 * nh * 64 * NKL) + (size_t)(b * nh + hd) * (64 * NKL);
      (void)vh;
#pragma unroll
      for (int ai = 0; ai < 2; ++ai)
#pragma unroll
        for (int m = 0; m < 4; ++m) {
          asm volatile("" ::: "memory");
          const int s = s0 + ai * 128 + m * 16;
          u16* vk = vb + vf_off((is_ctx ? 0 : 256) + s, c8);
#pragma unroll
          for (int bj = 0; bj < 2; ++bj)
#pragma unroll
            for (int n = 0; n < 2; ++n) {
              const unsigned lo = cvtpk(acc[ai][bj][m][n][0], acc[ai][bj][m][n][1]), hi = cvtpk(acc[ai][bj][m][n][2], acc[ai][bj][m][n][3]);
              u16* q = vk + bj * 512 + n * 32;
              q[0] = (u16)(lo & 0xffffu); q[8] = (u16)(lo >> 16); q[16] = (u16)(hi & 0xffffu); q[24] = (u16)(hi >> 16);
            }
          if (is_ctx) {
            float* op = ob + (size_t)s * 64;
            st_nt4(op, acc[ai][0][m][0]); st_nt4(op + 4, acc[ai][0][m][1]); st_nt4(op + 32, acc[ai][1][m][0]); st_nt4(op + 36, acc[ai][1][m][1]);
          }
        }
    } else if (wcb < 32) {
      const bool isq = wcb < 28;
      const int hd = isq ? wcb - 24 : wcb - 28;
      const float* g = (isq ? p.g_df_q : p.g_df_k) + l * 32 + c8;
      const f32x4 g0 = *(const f32x4*)(g), g1 = *(const f32x4*)(g + 4);
      const int ra = fq >> 1, half = fq & 1;
#pragma unroll
      for (int ai = 0; ai < 2; ++ai)
#pragma unroll
        for (int m = 0; m < 4; ++m) {
          asm volatile("" ::: "memory");
          const int t = r0 + ai * 128 + m * 16, s = s0 + ai * 128 + m * 16;
          f32x4 v[2][2];
#pragma unroll
          for (int bj = 0; bj < 2; ++bj) {
            float ss = dot4(acc[ai][bj][m][0]) + dot4(acc[ai][bj][m][1]);
            ss = rowsum_q(ss);
            const float rstd = rsqrtf(ss * (1.f / 32.f) + EPS) * (isq ? 0.25503486164919736f : 1.f);
            v[bj][0] = acc[ai][bj][m][0] * rstd * g0;
            v[bj][1] = acc[ai][bj][m][1] * rstd * g1;
          }
          if (!is_ctx) {
            const float pos = ra ? (float)(s & 63) : (float)(s >> 6);
#pragma unroll
            for (int bj = 0; bj < 2; ++bj)
#pragma unroll
              for (int n = 0; n < 2; ++n)
#pragma unroll
                for (int e = 0; e < 4; ++e) {
                  const int i = 4 * n + e;
                  const float inv = (i == 0) ? 1.0f : (i == 1) ? 0.31622776601683794f : (i == 2) ? 0.1f : (i == 3) ? 0.031622776601683794f
                                  : (i == 4) ? 0.01f : (i == 5) ? 0.0031622776601683794f : (i == 6) ? 0.001f : 0.00031622776601683794f;
                  const float ang = pos * inv;
                  const float cs = __cosf(ang), sn = __sinf(ang);
                  const float x = v[bj][n][e];
                  const float partner = __shfl_xor(x, 16);
                  v[bj][n][e] = x * cs + (half ? partner : -partner) * sn;
                }
          }
          if (isq) {
            u16* qp = p.qdf + (size_t)t * 256 + hd * 64 + c8;
            st_bf8(qp, v[0][0], v[0][1]); st_bf8(qp + 32, v[1][0], v[1][1]);
          } else if (is_ctx) {
            float* op = p.out + OUT_DFK + ((size_t)((b * 2 + l) * 4 + hd) * 256 + s) * 64 + c8;
            st_nt4(op, v[0][0]); st_nt4(op + 4, v[0][1]); st_nt4(op + 32, v[1][0]); st_nt4(op + 36, v[1][1]);
            u16* kp = p.kdf_c + (size_t)(b * 4 + hd) * (256 * 64);
            st_bf8(kp + kf_off(s, c8, 4), v[0][0], v[0][1]); st_bf8(kp + kf_off(s, 32 + c8, 4), v[1][0], v[1][1]);
          } else {
            u16* kp = p.kdf_l + (size_t)l * (2 * 4 * NKL * 64) + (size_t)(b * 4 + hd) * (NKL * 64);
            st_bf8(kp + kf_off(256 + s, c8, 4), v[0][0], v[0][1]); st_bf8(kp + kf_off(256 + s, 32 + c8, 4), v[1][0], v[1][1]);
          }
        }
    } else {
#pragma unroll
      for (int ai = 0; ai < 2; ++ai)
#pragma unroll
        for (int m = 0; m < 4; ++m) {
          asm volatile("" ::: "memory");
          const int t = r0 + ai * 128 + m * 16, s = s0 + ai * 128 + m * 16;
          float* kp = p.krope + (size_t)t * 32 + c8;
          *(f32x4*)(kp) = acc[ai][0][m][0]; *(f32x4*)(kp + 4) = acc[ai][0][m][1];
          if (is_ctx) {
            float* op = p.out + OUT_KROPE + ((size_t)(b * 2 + l) * 256 + s) * 32 + c8;
            st_nt4(op, acc[ai][0][m][0]); st_nt4(op + 4, acc[ai][0][m][1]);
          }
        }
    }
  }
};

template <int WHICH  >
struct EpiRes {
  const Params& p; int l;
  DI void operator()(const AccT& acc, const pg8::Unit& u, int wr, int wc, int fr, int fq) const {
    const int cond = u.pm < 32 ? 0 : 1 + ((u.pm - 32) >> 2);
    const int c0 = u.pn * 256 + wc * 64 + 8 * fq;
    const float* gate = p.mod + (size_t)((l * 3 + cond) * 6 + (WHICH == 0 ? 2 : 5)) * D + c0;
    f32x4 gv[2][2];
#pragma unroll
    for (int bj = 0; bj < 2; ++bj)
#pragma unroll
      for (int n = 0; n < 2; ++n) gv[bj][n] = *(const f32x4*)(gate + bj * 32 + 4 * n);
    u16* dsth = (WHICH == 0) ? p.xa : p.xb;
    const bool to_out = (WHICH == 1 && l == 1);
#pragma unroll
    for (int ai = 0; ai < 2; ++ai)
#pragma unroll
      for (int mh = 0; mh < 2; ++mh) {
        f32x4 xi[2][2][2];
#pragma unroll
        for (int mm = 0; mm < 2; ++mm) {
          const int m = mh * 2 + mm;
          const int t = u.pm * 256 + ai * 128 + wr * 64 + m * 16 + fr;
          const ResSrc xin = (WHICH == 0) ? xrow_in(p, l, t) : xa_row(p, t);
#pragma unroll
          for (int bj = 0; bj < 2; ++bj)
#pragma unroll
            for (int n = 0; n < 2; ++n) xi[mm][bj][n] = res_ld4(xin, c0 + bj * 32 + 4 * n);
        }
#pragma unroll
        for (int mm = 0; mm < 2; ++mm) {
          const int m = mh * 2 + mm;
          const int t = u.pm * 256 + ai * 128 + wr * 64 + m * 16 + fr;
          if (to_out) {
            float* xo = p.out + (size_t)t * D + c0;
#pragma unroll
            for (int bj = 0; bj < 2; ++bj)
#pragma unroll
              for (int n = 0; n < 2; ++n) st_nt4(xo + bj * 32 + 4 * n, xi[mm][bj][n] + gv[bj][n] * acc[ai][bj][m][n]);
          } else {
            u16* xo = dsth + (size_t)t * D + c0;
#pragma unroll
            for (int bj = 0; bj < 2; ++bj)
              st_bf8(xo + bj * 32, xi[mm][bj][0] + gv[bj][0] * acc[ai][bj][m][0], xi[mm][bj][1] + gv[bj][1] * acc[ai][bj][m][1]);
          }
        }
      }
  }
};

struct EpiGU {
  const Params& p;
  DI void operator()(const AccT& acc, const pg8::Unit& u, int wr, int wc, int fr, int fq) const {
    const int f0 = u.pn * 128 + wc * 32 + 8 * fq;
#pragma unroll
    for (int ai = 0; ai < 2; ++ai)
#pragma unroll
      for (int m = 0; m < 4; ++m) {
        const int t = u.pm * 256 + ai * 128 + wr * 64 + m * 16 + fr;
        f32x4 o[2];
#pragma unroll
        for (int n = 0; n < 2; ++n)
#pragma unroll
          for (int e = 0; e < 4; ++e) {
            const float gvv = acc[ai][0][m][n][e], uv = acc[ai][1][m][n][e];
            o[n][e] = gvv * __builtin_amdgcn_rcpf(1.f + __builtin_amdgcn_exp2f(-1.4426950408889634f * gvv)) * uv;
          }
        st_bf8(p.act + (size_t)t * DFF + f0, o[0], o[1]);
      }
  }
};

DI void mla_q_load(const Params& p, int l, int tb, bf16x8 (&bfr)[16], float& rstd) {
  const int lane = TIDX & 63, l31 = lane & 31, hh = lane >> 5;
  const int tok = tb * 32 + l31;
  const float* cqrow = p.cq + (size_t)tok * 256;
  const float* gq = p.g_qa + l * 256;
  float ss = 0.f;
#pragma unroll
  for (int ks = 0; ks < 16; ++ks) {
    const int k = ks * 16 + 8 * hh;
    const float4 a = *(const float4*)(cqrow + k), b2 = *(const float4*)(cqrow + k + 4);
    const float4 ga = *(const float4*)(gq + k), gb = *(const float4*)(gq + k + 4);
    ss += a.x * a.x + a.y * a.y + a.z * a.z + a.w * a.w + b2.x * b2.x + b2.y * b2.y + b2.z * b2.z + b2.w * b2.w;
    bfr[ks] = pack8(a.x * ga.x, a.y * ga.y, a.z * ga.z, a.w * ga.w, b2.x * gb.x, b2.y * gb.y, b2.z * gb.z, b2.w * gb.w);
  }
  ss += __shfl_xor(ss, 32);
  rstd = rsqrtf(ss * (1.f / 256.f) + EPS);
}

DI void mla_q_compute(const Params& p, int l, int tb, int h, const LAS unsigned char* wl, const bf16x8 (&bfr)[16], float rstd) {
  const int lane = TIDX & 63, l31 = lane & 31, hh = lane >> 5;
  const int tok = tb * 32 + l31;
  float4 gq2[3][4];
#pragma unroll
  for (int nt = 0; nt < 3; ++nt)
#pragma unroll
    for (int gi = 0; gi < 4; ++gi) gq2[nt][gi] = *(const float4*)(p.g_mla_q + l * 96 + nt * 32 + 8 * gi + 4 * hh);
  f32x16 acc[3];
  const LAS unsigned char* W = wl + lane * 16;
#pragma unroll
  for (int nt = 0; nt < 3; ++nt) {
#pragma unroll
    for (int r = 0; r < 16; ++r) acc[nt][r] = 0.f;
#pragma unroll
    for (int ks = 0; ks < 16; ++ks) {
      const bf16x8 wf = *(const LAS bf16x8*)(W + (nt * 16 + ks) * 1024);
      acc[nt] = mfma32(wf, bfr[ks], acc[nt]);
    }
  }
  float s2 = 0.f;
#pragma unroll
  for (int nt = 0; nt < 3; ++nt)
#pragma unroll
    for (int r = 0; r < 16; ++r) { acc[nt][r] *= rstd; s2 += acc[nt][r] * acc[nt][r]; }
  s2 += __shfl_xor(s2, 32);
  const float rstd2 = rsqrtf(s2 * (1.f / 96.f) + EPS) * 0.14724444602590306f;
#pragma unroll
  for (int nt = 0; nt < 3; ++nt)
#pragma unroll
    for (int gi = 0; gi < 4; ++gi) {
      const float4 gg = gq2[nt][gi];
      acc[nt][4 * gi + 0] *= rstd2 * gg.x; acc[nt][4 * gi + 1] *= rstd2 * gg.y;
      acc[nt][4 * gi + 2] *= rstd2 * gg.z; acc[nt][4 * gi + 3] *= rstd2 * gg.w;
    }
  if (tok >= TCTX) rope32(acc[2], (tok - TCTX) & 1023, hh);
  u16* qo = p.qmla + (size_t)tok * 576 + h * 96 + 4 * hh;
#pragma unroll
  for (int nt = 0; nt < 3; ++nt)
#pragma unroll
    for (int gi = 0; gi < 4; ++gi)
      st_bf4(qo + nt * 32 + 8 * gi, acc[nt][4 * gi], acc[nt][4 * gi + 1], acc[nt][4 * gi + 2], acc[nt][4 * gi + 3]);
}

struct KvRow { const float* csrc; const float* krsrc; int b, s; bool is_tok, is_ctx; };
DI KvRow kv_row(const Params& p, int l, int rb) {
  const int lane = TIDX & 63, l31 = lane & 31;
  const int row = rb * 32 + l31;
  KvRow r;
  r.is_tok = row < T;
  r.is_ctx = row < TCTX;
  if (r.is_tok) {
    r.csrc = p.ckv + (size_t)row * 128;
    r.krsrc = p.krope + (size_t)row * 32;
    if (r.is_ctx) { r.b = row >> 8; r.s = row & 255; }
    else { r.b = (row - TCTX) >> 10; r.s = (row - TCTX) & 1023; }
  } else {
    const int rr = row - T;
    r.b = rr >> 8; r.s = rr & 255;
    r.csrc = p.cache_mla_ckv + ((size_t)(r.b * 2 + l) * 256 + r.s) * 128;
    r.krsrc = p.cache_mla_krope + ((size_t)(r.b * 2 + l) * 256 + r.s) * 32;
  }
  return r;
}

DI void mla_kv_load(const Params& p, int l, int rb, bf16x8 (&bfr)[8], float& rstd) {
  const int lane = TIDX & 63, hh = lane >> 5;
  const KvRow R = kv_row(p, l, rb);
  const float* gk = p.g_kva + l * 128;
  float ss = 0.f;
#pragma unroll
  for (int ks = 0; ks < 8; ++ks) {
    const int k = ks * 16 + 8 * hh;
    const float4 a = *(const float4*)(R.csrc + k), b2 = *(const float4*)(R.csrc + k + 4);
    float4 ga = make_float4(1.f, 1.f, 1.f, 1.f), gb = ga;
    if (R.is_tok) { ga = *(const float4*)(gk + k); gb = *(const float4*)(gk + k + 4); }
    ss += a.x * a.x + a.y * a.y + a.z * a.z + a.w * a.w + b2.x * b2.x + b2.y * b2.y + b2.z * b2.z + b2.w * b2.w;
    bfr[ks] = pack8(a.x * ga.x, a.y * ga.y, a.z * ga.z, a.w * ga.w, b2.x * gb.x, b2.y * gb.y, b2.z * gb.z, b2.w * gb.w);
  }
  ss += __shfl_xor(ss, 32);
  rstd = R.is_tok ? rsqrtf(ss * (1.f / 128.f) + EPS) : 1.f;
}

DI void mla_kv_compute(const Params& p, int l, int rb, int h, const LAS unsigned char* wl, const bf16x8 (&bfr)[8], float rstd) {
  const int lane = TIDX & 63, hh = lane >> 5;
  const KvRow R = kv_row(p, l, rb);
  const bool is_tok = R.is_tok, is_ctx = R.is_ctx;
  const int b = R.b, s = R.s;
  const float* gk = p.g_kva + l * 128;
  f32x16 kr;
#pragma unroll
  for (int gi = 0; gi < 4; ++gi) {
    const float4 v = *(const float4*)(R.krsrc + 8 * gi + 4 * hh);
    kr[4 * gi] = v.x; kr[4 * gi + 1] = v.y; kr[4 * gi + 2] = v.z; kr[4 * gi + 3] = v.w;
  }
  const float* g = p.g_mla_k + l * 96;
  float4 gk0[4], gk1[4], gk2[4];
#pragma unroll
  for (int gi = 0; gi < 4; ++gi) {
    gk0[gi] = *(const float4*)(g + 8 * gi + 4 * hh); gk1[gi] = *(const float4*)(g + 32 + 8 * gi + 4 * hh); gk2[gi] = *(const float4*)(g + 64 + 8 * gi + 4 * hh);
  }
  f32x16 acc[4];
  const LAS unsigned char* W = wl + lane * 16;
#pragma unroll
  for (int nt = 0; nt < 4; ++nt) {
#pragma unroll
    for (int r = 0; r < 16; ++r) acc[nt][r] = 0.f;
#pragma unroll
    for (int ks = 0; ks < 8; ++ks) {
      const bf16x8 wf = *(const LAS bf16x8*)(W + (nt * 8 + ks) * 1024);
      acc[nt] = mfma32(wf, bfr[ks], acc[nt]);
    }
  }
  float sk = 0.f;
#pragma unroll
  for (int nt = 0; nt < 4; ++nt)
#pragma unroll
    for (int r = 0; r < 16; ++r) acc[nt][r] *= rstd;
#pragma unroll
  for (int r = 0; r < 16; ++r) sk += acc[0][r] * acc[0][r] + acc[1][r] * acc[1][r] + kr[r] * kr[r];
  sk += __shfl_xor(sk, 32);
  const float rstdk = rsqrtf(sk * (1.f / 96.f) + EPS);
#pragma unroll
  for (int gi = 0; gi < 4; ++gi) {
    const float4 g0 = gk0[gi], g1 = gk1[gi], g2 = gk2[gi];
    acc[0][4 * gi] *= rstdk * g0.x; acc[0][4 * gi + 1] *= rstdk * g0.y; acc[0][4 * gi + 2] *= rstdk * g0.z; acc[0][4 * gi + 3] *= rstdk * g0.w;
    acc[1][4 * gi] *= rstdk * g1.x; acc[1][4 * gi + 1] *= rstdk * g1.y; acc[1][4 * gi + 2] *= rstdk * g1.z; acc[1][4 * gi + 3] *= rstdk * g1.w;
    kr[4 * gi] *= rstdk * g2.x; kr[4 * gi + 1] *= rstdk * g2.y; kr[4 * gi + 2] *= rstdk * g2.z; kr[4 * gi + 3] *= rstdk * g2.w;
  }
  if (is_tok && !is_ctx) rope32(kr, s, hh);
  u16 *kd, *vd;
  int kidx;
  if (is_ctx) {
    kidx = s;
    kd = p.kmla_c + (size_t)(b * 6 + h) * (256 * 96);
    vd = p.vmla_c + (size_t)(b * 6 + h) * (64 * 256);
  } else {
    kidx = is_tok ? 256 + s : s;
    kd = p.kmla_l + (size_t)l * (2 * 6 * NKL * 96) + (size_t)(b * 6 + h) * (NKL * 96);
    vd = p.vmla_l + (size_t)l * (2 * 6 * 64 * NKL) + (size_t)(b * 6 + h) * (64 * NKL);
  }
#pragma unroll
  for (int gi = 0; gi < 4; ++gi) {
    st_bf4(kd + kf_off(kidx, 8 * gi, 6) + 4 * hh, acc[0][4 * gi], acc[0][4 * gi + 1], acc[0][4 * gi + 2], acc[0][4 * gi + 3]);
    st_bf4(kd + kf_off(kidx, 32 + 8 * gi, 6) + 4 * hh, acc[1][4 * gi], acc[1][4 * gi + 1], acc[1][4 * gi + 2], acc[1][4 * gi + 3]);
    st_bf4(kd + kf_off(kidx, 64 + 8 * gi, 6) + 4 * hh, kr[4 * gi], kr[4 * gi + 1], kr[4 * gi + 2], kr[4 * gi + 3]);
  }
#pragma unroll
  for (int nt = 0; nt < 2; ++nt)
#pragma unroll
    for (int r = 0; r < 16; ++r) {
      const int d = nt * 32 + (r & 3) + 8 * (r >> 2) + 4 * hh;
      vd[vf_off(kidx, d)] = f2bf(acc[2 + nt][r]);
    }
  if (is_ctx && h == 0) {
    float* ob = p.out + OUT_CKV + ((size_t)(b * 2 + l) * 256 + s) * 128;
    float4 oa[8], obv[8];
#pragma unroll
    for (int ks = 0; ks < 8; ++ks) {
      const int k = ks * 16 + 8 * hh;
      const float4 a = *(const float4*)(R.csrc + k), b2 = *(const float4*)(R.csrc + k + 4);
      const float4 ga = *(const float4*)(gk + k), gb = *(const float4*)(gk + k + 4);
      oa[ks] = make_float4(a.x * rstd * ga.x, a.y * rstd * ga.y, a.z * rstd * ga.z, a.w * rstd * ga.w);
      obv[ks] = make_float4(b2.x * rstd * gb.x, b2.y * rstd * gb.y, b2.z * rstd * gb.z, b2.w * rstd * gb.w);
    }
#pragma unroll
    for (int ks = 0; ks < 8; ++ks) {
      const int k = ks * 16 + 8 * hh;
      st_nt4(ob + k, (f32x4){oa[ks].x, oa[ks].y, oa[ks].z, oa[ks].w});
      st_nt4(ob + k + 4, (f32x4){obv[ks].x, obv[ks].y, obv[ks].z, obv[ks].w});
    }
  }
}

DI void phase_mla_up(const Params& p, int l, char* lds) {
  const int tid = TIDX, lane = tid & 63, w = __builtin_amdgcn_readfirstlane(tid >> 6);
  LAS unsigned char* ldsl = (LAS unsigned char*)lds;
  const int nslot = ((int)gridDim.x + 7) >> 3;
  for (int it0 = (BIDX & 7) * nslot + (BIDX >> 3); it0 < 252 + 8 * nslot; it0 += 8 * nslot) {
    const int item = it0;
    if (item >= 252 || (BIDX >> 3) >= nslot) break;
    __syncthreads();
    const bool hasq = item < 240;
    const int h = item % 6, grp = item / 6;
    if (hasq) {
      const u16* wsrc = p.wuq_t + (size_t)l * 576 * 256 + (size_t)(h * 3) * (16 * 512) + lane * 8;
#pragma unroll
      for (int i = 0; i < 6; ++i) {
        const int blk = w + 8 * i;
        __builtin_amdgcn_global_load_lds((const unsigned*)(wsrc + blk * 512), (LAS unsigned*)(ldsl + blk * 1024), 16, 0, 0);
      }
    }
    {
      const u16* wsrc = p.wukv_t + (size_t)l * 768 * 128 + (size_t)(h * 4) * (8 * 512) + lane * 8;
#pragma unroll
      for (int i = 0; i < 4; ++i) {
        const int blk = w + 8 * i;
        __builtin_amdgcn_global_load_lds((const unsigned*)(wsrc + blk * 512), (LAS unsigned*)(ldsl + 49152 + blk * 1024), 16, 0, 0);
      }
    }
    bf16x8 bq[16], bk[8];
    float rq = 1.f, rk = 1.f;
    if (hasq) mla_q_load(p, l, grp * 8 + w, bq, rq);
    mla_kv_load(p, l, grp * 8 + w, bk, rk);
    asm volatile("s_waitcnt vmcnt(0)" ::: "memory");
    __syncthreads();
    if (hasq) mla_q_compute(p, l, grp * 8 + w, h, ldsl, bq, rq);
    mla_kv_compute(p, l, grp * 8 + w, h, ldsl + 49152, bk, rk);
  }
}

constexpr int ATT_NST = 8, ATT_STB = 10240, ATT_RPB_OFF = ATT_NST * ATT_STB;
#define ATT_BAR() do { __builtin_amdgcn_s_barrier(); asm volatile("" ::: "memory"); } while (0)

template <int NDK>
DI void att_issue(LAS unsigned char* lds, const u16* Kb, const u16* Vb, int kt, int st, int w, int lane) {
#pragma unroll
  for (int i = 0; i < 2; ++i) {
    const int j = w + 8 * i;
    if (j < NDK + 4) {
      const u16* src = (j < NDK) ? Kb + (size_t)kt * (NDK * 512) + j * 512 : Vb + (size_t)kt * 2048 + (j - NDK) * 512;
      const int dst = st * ATT_STB + ((j < NDK) ? j * 1024 : 6144 + (j - NDK) * 1024);
      __builtin_amdgcn_global_load_lds((const unsigned*)(src + lane * 8), (LAS unsigned*)(lds + dst), 16, 0, 0);
    }
  }
}

template <int DQK, int MODE>
DI void attn_block_single(LAS unsigned char* lds, const u16* __restrict__ Kb, const u16* __restrict__ Vb, const u16* __restrict__ qrow,
                          u16* __restrict__ orow, float scale, int ntiles, int r, int qc, int rs0) {
  const int tid = TIDX, lane = tid & 63, w = __builtin_amdgcn_readfirstlane(tid >> 6), hh = lane >> 5;
  constexpr int NDK = DQK / 16;
  const int nl = (w + 8 < NDK + 4) ? 2 : 1;
#define ATT_KT(t_) ((MODE == 1 && (t_) >= 8) ? 8 + (rs0 + (((t_) - 8) >> 1)) * 2 + (((t_) - 8) & 1) : (t_))
  for (int tt = 0; tt < ATT_NST - 1; ++tt) { const int tc = min(tt, ntiles - 1); att_issue<NDK>(lds, Kb, Vb, ATT_KT(tc), tt, w, lane); }
  bf16x8 qf[NDK];
#pragma unroll
  for (int dk = 0; dk < NDK; ++dk) qf[dk] = *(const bf16x8*)(qrow + dk * 16 + 8 * hh);
#pragma unroll
  for (int dk = 0; dk < NDK; ++dk) asm volatile("" :: "v"(qf[dk]));
  f32x16 o0, o1;
#pragma unroll
  for (int i = 0; i < 16; ++i) { o0[i] = 0.f; o1[i] = 0.f; }
  float mrun = -1e30f, lsum = 0.f;
  int rs = 0, cs = 0;
  if (MODE == 1) { rs = min(max(r - 4, 0), 8); cs = min(max(qc - 8, 0), 48); }
  const LAS float* rpbl = (const LAS float*)(lds + ATT_RPB_OFF);
  for (int t = 0; t < ntiles; ++t) {
    if (nl == 2) asm volatile("s_waitcnt vmcnt(12)" ::: "memory"); else asm volatile("s_waitcnt vmcnt(6)" ::: "memory");
    ATT_BAR();
    { const int tn = min(t + ATT_NST - 1, ntiles - 1); att_issue<NDK>(lds, Kb, Vb, ATT_KT(tn), (t + ATT_NST - 1) & (ATT_NST - 1), w, lane); }
    int jr = 0, ct = 0;
    if (MODE == 1 && t >= 8) {
      jr = rs0 + ((t - 8) >> 1) - rs; ct = (t - 8) & 1;
      if (jr < 0 || jr > 7) continue;
    }
    const LAS unsigned char* sp = lds + (t & (ATT_NST - 1)) * ATT_STB + lane * 16;
    f32x16 s;
#pragma unroll
    for (int i = 0; i < 16; ++i) s[i] = 0.f;
    __builtin_amdgcn_s_setprio(1);
#pragma unroll
    for (int dk = 0; dk < NDK; ++dk) s = mfma32(*(const LAS bf16x8*)(sp + dk * 1024), qf[dk], s);
    __builtin_amdgcn_s_setprio(0);
    const bf16x8 v00 = *(const LAS bf16x8*)(sp + 6144), v01 = *(const LAS bf16x8*)(sp + 6144 + 1024),
                 v10 = *(const LAS bf16x8*)(sp + 6144 + 2048), v11 = *(const LAS bf16x8*)(sp + 6144 + 3072);
    float tmax = -1e30f;
    if (MODE == 1 && t >= 8) {
      const LAS float* rp = rpbl + (rs + jr - r + 7) * 31;
#pragma unroll
      for (int reg = 0; reg < 16; ++reg) {
        const int kc = ct * 32 + (reg & 3) + 8 * (reg >> 2) + 4 * hh;
        const int rc = min(max(kc - qc, -15), 15) + 15;
        const float bias = rp[rc];
        const float v = (kc >= cs && kc < cs + 16) ? s[reg] + bias : -1e30f;
        s[reg] = v;
        tmax = fmaxf(tmax, v);
      }
    } else {
#pragma unroll
      for (int reg = 0; reg < 16; ++reg) tmax = fmaxf(tmax, s[reg]);
    }
    tmax = fmaxf(tmax, __shfl_xor(tmax, 32));
    const float mn = fmaxf(mrun, tmax);
    if (__builtin_amdgcn_ballot_w64(mn != mrun) != 0ull) {
      const float alpha = __builtin_amdgcn_exp2f(mrun - mn);
      lsum *= alpha;
#pragma unroll
      for (int i = 0; i < 16; ++i) { o0[i] *= alpha; o1[i] *= alpha; }
    }
    mrun = mn;
    float ps = 0.f;
#pragma unroll
    for (int reg = 0; reg < 16; ++reg) { const float pv = __builtin_amdgcn_exp2f(s[reg] - mn); s[reg] = pv; ps += pv; }
    lsum += ps;
    const bf16x8 pf0 = pack8(s[0], s[1], s[2], s[3], s[4], s[5], s[6], s[7]);
    const bf16x8 pf1 = pack8(s[8], s[9], s[10], s[11], s[12], s[13], s[14], s[15]);
    __builtin_amdgcn_s_setprio(1);
    o0 = mfma32(v00, pf0, o0);
    o1 = mfma32(v01, pf0, o1);
    o0 = mfma32(v10, pf1, o0);
    o1 = mfma32(v11, pf1, o1);
    __builtin_amdgcn_s_setprio(0);
  }
#undef ATT_KT
  asm volatile("s_waitcnt vmcnt(0)" ::: "memory");
  ATT_BAR();
  lsum += __shfl_xor(lsum, 32);
  const float inv = 1.f / lsum;
  u16* op = orow + 4 * hh;
#pragma unroll
  for (int gi = 0; gi < 4; ++gi) {
    st_bf4(op + 8 * gi, o0[4 * gi] * inv, o0[4 * gi + 1] * inv, o0[4 * gi + 2] * inv, o0[4 * gi + 3] * inv);
    st_bf4(op + 32 + 8 * gi, o1[4 * gi] * inv, o1[4 * gi + 1] * inv, o1[4 * gi + 2] * inv, o1[4 * gi + 3] * inv);
  }
}

template <int DQK>
DI void attn_block_pp(LAS unsigned char* lds, const u16* __restrict__ Kb, const u16* __restrict__ Vb, const u16* __restrict__ qrow,
                      u16* __restrict__ orow, int ntiles) {
  const int tid = TIDX, lane = tid & 63, w = __builtin_amdgcn_readfirstlane(tid >> 6), hh = lane >> 5;
  constexpr int NDK = DQK / 16;
  const int nl = (w + 8 < NDK + 4) ? 2 : 1;
  for (int tt = 0; tt < ATT_NST - 1; ++tt) att_issue<NDK>(lds, Kb, Vb, min(tt, ntiles - 1), tt, w, lane);
  bf16x8 qf[NDK];
#pragma unroll
  for (int dk = 0; dk < NDK; ++dk) qf[dk] = *(const bf16x8*)(qrow + dk * 16 + 8 * hh);
#pragma unroll
  for (int dk = 0; dk < NDK; ++dk) asm volatile("" :: "v"(qf[dk]));
  f32x16 o0, o1;
#pragma unroll
  for (int i = 0; i < 16; ++i) { o0[i] = 0.f; o1[i] = 0.f; }
  float mrun = -1e30f, lsum = 0.f;
  asm volatile("s_waitcnt vmcnt(0)" ::: "memory");
  ATT_BAR();
  f32x16 sn;
#pragma unroll
  for (int i = 0; i < 16; ++i) sn[i] = 0.f;
  {
    const LAS unsigned char* sp0 = lds + lane * 16;
#pragma unroll
    for (int dk = 0; dk < NDK; ++dk) sn = mfma32(*(const LAS bf16x8*)(sp0 + dk * 1024), qf[dk], sn);
  }
  for (int t = 0; t < ntiles; ++t) {
    if (nl == 2) asm volatile("s_waitcnt vmcnt(10)" ::: "memory"); else asm volatile("s_waitcnt vmcnt(5)" ::: "memory");
    ATT_BAR();
    { const int tn = min(t + ATT_NST - 1, ntiles - 1); att_issue<NDK>(lds, Kb, Vb, tn, (t + ATT_NST - 1) & (ATT_NST - 1), w, lane); }
    const LAS unsigned char* sp = lds + (t & (ATT_NST - 1)) * ATT_STB + lane * 16;
    const LAS unsigned char* spn = lds + ((t + 1) & (ATT_NST - 1)) * ATT_STB + lane * 16;
    f32x16 s = sn;
    const bf16x8 v00 = *(const LAS bf16x8*)(sp + 6144), v01 = *(const LAS bf16x8*)(sp + 6144 + 1024),
                 v10 = *(const LAS bf16x8*)(sp + 6144 + 2048), v11 = *(const LAS bf16x8*)(sp + 6144 + 3072);
#pragma unroll
    for (int i = 0; i < 16; ++i) sn[i] = 0.f;
#pragma unroll
    for (int dk = 0; dk < NDK; ++dk) sn = mfma32(*(const LAS bf16x8*)(spn + dk * 1024), qf[dk], sn);
    float tmax = -1e30f;
#pragma unroll
    for (int reg = 0; reg < 16; ++reg) tmax = fmaxf(tmax, s[reg]);
    tmax = fmaxf(tmax, __shfl_xor(tmax, 32));
    const float mn = fmaxf(mrun, tmax);
    {
      const float alpha = __builtin_amdgcn_exp2f(mrun - mn);
      lsum *= alpha;
#pragma unroll
      for (int i = 0; i < 16; ++i) { o0[i] *= alpha; o1[i] *= alpha; }
    }
    mrun = mn;
    float ps = 0.f;
#pragma unroll
    for (int reg = 0; reg < 16; ++reg) { const float pv = __builtin_amdgcn_exp2f(s[reg] - mn); s[reg] = pv; ps += pv; }
    lsum += ps;
    const bf16x8 pf0 = pack8(s[0], s[1], s[2], s[3], s[4], s[5], s[6], s[7]);
    const bf16x8 pf1 = pack8(s[8], s[9], s[10], s[11], s[12], s[13], s[14], s[15]);
    __builtin_amdgcn_s_setprio(1);
    o0 = mfma32(v00, pf0, o0);
    o1 = mfma32(v01, pf0, o1);
    o0 = mfma32(v10, pf1, o0);
    o1 = mfma32(v11, pf1, o1);
    __builtin_amdgcn_s_setprio(0);
  }
  asm volatile("s_waitcnt vmcnt(0)" ::: "memory");
  ATT_BAR();
  lsum += __shfl_xor(lsum, 32);
  const float inv = 1.f / lsum;
  u16* op = orow + 4 * hh;
#pragma unroll
  for (int gi = 0; gi < 4; ++gi) {
    st_bf4(op + 8 * gi, o0[4 * gi] * inv, o0[4 * gi + 1] * inv, o0[4 * gi + 2] * inv, o0[4 * gi + 3] * inv);
    st_bf4(op + 32 + 8 * gi, o1[4 * gi] * inv, o1[4 * gi + 1] * inv, o1[4 * gi + 2] * inv, o1[4 * gi + 3] * inv);
  }
}

DI void attn_block_diff(LAS unsigned char* lds, const u16* __restrict__ Kb, const u16* __restrict__ Vb, const u16* __restrict__ qrow,
                        u16* __restrict__ orow, float scale, int ntiles, float lam, const float* __restrict__ gsub, float outscale) {
  const int tid = TIDX, lane = tid & 63, w = __builtin_amdgcn_readfirstlane(tid >> 6), hh = lane >> 5;
  for (int tt = 0; tt < ATT_NST - 1; ++tt) att_issue<4>(lds, Kb, Vb, min(tt, ntiles - 1), tt, w, lane);
  bf16x8 qf[4];
#pragma unroll
  for (int dk = 0; dk < 4; ++dk) qf[dk] = *(const bf16x8*)(qrow + dk * 16 + 8 * hh);
#pragma unroll
  for (int dk = 0; dk < 4; ++dk) asm volatile("" :: "v"(qf[dk]));
  f32x16 oa0, oa1, ob0, ob1;
#pragma unroll
  for (int i = 0; i < 16; ++i) { oa0[i] = 0.f; oa1[i] = 0.f; ob0[i] = 0.f; ob1[i] = 0.f; }
  float m1 = -1e30f, l1 = 0.f, m2 = -1e30f, l2 = 0.f;
  for (int t = 0; t < ntiles; ++t) {
    asm volatile("s_waitcnt vmcnt(6)" ::: "memory");
    ATT_BAR();
    att_issue<4>(lds, Kb, Vb, min(t + ATT_NST - 1, ntiles - 1), (t + ATT_NST - 1) & (ATT_NST - 1), w, lane);
    const LAS unsigned char* sp = lds + (t & (ATT_NST - 1)) * ATT_STB + lane * 16;
    f32x16 s1, s2;
#pragma unroll
    for (int i = 0; i < 16; ++i) { s1[i] = 0.f; s2[i] = 0.f; }
    __builtin_amdgcn_s_setprio(1);
    s1 = mfma32(*(const LAS bf16x8*)(sp), qf[0], s1); s1 = mfma32(*(const LAS bf16x8*)(sp + 1024), qf[1], s1);
    s2 = mfma32(*(const LAS bf16x8*)(sp + 2048), qf[2], s2); s2 = mfma32(*(const LAS bf16x8*)(sp + 3072), qf[3], s2);
    __builtin_amdgcn_s_setprio(0);
    const bf16x8 v00 = *(const LAS bf16x8*)(sp + 6144), v10 = *(const LAS bf16x8*)(sp + 6144 + 1024),
                 v01 = *(const LAS bf16x8*)(sp + 6144 + 2048), v11 = *(const LAS bf16x8*)(sp + 6144 + 3072);
    float t1 = -1e30f, t2 = -1e30f;
#pragma unroll
    for (int reg = 0; reg < 16; ++reg) {
      t1 = fmaxf(t1, s1[reg]); t2 = fmaxf(t2, s2[reg]);
    }
    t1 = fmaxf(t1, __shfl_xor(t1, 32));
    t2 = fmaxf(t2, __shfl_xor(t2, 32));
    const float mn1 = fmaxf(m1, t1), mn2 = fmaxf(m2, t2);
    if (__builtin_amdgcn_ballot_w64(mn1 != m1) != 0ull) {
      const float a1 = __builtin_amdgcn_exp2f(m1 - mn1);
      l1 *= a1;
#pragma unroll
      for (int i = 0; i < 16; ++i) { oa0[i] *= a1; oa1[i] *= a1; }
    }
    if (__builtin_amdgcn_ballot_w64(mn2 != m2) != 0ull) {
      const float a2 = __builtin_amdgcn_exp2f(m2 - mn2);
      l2 *= a2;
#pragma unroll
      for (int i = 0; i < 16; ++i) { ob0[i] *= a2; ob1[i] *= a2; }
    }
    m1 = mn1; m2 = mn2;
    float p1 = 0.f, p2 = 0.f;
#pragma unroll
    for (int reg = 0; reg < 16; ++reg) {
      const float e1 = __builtin_amdgcn_exp2f(s1[reg] - mn1), e2 = __builtin_amdgcn_exp2f(s2[reg] - mn2);
      s1[reg] = e1; s2[reg] = e2; p1 += e1; p2 += e2;
    }
    l1 += p1; l2 += p2;
    const bf16x8 pa0 = pack8(s1[0], s1[1], s1[2], s1[3], s1[4], s1[5], s1[6], s1[7]);
    const bf16x8 pa1 = pack8(s1[8], s1[9], s1[10], s1[11], s1[12], s1[13], s1[14], s1[15]);
    const bf16x8 pb0 = pack8(s2[0], s2[1], s2[2], s2[3], s2[4], s2[5], s2[6], s2[7]);
    const bf16x8 pb1 = pack8(s2[8], s2[9], s2[10], s2[11], s2[12], s2[13], s2[14], s2[15]);
    __builtin_amdgcn_s_setprio(1);
    oa0 = mfma32(v00, pa0, oa0); oa1 = mfma32(v10, pa0, oa1);
    oa0 = mfma32(v01, pa1, oa0); oa1 = mfma32(v11, pa1, oa1);
    ob0 = mfma32(v00, pb0, ob0); ob1 = mfma32(v10, pb0, ob1);
    ob0 = mfma32(v01, pb1, ob0); ob1 = mfma32(v11, pb1, ob1);
    __builtin_amdgcn_s_setprio(0);
  }
  asm volatile("s_waitcnt vmcnt(0)" ::: "memory");
  ATT_BAR();
  l1 += __shfl_xor(l1, 32);
  l2 += __shfl_xor(l2, 32);
  const float i1 = 1.f / l1, i2 = lam / l2;
  float ss = 0.f;
#pragma unroll
  for (int i = 0; i < 16; ++i) {
    oa0[i] = oa0[i] * i1 - ob0[i] * i2;
    oa1[i] = oa1[i] * i1 - ob1[i] * i2;
    ss += oa0[i] * oa0[i] + oa1[i] * oa1[i];
  }
  ss += __shfl_xor(ss, 32);
  const float rstd = rsqrtf(ss * (1.f / 64.f) + EPS) * outscale;
  u16* op = orow + 4 * hh;
  float4 gs0[4], gs1[4];
#pragma unroll
  for (int gi = 0; gi < 4; ++gi) { gs0[gi] = *(const float4*)(gsub + 8 * gi + 4 * hh); gs1[gi] = *(const float4*)(gsub + 32 + 8 * gi + 4 * hh); }
#pragma unroll
  for (int gi = 0; gi < 4; ++gi) {
    const float4 g0 = gs0[gi], g1 = gs1[gi];
    st_bf4(op + 8 * gi, oa0[4 * gi] * rstd * g0.x, oa0[4 * gi + 1] * rstd * g0.y, oa0[4 * gi + 2] * rstd * g0.z, oa0[4 * gi + 3] * rstd * g0.w);
    st_bf4(op + 32 + 8 * gi, oa1[4 * gi] * rstd * g1.x, oa1[4 * gi + 1] * rstd * g1.y, oa1[4 * gi + 2] * rstd * g1.z, oa1[4 * gi + 3] * rstd * g1.w);
  }
}

constexpr int ATT_ITEMS = 640;
DI void phase_attn(const Params& p, int l, char* ldsg) {
  LAS unsigned char* lds = (LAS unsigned char*)ldsg;
  const int tid = TIDX, lane = tid & 63, l31 = lane & 31, w = __builtin_amdgcn_readfirstlane(tid >> 6);
  const float lam = p.lam[l];
  const float outscale = 1.f - lam_init_of(l);
  volatile LAS unsigned* slot = (volatile LAS unsigned*)(lds + 131072 + 8);
  for (;;) {
    __syncthreads();
    if (tid == 0) *slot = atomicAdd(&p.counters[l], 1u);
    __syncthreads();
    const unsigned it = __builtin_amdgcn_readfirstlane(*slot);
    if (it >= (unsigned)ATT_ITEMS) break;
    int idx = (int)it;
    if (idx < 32) {
      const int b = idx >> 4, h = (idx >> 2) & 3, qb = (idx & 3) * 8 + w;
      const int tok = TCTX + b * 1024 + qb * 32 + l31;
      attn_block_diff(lds, p.kdf_l + (size_t)l * (2 * 4 * NKL * 64) + (size_t)(b * 4 + h) * (NKL * 64),
                      p.vdf_l + (size_t)l * (2 * 4 * 64 * NKL) + (size_t)(b * 4 + h) * (64 * NKL), p.qdf + (size_t)tok * 256 + h * 64,
                      p.o + (size_t)tok * D + 768 + h * 64, 0.17677669529663687f, 40, lam, p.g_df_sub + l * 64, outscale);
      continue;
    }
    idx -= 32;
    if (idx < 48) {
      const int b = idx / 24, h = (idx >> 2) % 6, qb = (idx & 3) * 8 + w;
      const int tok = TCTX + b * 1024 + qb * 32 + l31;
      attn_block_pp<96>(lds, p.kmla_l + (size_t)l * (2 * 6 * NKL * 96) + (size_t)(b * 6 + h) * (NKL * 96),
                               p.vmla_l + (size_t)l * (2 * 6 * 64 * NKL) + (size_t)(b * 6 + h) * (64 * NKL), p.qmla + (size_t)tok * 576 + h * 96,
                               p.o + (size_t)tok * D + h * 64, 40);
      continue;
    }
    idx -= 48;
    if (idx < 48) {
      const int b = idx / 24, h = (idx >> 2) % 6, qt = idx & 3, qb = qt * 8 + w;
      const int tok = TCTX + b * 1024 + qb * 32 + l31;
      {
        const float* rg = p.na_rpb + (size_t)(l * 6 + h) * (15 * 31);
        LAS float* rl = (LAS float*)(lds + ATT_RPB_OFF);
        if (tid < 465) rl[tid] = rg[tid] * 1.4426950408889634f;
      }
      const int r0 = qt * 4;
      const int rs0 = min(max(r0 - 4, 0), 8), rs3 = min(max(r0 + 3 - 4, 0), 8);
      const int ntiles = 8 + 2 * (rs3 + 8 - rs0);
      attn_block_single<64, 1>(lds, p.kna_l + (size_t)l * (2 * 6 * NKL * 64) + (size_t)(b * 6 + h) * (NKL * 64),
                               p.vna_l + (size_t)l * (2 * 6 * 64 * NKL) + (size_t)(b * 6 + h) * (64 * NKL), p.qna + (size_t)tok * 384 + h * 64,
                               p.o + (size_t)tok * D + 384 + h * 64, 0.125f, ntiles, qb >> 1, (qb & 1) * 32 + l31, rs0);
      continue;
    }
    idx -= 48;
    if (idx < 192) {
      const int b = idx / 6, h = idx % 6;
      const int tok = b * 256 + w * 32 + l31;
      attn_block_pp<96>(lds, p.kmla_c + (size_t)(b * 6 + h) * (256 * 96), p.vmla_c + (size_t)(b * 6 + h) * (64 * 256),
                               p.qmla + (size_t)tok * 576 + h * 96, p.o + (size_t)tok * D + h * 64, 8);
      continue;
    }
    idx -= 192;
    if (idx < 192) {
      const int b = idx / 6, h = idx % 6;
      const int tok = b * 256 + w * 32 + l31;
      attn_block_pp<64>(lds, p.kna_c + (size_t)(b * 6 + h) * (256 * 64), p.vna_c + (size_t)(b * 6 + h) * (64 * 256),
                               p.qna + (size_t)tok * 384 + h * 64, p.o + (size_t)tok * D + 384 + h * 64, 8);
      continue;
    }
    idx -= 192;
    {
      const int b = idx >> 2, h = idx & 3;
      const int tok = b * 256 + w * 32 + l31;
      attn_block_diff(lds, p.kdf_c + (size_t)(b * 4 + h) * (256 * 64), p.vdf_c + (size_t)(b * 4 + h) * (64 * 256), p.qdf + (size_t)tok * 256 + h * 64,
                      p.o + (size_t)tok * D + 768 + h * 64, 0.17677669529663687f, 8, lam, p.g_df_sub + l * 64, outscale);
    }
  }
}

__global__ void __launch_bounds__(512, 2) fwd_megakernel(Params p, int ph_begin, int ph_end) {
  __shared__ __attribute__((aligned(16))) char lds[131072 + 16];
  cg::grid_group grid = cg::this_grid();
  if (ph_begin < 0) grid.sync();
  if (threadIdx.x == 0) *(uint4*)(lds + 131072) = make_uint4(0u, 0u, 0u, 0u);
  __syncthreads();
  XcdBarrier xb = xcd_barrier_post(p.bar, (volatile LAS unsigned*)(lds + 131072));
  LAS unsigned char* ldsl = (LAS unsigned char*)lds;
  for (int ph = ph_begin; ph < ph_end; ++ph) {
    if (ph > ph_begin) xcd_barrier(xb);
    if (ph == 0) { phase_prep(p, lds); continue; }
    const int l = (ph - 1) >> 3, s = (ph - 1) & 7;
    switch (s) {
      case 0: if (l == 1) prep_deferred(p, lds, 1 << 20); phase_norm(p, l, 0); break;
      case 1: { EpiIn e{p, l}; pg8::gemm_phase(ldsl, p.h, p.win_t + (size_t)l * NIN * D, T, NIN, D, e); } break;
      case 2: phase_mla_up(p, l, lds); break;
      case 3: phase_attn(p, l, lds); break;
      case 4: { EpiRes<0> e{p, l}; pg8::gemm_phase(ldsl, p.o, p.wout_t + (size_t)l * D * D, T, D, D, e); if (l == 0) prep_deferred(p, lds, BIDX >= 160 ? 4 : 0); } break;
      case 5: phase_norm(p, l, 1); break;
      case 6: { EpiGU e{p}; pg8::gemm_phase(ldsl, p.h, p.wgu_t + (size_t)l * NGU * D, T, NGU, D, e); } break;
      case 7: { EpiRes<1> e{p, l}; pg8::gemm_phase(ldsl, p.act, p.wdn_t + (size_t)l * D * DFF, T, D, DFF, e); if (l == 0) prep_deferred(p, lds, 1 << 20); } break;
    }
  }
}

extern "C" void kernel_launch(void* const* d_in, const int* in_sizes, int n_in, void* d_out, int out_size, void* d_ws, size_t ws_size,
                              hipStream_t stream) {
  static int grid_blocks = 0;
  if (!grid_blocks) {
    int dev = 0, cus = 0, per_cu = 0;
    hipGetDevice(&dev);
    hipDeviceGetAttribute(&cus, hipDeviceAttributeMultiprocessorCount, dev);
    hipOccupancyMaxActiveBlocksPerMultiprocessor(&per_cu, fwd_megakernel, 512, 0);
    if (per_cu > 1) per_cu = 1;
    if (per_cu < 1) per_cu = 1;
    grid_blocks = cus * per_cu;
  }
  Params p{};
  const float** ins = (const float**)&p;
  for (int i = 0; i < 35; ++i) ins[i] = (const float*)d_in[i];
  p.out = (float*)d_out;
  char* w = (char*)d_ws;
  size_t off = 0;
  auto alloc = [&](size_t bytes) { char* r = w + off; off += (bytes + 255) & ~(size_t)255; return r; };
  p.win_t = (u16*)alloc((size_t)2 * NIN * 1024 * 2);
  p.wuq_t = (u16*)alloc((size_t)2 * 576 * 256 * 2);
  p.wukv_t = (u16*)alloc((size_t)2 * 768 * 128 * 2);
  p.wout_t = (u16*)alloc((size_t)2 * 1024 * 1024 * 2);
  p.wgu_t = (u16*)alloc((size_t)2 * NGU * 1024 * 2);
  p.wdn_t = (u16*)alloc((size_t)2 * 1024 * DFF * 2);
  p.mod = (float*)alloc((size_t)2 * 3 * 6144 * 4);
  p.h = (u16*)alloc((size_t)T * D * 2);
  p.cq = (float*)alloc((size_t)T * 256 * 4);
  p.ckv = (float*)alloc((size_t)T * 128 * 4);
  p.krope = (float*)alloc((size_t)T * 32 * 4);
  p.qmla = (u16*)alloc((size_t)T * 576 * 2);
  p.qna = (u16*)alloc((size_t)T * 384 * 2);
  p.qdf = (u16*)alloc((size_t)T * 256 * 2);
  p.kmla_c = (u16*)alloc((size_t)32 * 6 * 256 * 96 * 2);
  p.vmla_c = (u16*)alloc((size_t)32 * 6 * 64 * 256 * 2);
  p.kna_c = (u16*)alloc((size_t)32 * 6 * 256 * 64 * 2);
  p.vna_c = (u16*)alloc((size_t)32 * 6 * 64 * 256 * 2);
  p.kdf_c = (u16*)alloc((size_t)32 * 4 * 256 * 64 * 2);
  p.vdf_c = (u16*)alloc((size_t)32 * 4 * 64 * 256 * 2);
  p.kmla_l = (u16*)alloc((size_t)2 * 2 * 6 * NKL * 96 * 2);
  p.vmla_l = (u16*)alloc((size_t)2 * 2 * 6 * 64 * NKL * 2);
  p.kna_l = (u16*)alloc((size_t)2 * 2 * 6 * NKL * 64 * 2);
  p.vna_l = (u16*)alloc((size_t)2 * 2 * 6 * 64 * NKL * 2);
  p.kdf_l = (u16*)alloc((size_t)2 * 2 * 4 * NKL * 64 * 2);
  p.vdf_l = (u16*)alloc((size_t)2 * 2 * 4 * 64 * NKL * 2);
  p.o = (u16*)alloc((size_t)T * D * 2);
  p.xa = (u16*)alloc((size_t)T * D * 2);
  p.xb = (u16*)alloc((size_t)T * D * 2);
  p.act = (u16*)alloc((size_t)T * DFF * 2);
  p.lam = (float*)alloc(256);
  p.bar = (unsigned*)alloc((size_t)XCD_BAR_WORDS * 4 + 256);
  p.counters = p.bar + XCD_BAR_WORDS;
  if (off > ws_size) { fprintf(stderr, "workspace too small: need %zu have %zu\n", off, ws_size); return; }
  hipMemsetAsync(p.bar, 0, (size_t)XCD_BAR_WORDS * 4 + 256, stream);
  int b = 0, e = 17;
  void* args[] = {&p, &b, &e};
  hipError_t err = hipLaunchCooperativeKernel((void*)fwd_megakernel, dim3(grid_blocks), dim3(512), args, 0, stream);
  if (err != hipSuccess) fprintf(stderr, "cooperative launch failed: %s (grid %d)\n", hipGetErrorString(err), grid_blocks);
}
```

```cpp
#include <hip/hip_runtime.h>
#include <hip/hip_cooperative_groups.h>
#include <cstdio>
#include <cstdint>
namespace cg = cooperative_groups;

typedef unsigned short u16;
typedef __attribute__((ext_vector_type(8))) short bf16x8;
typedef __attribute__((ext_vector_type(4))) float f32x4;
typedef __attribute__((ext_vector_type(16))) float f32x16;
typedef __attribute__((ext_vector_type(4))) unsigned u32x4;

#define DI __device__ __forceinline__

constexpr int D = 1024;
constexpr int TCTX = 8192;
constexpr int TLAT = 2048;
constexpr int T = TCTX + TLAT;
constexpr int NIN = 2560;
constexpr int DFF = 2816;
constexpr int NGU = 2 * DFF;
constexpr float EPS = 1e-6f;
constexpr int NKL = 1280;

constexpr size_t OUT_YP = 0;
constexpr size_t OUT_CKV = 10485760;
constexpr size_t OUT_KROPE = 12582912;
constexpr size_t OUT_NAK = 13107200;
constexpr size_t OUT_NAV = 19398656;
constexpr size_t OUT_DFK = 25690112;
constexpr size_t OUT_DFV = 29884416;

struct Params {
  const float *x_prompt, *x_sample, *cache_mla_ckv, *cache_mla_krope, *cache_na_k, *cache_na_v, *cache_df_k, *cache_df_v, *c, *c_ctx;
  const float *w_mod, *b_mod, *g_mix, *w_in, *g_qa, *w_uq, *g_kva, *w_ukv, *g_mla_q, *g_mla_k, *g_na_q, *g_na_k, *na_rpb, *g_df_q,
      *g_df_k, *df_lq1, *df_lk1, *df_lq2, *df_lk2, *g_df_sub, *w_out, *g_ffn, *w_gate, *w_up, *w_down;
  float* out;
  u16 *win_t, *wuq_t, *wukv_t, *wout_t, *wgu_t, *wdn_t;
  float* mod;
  u16* h;
  float *cq, *ckv, *krope;
  u16 *qmla, *qna, *qdf;
  u16 *kmla_c, *vmla_c, *kna_c, *vna_c, *kdf_c, *vdf_c;
  u16 *kmla_l, *vmla_l, *kna_l, *vna_l, *kdf_l, *vdf_l;
  u16* o;
  u16 *xa, *xb;
  u16* act;
  float* lam;
  unsigned* counters;
  unsigned* bar;
};

DI int opaque_v(int x) { asm volatile("" : "+v"(x)); return x; }
DI int opaque_s(int x) { asm volatile("" : "+s"(x)); return x; }
#define TIDX opaque_v((int)threadIdx.x)
#define BIDX opaque_s((int)blockIdx.x)
DI unsigned cvtpk(float lo, float hi) {
  unsigned r;
  asm volatile("v_cvt_pk_bf16_f32 %0, %1, %2" : "=v"(r) : "v"(lo), "v"(hi));
  return r;
}
DI u16 f2bf(float f) { return (u16)(cvtpk(f, 0.f) & 0xffffu); }
DI bf16x8 pack8(float a0, float a1, float a2, float a3, float a4, float a5, float a6, float a7) {
  uint4 u;
  u.x = cvtpk(a0, a1); u.y = cvtpk(a2, a3); u.z = cvtpk(a4, a5); u.w = cvtpk(a6, a7);
  return __builtin_bit_cast(bf16x8, u);
}
DI void st_bf4(u16* p, float a, float b, float c, float d) {
  uint2 u; u.x = cvtpk(a, b); u.y = cvtpk(c, d);
  *(uint2*)p = u;
}
DI f32x16 mfma32(bf16x8 a, bf16x8 b, f32x16 c) { return __builtin_amdgcn_mfma_f32_32x32x16_bf16(a, b, c, 0, 0, 0); }
DI f32x4 mfma16(bf16x8 a, bf16x8 b, f32x4 c) { return __builtin_amdgcn_mfma_f32_16x16x32_bf16(a, b, c, 0, 0, 0); }
DI float lam_init_of(int l) { return l == 0 ? 0.2f : 0.35550906759f; }
DI f32x4 bf4_to_f32(uint2 u) {
  f32x4 r;
  r[0] = __uint_as_float(u.x << 16); r[1] = __uint_as_float(u.x & 0xffff0000u);
  r[2] = __uint_as_float(u.y << 16); r[3] = __uint_as_float(u.y & 0xffff0000u);
  return r;
}
struct ResSrc { const float* f; const u16* h; };
DI ResSrc xrow_in(const Params& p, int l, int t) {
  ResSrc r; r.f = nullptr; r.h = nullptr;
  if (l == 0) r.f = t < TCTX ? p.x_prompt + (size_t)t * D : p.x_sample + (size_t)(t - TCTX) * D;
  else r.h = p.xb + (size_t)t * D;
  return r;
}
DI ResSrc xa_row(const Params& p, int t) { ResSrc r; r.f = nullptr; r.h = p.xa + (size_t)t * D; return r; }
DI f32x4 res_ld4(const ResSrc& s, int c) { return s.f ? __builtin_nontemporal_load((const f32x4*)(s.f + c)) : bf4_to_f32(*(const uint2*)(s.h + c)); }
DI int cond_of(int t) { return t < TCTX ? 0 : 1 + ((t - TCTX) >> 10); }

DI void rope32(f32x16& x, int s, int hh) {
  const float prow = (float)(s >> 6), pcol = (float)(s & 63);
  const float hs = hh ? 0.01f : 1.0f;
  f32x16 y;
#pragma unroll
  for (int reg = 0; reg < 16; ++reg) {
    const int a = reg >> 3, half = (reg >> 2) & 1, i3 = reg & 3;
    const float base = (i3 == 0) ? 1.0f : (i3 == 1) ? 0.31622776601683794f : (i3 == 2) ? 0.1f : 0.031622776601683794f;
    const float ang = (a ? pcol : prow) * (base * hs);
    const float cs = __cosf(ang), sn = __sinf(ang);
    const float partner = x[reg ^ 4];
    y[reg] = x[reg] * cs + (half ? partner : -partner) * sn;
  }
  x = y;
}


#define XB_TMO      128
#define XB_XCNT(j)  (256  + 64 * (j))
#define XB_XSUB(j)  (1280 + 64 * (j))
#define XB_XGEN(j)  (2304 + 64 * (j))
#define XB_TOP      3328
#define XB_TOPGEN   3392
#define XCD_BAR_WORDS 3456
#define XB_SPIN_CAP (1u << 22)
#define LAS __attribute__((address_space(3)))
DI unsigned xb_ld(unsigned* p) { return __hip_atomic_load(p, __ATOMIC_RELAXED, __HIP_MEMORY_SCOPE_AGENT); }
DI unsigned xb_add(unsigned* p, unsigned v) { return __hip_atomic_fetch_add(p, v, __ATOMIC_RELAXED, __HIP_MEMORY_SCOPE_AGENT); }
DI unsigned xb_xcc_id() { return (unsigned)__builtin_amdgcn_s_getreg((3 << 11) | 20) & 0xFu; }
#define XB_SPIN(cond, bar) do { unsigned _sp = 0; while (cond) { __builtin_amdgcn_s_sleep(1); \
    if ((++_sp & 255u) == 0u) { if (xb_ld(&(bar)[XB_TMO])) break; if (_sp > XB_SPIN_CAP) { atomicAdd(&(bar)[XB_TMO], 1u); break; } } } } while (0)
struct XcdBarrier { unsigned* bar; unsigned x; volatile LAS unsigned* st; };
DI XcdBarrier xcd_barrier_post(unsigned* bar, volatile LAS unsigned* st) {
  XcdBarrier b; b.bar = bar; b.x = xb_xcc_id(); b.st = st;
  if (threadIdx.x == 0) (void)xb_add(&bar[XB_XCNT(b.x)], 1u);
  return b;
}
DI void xcd_barrier_complete(unsigned* bar, unsigned x, unsigned& nloc, unsigned& nx) {
  const unsigned G = gridDim.x * gridDim.y * gridDim.z;
  unsigned sum, cnt, mine, sp = 0u;
  for (;;) {
    sum = 0u; cnt = 0u; mine = 0u;
#pragma unroll
    for (unsigned j = 0; j < 16; ++j) { const unsigned c = xb_ld(&bar[XB_XCNT(j)]); sum += c; cnt += (c > 0u) ? 1u : 0u; mine = (j == x) ? c : mine; }
    if (sum == G) break;
    __builtin_amdgcn_s_sleep(1);
    if ((++sp & 255u) == 0u) { if (xb_ld(&bar[XB_TMO])) break; if (sp > XB_SPIN_CAP) { atomicAdd(&bar[XB_TMO], 1u); break; } }
  }
  nloc = mine > 0u ? mine : 1u; nx = cnt > 0u ? cnt : 1u;
}
DI void xcd_barrier(const XcdBarrier& b) {
  asm volatile("s_waitcnt vmcnt(0)" ::: "memory");
  __syncthreads();
  if (threadIdx.x == 0) {
    unsigned* bar = b.bar;
    __builtin_amdgcn_s_waitcnt(0);
    unsigned nloc = b.st[0], nx = b.st[1];
    if (nloc == 0u) { xcd_barrier_complete(bar, b.x, nloc, nx); b.st[0] = nloc; b.st[1] = nx; }
    const unsigned old = xb_add(&bar[XB_XSUB(b.x)], 1u);
    const unsigned gen = old / nloc;
    if (old + 1u == (gen + 1u) * nloc) {
      __builtin_amdgcn_fence(__ATOMIC_RELEASE, "agent");
      asm volatile("s_waitcnt vmcnt(0)" ::: "memory");
      const unsigned og = xb_add(&bar[XB_TOP], 1u);
      const unsigned tg = og / nx;
      if (og + 1u == (tg + 1u) * nx) xb_add(&bar[XB_TOPGEN], 1u);
      else XB_SPIN(xb_ld(&bar[XB_TOPGEN]) == tg, bar);
      __builtin_amdgcn_fence(__ATOMIC_ACQUIRE, "agent");
      xb_add(&bar[XB_XGEN(b.x)], 1u);
      asm volatile("s_waitcnt vmcnt(0)" ::: "memory");
    } else {
      XB_SPIN(xb_ld(&bar[XB_XGEN(b.x)]) == gen, bar);
      __builtin_amdgcn_fence(__ATOMIC_ACQUIRE, "agent");
      asm volatile("s_waitcnt vmcnt(0)" ::: "memory");
    }
  }
  __syncthreads();
}

DI size_t kf_off(int kidx, int d8  , int ndk) { return ((size_t)((kidx >> 5) * ndk + (d8 >> 4)) * 64 + ((d8 >> 3) & 1) * 32 + (kidx & 31)) * 8; }
DI size_t vf_off(int kidx, int d) {
  const int kin = kidx & 31, q = kin & 15;
  return ((size_t)(((kidx >> 5) * 2 + (kin >> 4)) * 2 + (d >> 5)) * 64 + ((q >> 2) & 1) * 32 + (d & 31)) * 8 + 4 * (q >> 3) + (q & 3);
}

DI int phys_row(int L) {
  const int cl = L & 31;
  const int rho = 16 * ((cl >> 2) & 1) + 4 * (cl >> 3) + (cl & 3);
  return (L & ~255) + ((L >> 5) & 1) * 128 + ((L >> 6) & 3) * 32 + rho;
}
DI int map_row(int type, int n) {
  if (type == 1) {
    const int L = (n < 384) ? n : (n < 416) ? 2304 + (n - 384) : n - 32;
    return phys_row(L);
  }
  if (type == 2 || type == 3) {
    const int cl = n & 31;
    const int rho = 16 * ((cl >> 2) & 1) + 4 * (cl >> 3) + (cl & 3);
    return (n >> 7) * 256 + (type == 3 ? 128 : 0) + ((n >> 5) & 3) * 32 + rho;
  }
  if (type == 0) return phys_row(n);
  return n;
}
DI void transpose_tile(const float* __restrict__ src, int ld_src, int N, int k0, int n0, u16* __restrict__ dst, int ld_dst,
                       int type, int mode, u16* tile, int ng) {
  const int tid = TIDX;
  {
    const int c4 = tid & 15, r0 = tid >> 4;
    float4 v[4][2];
#pragma unroll
    for (int j = 0; j < 4; ++j)
#pragma unroll
      for (int ps = 0; ps < 2; ++ps) {
        v[j][ps] = make_float4(0.f, 0.f, 0.f, 0.f);
        if (j < ng && n0 + j * 64 + c4 * 4 < N) {
          const f32x4 t4 = __builtin_nontemporal_load((const f32x4*)(src + (size_t)(k0 + r0 + ps * 32) * ld_src + n0 + j * 64 + c4 * 4));
          v[j][ps] = make_float4(t4[0], t4[1], t4[2], t4[3]);
        }
      }
#pragma unroll
    for (int j = 0; j < 4; ++j)
      if (j < ng) {
#pragma unroll
        for (int ps = 0; ps < 2; ++ps) {
          unsigned* tp = (unsigned*)(tile + j * 4224 + (r0 + ps * 32) * 66 + c4 * 4);
          tp[0] = cvtpk(v[j][ps].x, v[j][ps].y);
          tp[1] = cvtpk(v[j][ps].z, v[j][ps].w);
        }
      }
  }
  __syncthreads();
  {
    const int kc = tid & 7, nrow = tid >> 3;
    const int k = k0 + kc * 8;
#pragma unroll
    for (int j = 0; j < 4; ++j) {
      const int n = n0 + j * 64 + nrow;
      if (j < ng && n < N) {
        const u16* tj = tile + j * 4224;
        unsigned w[4];
#pragma unroll
        for (int q = 0; q < 4; ++q) {
          const unsigned lo = tj[(kc * 8 + 2 * q) * 66 + nrow];
          const unsigned hi = tj[(kc * 8 + 2 * q + 1) * 66 + nrow];
          w[q] = lo | (hi << 16);
        }
        size_t off;
        if (mode == 0) {
          if (type == 4) {
            off = ((size_t)((n >> 5) * (ld_dst >> 4) + (k >> 4)) * 64 + ((k >> 3) & 1) * 32 + (n & 31)) * 8;
          } else off = (size_t)map_row(type, n) * ld_dst + k;
          *(uint4*)(dst + off) = make_uint4(w[0], w[1], w[2], w[3]);
        } else {
          const size_t o0 = vf_off(k, n);
          *(uint2*)(dst + o0) = make_uint2(w[0], w[1]);
          *(uint2*)(dst + o0 + 32 * 8) = make_uint2(w[2], w[3]);
        }
      }
    }
  }
  __syncthreads();
}

DI void mod_item(const Params& p, int l, int chunk, float* lds) {
  const int tid = TIDX;
  float* sv = lds;
  float* red = lds + 3072;
  for (int i = tid; i < 3072; i += 512) {
    const int n = i >> 10, k = i & 1023;
    const float v = (n == 0) ? p.c_ctx[k] : p.c[(n - 1) * 1024 + k];
    sv[i] = v / (1.f + expf(-v));
  }
  __syncthreads();
  const int c4 = tid & 15, kg = tid >> 4;
  const int c0 = chunk * 64;
  float acc[3][4];
#pragma unroll
  for (int n = 0; n < 3; ++n)
#pragma unroll
    for (int e = 0; e < 4; ++e) acc[n][e] = 0.f;
  const float* wp = p.w_mod + ((size_t)l * 1024 + kg * 32) * 6144 + c0 + c4 * 4;
#pragma unroll 8
  for (int kk = 0; kk < 32; ++kk) {
    const f32x4 w4 = __builtin_nontemporal_load((const f32x4*)(wp + (size_t)kk * 6144));
    const float4 w = make_float4(w4[0], w4[1], w4[2], w4[3]);
    const int k = kg * 32 + kk;
#pragma unroll
    for (int n = 0; n < 3; ++n) {
      const float s = sv[n * 1024 + k];
      acc[n][0] += s * w.x; acc[n][1] += s * w.y; acc[n][2] += s * w.z; acc[n][3] += s * w.w;
    }
  }
#pragma unroll
  for (int n = 0; n < 3; ++n)
#pragma unroll
    for (int e = 0; e < 4; ++e) red[(kg * 12 + n * 4 + e) * 16 + c4] = acc[n][e];
  __syncthreads();
  if (tid < 192) {
    const int n = tid >> 6, cc = tid & 63, cc4 = cc >> 2, e = cc & 3;
    float s = 0.f;
#pragma unroll
    for (int g = 0; g < 32; ++g) s += red[(g * 12 + n * 4 + e) * 16 + cc4];
    p.mod[(size_t)(l * 3 + n) * 6144 + c0 + cc] = s + p.b_mod[(size_t)l * 6144 + c0 + cc];
  }
  __syncthreads();
}

constexpr int P0_TR_PER_LAYER = 160 + 12 + 6 + 64 + 176 + 176 + 176 + 48 + 32;
constexpr int P0_MOD_PER_LAYER = 96;
constexpr int P0_KC_PER_LAYER = 20;
constexpr int P0_PER_LAYER = P0_TR_PER_LAYER + P0_MOD_PER_LAYER + P0_KC_PER_LAYER;

DI void prep_item(const Params& p, int l, int r, char* lds) {
  const int tid = TIDX;
    if (r < P0_MOD_PER_LAYER) { mod_item(p, l, r, (float*)lds); return; }
    r -= P0_MOD_PER_LAYER;
    u16* tile = (u16*)lds;
    if (r < 160) {
      const int kt = r / 10, g = r % 10;
      transpose_tile(p.w_in + (size_t)l * 1024 * 2336, 2336, 2336, kt * 64, g * 256, p.win_t + (size_t)l * NIN * 1024, 1024, 1, 0, tile, min(4, 37 - 4 * g));
      return;
    }
    r -= 160;
    if (r < 12) {
      const int kt = r / 3, g = r % 3;
      transpose_tile(p.w_uq + (size_t)l * 256 * 576, 576, 576, kt * 64, g * 256, p.wuq_t + (size_t)l * 576 * 256, 256, 4, 0, tile, min(4, 9 - 4 * g));
      return;
    }
    r -= 12;
    if (r < 6) {
      const int kt = r / 3, g = r % 3;
      transpose_tile(p.w_ukv + (size_t)l * 128 * 768, 768, 768, kt * 64, g * 256, p.wukv_t + (size_t)l * 768 * 128, 128, 4, 0, tile, 4);
      return;
    }
    r -= 6;
    if (r < 64) {
      const int kt = r / 4, g = r % 4;
      transpose_tile(p.w_out + (size_t)l * 1024 * 1024, 1024, 1024, kt * 64, g * 256, p.wout_t + (size_t)l * 1024 * 1024, 1024, 0, 0, tile, 4);
      return;
    }
    r -= 64;
    if (r < 176) {
      const int kt = r / 11, g = r % 11;
      transpose_tile(p.w_gate + (size_t)l * 1024 * DFF, DFF, DFF, kt * 64, g * 256, p.wgu_t + (size_t)l * NGU * 1024, 1024, 2, 0, tile, 4);
      return;
    }
    r -= 176;
    if (r < 176) {
      const int kt = r / 11, g = r % 11;
      transpose_tile(p.w_up + (size_t)l * 1024 * DFF, DFF, DFF, kt * 64, g * 256, p.wgu_t + (size_t)l * NGU * 1024, 1024, 3, 0, tile, 4);
      return;
    }
    r -= 176;
    if (r < 176) {
      const int kt = r / 4, g = r % 4;
      transpose_tile(p.w_down + (size_t)l * DFF * 1024, 1024, 1024, kt * 64, g * 256, p.wdn_t + (size_t)l * 1024 * DFF, DFF, 0, 0, tile, 4);
      return;
    }
    r -= 176;
    if (r < 48) {
      const int bh = r >> 2, kt = r & 3, b = bh / 6, hh = bh % 6;
      transpose_tile(p.cache_na_v + ((size_t)((b * 2 + l) * 6 + hh) * 256) * 64, 64, 64, kt * 64, 0,
                     p.vna_l + (size_t)l * (2 * 6 * 64 * NKL) + (size_t)bh * (64 * NKL), 0, 0, 1, tile, 1);
      return;
    }
    r -= 48;
    if (r < 32) {
      const int bh = r >> 2, kt = r & 3, b = bh / 4, hh = bh % 4;
      transpose_tile(p.cache_df_v + ((size_t)((b * 2 + l) * 4 + hh) * 256) * 64, 64, 64, kt * 64, 0,
                     p.vdf_l + (size_t)l * (2 * 4 * 64 * NKL) + (size_t)bh * (64 * NKL), 0, 0, 1, tile, 1);
      return;
    }
    r -= 32;
    {
      const float* src;
      u16* dst;
      if (r < 12) {
        const int b = r / 6, hh = r % 6;
        src = p.cache_na_k + ((size_t)((b * 2 + l) * 6 + hh) * 256) * 64;
        dst = p.kna_l + (size_t)l * (2 * 6 * NKL * 64) + (size_t)(b * 6 + hh) * (NKL * 64);
      } else {
        const int q = r - 12, b = q / 4, hh = q % 4;
        src = p.cache_df_k + ((size_t)((b * 2 + l) * 4 + hh) * 256) * 64;
        dst = p.kdf_l + (size_t)l * (2 * 4 * NKL * 64) + (size_t)(b * 4 + hh) * (NKL * 64);
      }
      float4 v[8];
#pragma unroll
      for (int i = 0; i < 8; ++i) v[i] = *(const float4*)(src + (tid + 512 * i) * 4);
#pragma unroll
      for (int i = 0; i < 8; ++i) {
        const int e = (tid + 512 * i) * 4;
        const int key = e >> 6, d4 = e & 63;
        st_bf4(dst + kf_off(key, d4 & ~7, 4) + (d4 & 7), v[i].x, v[i].y, v[i].z, v[i].w);
      }
    }
}

constexpr int P0_W_ITEMS = 160 + 12 + 6 + 64 + 176 + 176 + 176;
DI void phase_prep(const Params& p, char* lds) {
  const int tid = TIDX;
  if (BIDX == 0 && tid == 0) {
    for (int l = 0; l < 2; ++l) {
      float s1 = 0.f, s2 = 0.f;
      for (int i = 0; i < 32; ++i) {
        s1 += p.df_lq1[l * 32 + i] * p.df_lk1[l * 32 + i];
        s2 += p.df_lq2[l * 32 + i] * p.df_lk2[l * 32 + i];
      }
      p.lam[l] = expf(s1) - expf(s2) + lam_init_of(l);
    }
  }
  constexpr int NREST0 = P0_PER_LAYER - P0_MOD_PER_LAYER;
  constexpr int NREST1 = P0_PER_LAYER - P0_MOD_PER_LAYER - P0_W_ITEMS;
  for (int item = BIDX; item < 2 * P0_MOD_PER_LAYER + NREST0 + NREST1; item += gridDim.x) {
    int l, r;
    if (item < 2 * P0_MOD_PER_LAYER) { l = item / P0_MOD_PER_LAYER; r = item % P0_MOD_PER_LAYER; }
    else if (item < 2 * P0_MOD_PER_LAYER + NREST0) { l = 0; r = P0_MOD_PER_LAYER + (item - 2 * P0_MOD_PER_LAYER); }
    else { l = 1; r = P0_MOD_PER_LAYER + P0_W_ITEMS + (item - 2 * P0_MOD_PER_LAYER - NREST0); }
    prep_item(p, l, r, lds);
  }
}

DI void prep_deferred(const Params& p, char* lds, int cap) {
  const int tid = TIDX;
  volatile LAS unsigned* slot = (volatile LAS unsigned*)((LAS unsigned char*)lds + 131072 + 8);
  for (int n = 0; n < cap; ++n) {
    __syncthreads();
    if (tid == 0) *slot = atomicAdd(&p.counters[8], 1u);
    __syncthreads();
    const unsigned it = __builtin_amdgcn_readfirstlane(*slot);
    if (it >= (unsigned)P0_W_ITEMS) break;
    prep_item(p, 1, P0_MOD_PER_LAYER + (int)it, lds);
  }
}

DI void phase_norm(const Params& p, int l, int which  ) {
  const int lane = TIDX & 63, wid = TIDX >> 6;
  const float* g = (which == 0 ? p.g_mix : p.g_ffn) + l * D;
  const int nw = gridDim.x * 8;
  for (int t = BIDX * 8 + wid; t < T; t += 2 * nw) {
    const int t1 = t + nw;
    const bool has1 = t1 < T;
    const int tb = has1 ? t1 : t;
    const bool f32src = (which == 0 && l == 0);
    const float* sh0 = p.mod + (size_t)((l * 3 + cond_of(t)) * 6 + (which == 0 ? 0 : 3)) * D;
    const float* sh1 = p.mod + (size_t)((l * 3 + cond_of(tb)) * 6 + (which == 0 ? 0 : 3)) * D;
    float4 v0[4], v1[4], gg[4], sa0[4], sb0[4], sa1[4], sb1[4];
#pragma unroll
    for (int i = 0; i < 4; ++i) {
      const int c = i * 256 + lane * 4;
      gg[i] = *(const float4*)(g + c);
      sb0[i] = *(const float4*)(sh0 + c); sa0[i] = *(const float4*)(sh0 + D + c);
      sb1[i] = *(const float4*)(sh1 + c); sa1[i] = *(const float4*)(sh1 + D + c);
    }
    if (f32src) {
      const float* x0 = t < TCTX ? p.x_prompt + (size_t)t * D : p.x_sample + (size_t)(t - TCTX) * D;
      const float* x1 = tb < TCTX ? p.x_prompt + (size_t)tb * D : p.x_sample + (size_t)(tb - TCTX) * D;
#pragma unroll
      for (int i = 0; i < 4; ++i) {
        const int c = i * 256 + lane * 4;
        const f32x4 a = __builtin_nontemporal_load((const f32x4*)(x0 + c)), b2 = __builtin_nontemporal_load((const f32x4*)(x1 + c));
        v0[i] = make_float4(a[0], a[1], a[2], a[3]); v1[i] = make_float4(b2[0], b2[1], b2[2], b2[3]);
      }
    } else {
      const u16* hsrc = (which == 0) ? p.xb : p.xa;
#pragma unroll
      for (int i = 0; i < 4; ++i) {
        const int c = i * 256 + lane * 4;
        const f32x4 a = bf4_to_f32(*(const uint2*)(hsrc + (size_t)t * D + c)), b2 = bf4_to_f32(*(const uint2*)(hsrc + (size_t)tb * D + c));
        v0[i] = make_float4(a[0], a[1], a[2], a[3]); v1[i] = make_float4(b2[0], b2[1], b2[2], b2[3]);
      }
    }
    float ss0 = 0.f, ss1 = 0.f;
#pragma unroll
    for (int i = 0; i < 4; ++i) {
      ss0 += v0[i].x * v0[i].x + v0[i].y * v0[i].y + v0[i].z * v0[i].z + v0[i].w * v0[i].w;
      ss1 += v1[i].x * v1[i].x + v1[i].y * v1[i].y + v1[i].z * v1[i].z + v1[i].w * v1[i].w;
    }
#pragma unroll
    for (int m = 1; m < 64; m <<= 1) { ss0 += __shfl_xor(ss0, m); ss1 += __shfl_xor(ss1, m); }
    const float r0 = rsqrtf(ss0 * (1.f / D) + EPS), r1 = rsqrtf(ss1 * (1.f / D) + EPS);
#pragma unroll
    for (int i = 0; i < 4; ++i) {
      const int c = i * 256 + lane * 4;
      st_bf4(p.h + (size_t)t * D + c, v0[i].x * r0 * gg[i].x * (1.f + sa0[i].x) + sb0[i].x, v0[i].y * r0 * gg[i].y * (1.f + sa0[i].y) + sb0[i].y,
             v0[i].z * r0 * gg[i].z * (1.f + sa0[i].z) + sb0[i].z, v0[i].w * r0 * gg[i].w * (1.f + sa0[i].w) + sb0[i].w);
    }
    if (has1) {
#pragma unroll
      for (int i = 0; i < 4; ++i) {
        const int c = i * 256 + lane * 4;
        st_bf4(p.h + (size_t)t1 * D + c, v1[i].x * r1 * gg[i].x * (1.f + sa1[i].x) + sb1[i].x, v1[i].y * r1 * gg[i].y * (1.f + sa1[i].y) + sb1[i].y,
               v1[i].z * r1 * gg[i].z * (1.f + sa1[i].z) + sb1[i].z, v1[i].w * r1 * gg[i].w * (1.f + sa1[i].w) + sb1[i].w);
      }
    }
  }
}

namespace pg8 {
typedef unsigned short bf16_t;
constexpr int BM = 256, BK = 64, HALF = 128, HTB = HALF * BK * 2, STAGE_BYTES = 8 * HTB, NXCD = 8, WGM = 8;
DI int lds_byte(int r, int c) { const int st = (r >> 4) * 2 + (c >> 5), rr = r & 15, cc = c & 31, ob = rr * 64 + cc * 2; return st * 1024 + (ob ^ (((ob >> 9) & 1) << 5)); }
DI void stage_rc(int b, int& R, int& C) { const int st = b / 1024, sb = b % 1024, swz = sb ^ (((sb >> 9) & 1) << 5); R = (st >> 1) * 16 + swz / 64; C = (st & 1) * 32 + (swz % 64) / 2; }
struct Unit { int pm, pn; };
struct StaticOrder {
  int nM, nN, nwg, G, c;
  DI void init(int M, int N, int G_, int c_) { nM = M / BM; nN = N / BM; nwg = nM * nN; G = G_; c = c_; }
  DI bool next(int i, Unit& u) const {
    const long L = (long)i * G + c; if (L >= nwg) return false;
    int wgid = (int)L; { const int q = nwg / NXCD, r = nwg % NXCD, xcd = wgid % NXCD, off = wgid / NXCD; wgid = (xcd < r ? xcd * (q + 1) : r * (q + 1) + (xcd - r) * q) + off; }
    const int nig = WGM * nN, gid = wgid / nig, fm = gid * WGM, gsz = (nM - fm) < WGM ? (nM - fm) : WGM;
    u.pm = fm + ((wgid % nig) % gsz); u.pn = (wgid % nig) / gsz; return true;
  }
};

template <class Epi>
DI void gemm_phase(LAS unsigned char* lds, const bf16_t* gA, const bf16_t* gBt, int M, int N, int K, const Epi& E) {
  const int tid = TIDX, wid = __builtin_amdgcn_readfirstlane(tid >> 6), lane = tid & 63, wr = wid >> 2, wc = wid & 3, fr = lane & 15, fq = lane >> 4;
  const int nt = K / BK;
  StaticOrder S; S.init(M, N, (int)gridDim.x, BIDX);
  unsigned voffA[2];
#pragma unroll
  for (int i = 0; i < 2; ++i) { int R, C; stage_rc(tid * 16 + i * 8192, R, C); voffA[i] = (unsigned)(R * K + C) * 2u; }
  const size_t kstep = (size_t)(BK * 2);
  const size_t hstep = (size_t)HALF * K * 2;
  const size_t tstep = 2 * hstep;
  const unsigned ldsw = (unsigned)wid * 1024u;
  const int aoff = lds_byte(wr * 64 + fr, fq * 8), boff = lds_byte(wc * 32 + fr, fq * 8);
#define PG8_SA(b, h) (((b) * 2 + (h)) * HTB)
#define PG8_SB(b, h) ((4 + (b) * 2 + (h)) * HTB)
#define PG8_STAGE(bufoff, gbase) do { _Pragma("unroll") for (int _i = 0; _i < 2; ++_i) \
    __builtin_amdgcn_global_load_lds((const unsigned*)((const char*)(gbase) + voffA[_i]), (LAS unsigned*)(lds + (bufoff) + ldsw + _i * 8192), 16, 0, 0); } while (0)
#define PG8_LDA(dst, b, h) do { _Pragma("unroll") for (int m = 0; m < 4; ++m) _Pragma("unroll") for (int k = 0; k < 2; ++k) dst[m][k] = *(const LAS bf16x8*)(lds + PG8_SA(b, h) + aoff + m * 2048 + k * 1024); } while (0)
#define PG8_LDB(dst, b, h) do { _Pragma("unroll") for (int n = 0; n < 2; ++n) _Pragma("unroll") for (int k = 0; k < 2; ++k) dst[n][k] = *(const LAS bf16x8*)(lds + PG8_SB(b, h) + boff + n * 2048 + k * 1024); } while (0)
#define PG8_MMA(ai, bj, At, Bt) do { __builtin_amdgcn_s_setprio(1); _Pragma("unroll") for (int m = 0; m < 4; ++m) _Pragma("unroll") for (int n = 0; n < 2; ++n) _Pragma("unroll") for (int k = 0; k < 2; ++k) \
    acc[ai][bj][m][n] = __builtin_amdgcn_mfma_f32_16x16x32_bf16(Bt[n][k], At[m][k], acc[ai][bj][m][n], 0, 0, 0); __builtin_amdgcn_s_setprio(0); } while (0)
#define PG8_WAIT_V(n) asm volatile("s_waitcnt vmcnt(" #n ")" ::: "memory")
#define PG8_WAIT_L(n) asm volatile("s_waitcnt lgkmcnt(" #n ")" ::: "memory")
#define PG8_BAR __builtin_amdgcn_s_barrier()
#define PG8_SCHED __builtin_amdgcn_sched_barrier(0)
  Unit cur, nxt; int ui = 0;
  if (!S.next(0, cur)) return;
  f32x4 acc[2][2][4][2];
#pragma unroll
  for (int a = 0; a < 2; ++a)
#pragma unroll
    for (int b = 0; b < 2; ++b)
#pragma unroll
      for (int m = 0; m < 4; ++m)
#pragma unroll
        for (int n = 0; n < 2; ++n) acc[a][b][m][n] = (f32x4){0.f, 0.f, 0.f, 0.f};
  bf16x8 At[4][2], B0[2][2], B1[2][2];
  const char* cA = (const char*)gA + (size_t)cur.pm * tstep; const char* cB = (const char*)gBt + (size_t)cur.pn * tstep;
  PG8_STAGE(PG8_SB(0, 0), cB); PG8_STAGE(PG8_SA(0, 0), cA); PG8_STAGE(PG8_SB(0, 1), cB + hstep); PG8_STAGE(PG8_SA(0, 1), cA + hstep);
  if (wr == 1) PG8_BAR;
  PG8_WAIT_V(4); PG8_BAR;
  PG8_STAGE(PG8_SB(1, 0), cB + kstep); PG8_STAGE(PG8_SA(1, 0), cA + kstep); PG8_STAGE(PG8_SB(1, 1), cB + hstep + kstep);
  PG8_WAIT_V(6); PG8_BAR;
  for (;;) {
    const bool has_next = S.next(ui + 1, nxt);
    const char* nA = has_next ? (const char*)gA + (size_t)nxt.pm * tstep : cA; const char* nB = has_next ? (const char*)gBt + (size_t)nxt.pn * tstep : cB;
    for (int t = 0; t < nt; t += 2) {
      const bool last = (t == nt - 2);
      const char* a1 = cA + (size_t)(t + 1) * kstep;
      const char* a2 = last ? nA : cA + (size_t)(t + 2) * kstep; const char* b2 = last ? nB : cB + (size_t)(t + 2) * kstep;
      const char* a3 = a2 + kstep; const char* b3 = b2 + kstep;
      PG8_LDB(B0, 0, 0); PG8_SCHED; PG8_LDA(At, 0, 0); PG8_STAGE(PG8_SA(1, 1), a1 + hstep);
      PG8_WAIT_L(8); PG8_BAR; PG8_WAIT_L(0); PG8_MMA(0, 0, At, B0); PG8_BAR; PG8_SCHED;
      PG8_LDB(B1, 0, 1); PG8_STAGE(PG8_SB(0, 0), b2);
      PG8_BAR; PG8_WAIT_L(0); PG8_MMA(0, 1, At, B1); PG8_BAR;
      PG8_LDA(At, 0, 1); PG8_STAGE(PG8_SA(0, 0), a2);
      PG8_BAR; PG8_WAIT_L(0); PG8_MMA(1, 0, At, B0); PG8_BAR; PG8_SCHED;
      PG8_STAGE(PG8_SB(0, 1), b2 + hstep);
      PG8_WAIT_V(6); PG8_BAR; PG8_MMA(1, 1, At, B1); PG8_BAR;
      PG8_LDB(B0, 1, 0); PG8_SCHED; PG8_LDA(At, 1, 0); PG8_STAGE(PG8_SA(0, 1), a2 + hstep);
      PG8_WAIT_L(8); PG8_BAR; PG8_WAIT_L(0); PG8_MMA(0, 0, At, B0); PG8_BAR; PG8_SCHED;
      PG8_LDB(B1, 1, 1); PG8_STAGE(PG8_SB(1, 0), b3);
      PG8_BAR; PG8_WAIT_L(0); PG8_MMA(0, 1, At, B1); PG8_BAR;
      PG8_LDA(At, 1, 1); PG8_STAGE(PG8_SA(1, 0), a3);
      PG8_BAR; PG8_WAIT_L(0); PG8_MMA(1, 0, At, B0); PG8_BAR; PG8_SCHED;
      PG8_STAGE(PG8_SB(1, 1), b3 + hstep);
      PG8_WAIT_V(6); PG8_BAR; PG8_MMA(1, 1, At, B1); PG8_BAR;
    }
    {
      int fr2 = fr, fq2 = fq; Unit cu = cur;
      asm volatile("" : "+v"(fr2), "+v"(fq2), "+s"(cu.pm), "+s"(cu.pn));
      E(acc, cu, wr, wc, fr2, fq2);
    }
    if (!has_next) break;
#pragma unroll
    for (int a = 0; a < 2; ++a)
#pragma unroll
      for (int b = 0; b < 2; ++b)
#pragma unroll
        for (int m = 0; m < 4; ++m)
#pragma unroll
          for (int n = 0; n < 2; ++n) acc[a][b][m][n] = (f32x4){0.f, 0.f, 0.f, 0.f};
    cur = nxt; cA = nA; cB = nB; ++ui;
  }
  PG8_WAIT_V(0);
  if (wr == 0) PG8_BAR;
  PG8_BAR;
#undef PG8_SA
#undef PG8_SB
#undef PG8_STAGE
#undef PG8_LDA
#undef PG8_LDB
#undef PG8_MMA
#undef PG8_WAIT_V
#undef PG8_WAIT_L
#undef PG8_BAR
#undef PG8_SCHED
}
}

typedef f32x4 AccT[2][2][4][2];
DI void st_nt4(float* p_, f32x4 v_) { __builtin_nontemporal_store(v_, (f32x4*)p_); }
DI float dot4(f32x4 a) { return a[0] * a[0] + a[1] * a[1] + a[2] * a[2] + a[3] * a[3]; }
DI float rowsum_q(float v) { v += __shfl_xor(v, 16); v += __shfl_xor(v, 32); return v; }
DI void st_bf8(u16* p, f32x4 a, f32x4 b) {
  u32x4 w; w.x = cvtpk(a[0], a[1]); w.y = cvtpk(a[2], a[3]); w.z = cvtpk(b[0], b[1]); w.w = cvtpk(b[2], b[3]);
  *(u32x4*)p = w;
}

struct EpiIn {
  const Params& p; int l;
  DI void operator()(const AccT& acc, const pg8::Unit& u, int wr, int wc, int fr, int fq) const {
    const int wcb = u.pn * 4 + wc;
    if (wcb > 36) return;
    const bool is_ctx = u.pm < 32;
    const int r0 = u.pm * 256 + wr * 64 + fr;
    int b, s0;
    if (is_ctx) { b = u.pm; s0 = wr * 64 + fr; }
    else { const int tl = r0 - TCTX; b = tl >> 10; s0 = tl & 1023; }
    const int c8 = 8 * fq;
    if (wcb < 4) {
#pragma unroll
      for (int ai = 0; ai < 2; ++ai)
#pragma unroll
        for (int m = 0; m < 4; ++m) {
          asm volatile("" ::: "memory");
          float* rp = p.cq + (size_t)(r0 + ai * 128 + m * 16) * 256 + wcb * 64 + c8;
#pragma unroll
          for (int bj = 0; bj < 2; ++bj)
#pragma unroll
            for (int n = 0; n < 2; ++n) *(f32x4*)(rp + bj * 32 + 4 * n) = acc[ai][bj][m][n];
        }
    } else if (wcb < 6) {
#pragma unroll
      for (int ai = 0; ai < 2; ++ai)
#pragma unroll
        for (int m = 0; m < 4; ++m) {
          asm volatile("" ::: "memory");
          float* rp = p.ckv + (size_t)(r0 + ai * 128 + m * 16) * 128 + (wcb - 4) * 64 + c8;
#pragma unroll
          for (int bj = 0; bj < 2; ++bj)
#pragma unroll
            for (int n = 0; n < 2; ++n) *(f32x4*)(rp + bj * 32 + 4 * n) = acc[ai][bj][m][n];
        }
    } else if (wcb < 18) {
      const bool isq = wcb < 12;
      const int hd = isq ? wcb - 6 : wcb - 12;
      const float* g = (isq ? p.g_na_q : p.g_na_k) + l * 64 + c8;
      f32x4 gv[2][2];
#pragma unroll
      for (int bj = 0; bj < 2; ++bj)
#pragma unroll
        for (int n = 0; n < 2; ++n) gv[bj][n] = *(const f32x4*)(g + bj * 32 + 4 * n);
#pragma unroll
      for (int ai = 0; ai < 2; ++ai)
#pragma unroll
        for (int m = 0; m < 4; ++m) {
          asm volatile("" ::: "memory");
          float ss = dot4(acc[ai][0][m][0]) + dot4(acc[ai][0][m][1]) + dot4(acc[ai][1][m][0]) + dot4(acc[ai][1][m][1]);
          ss = rowsum_q(ss);
          const float rstd = rsqrtf(ss * (1.f / 64.f) + EPS) * (isq ? 0.18033688011112042f : 1.f);
          const int t = r0 + ai * 128 + m * 16, s = s0 + ai * 128 + m * 16;
          f32x4 v[2][2];
#pragma unroll
          for (int bj = 0; bj < 2; ++bj)
#pragma unroll
            for (int n = 0; n < 2; ++n) v[bj][n] = acc[ai][bj][m][n] * rstd * gv[bj][n];
          if (isq) {
            u16* qp = p.qna + (size_t)t * 384 + hd * 64 + c8;
            st_bf8(qp, v[0][0], v[0][1]); st_bf8(qp + 32, v[1][0], v[1][1]);
          } else if (is_ctx) {
            float* op = p.out + OUT_NAK + ((size_t)((b * 2 + l) * 6 + hd) * 256 + s) * 64 + c8;
            st_nt4(op, v[0][0]); st_nt4(op + 4, v[0][1]); st_nt4(op + 32, v[1][0]); st_nt4(op + 36, v[1][1]);
            u16* kp = p.kna_c + (size_t)(b * 6 + hd) * (256 * 64);
            st_bf8(kp + kf_off(s, c8, 4), v[0][0], v[0][1]); st_bf8(kp + kf_off(s, 32 + c8, 4), v[1][0], v[1][1]);
          } else {
            u16* kp = p.kna_l + (size_t)l * (2 * 6 * NKL * 64) + (size_t)(b * 6 + hd) * (NKL * 64);
            st_bf8(kp + kf_off(256 + s, c8, 4), v[0][0], v[0][1]); st_bf8(kp + kf_off(256 + s, 32 + c8, 4), v[1][0], v[1][1]);
          }
        }
    } else if (wcb < 24 || (wcb >= 32 && wcb < 36)) {
      const bool isna = wcb < 24;
      const int hd = isna ? wcb - 18 : wcb - 32;
      const int nh = isna ? 6 : 4;
      const int vh = isna ? hd : 6 + hd;
      float* ob = p.out + (isna ? OUT_NAV : OUT_DFV) + ((size_t)((b * 2 + l) * nh + hd) * 256) * 64 + c8;
      u16* vb = is_ctx ? (isna ? p.vna_c : p.vdf_c) + (size_t)(b * nh + hd) * (64 * 256)
                       : (isna ? p.vna_l : p.vdf_l) + (size_t)l * (2 * nh * 64 * NKL) + (size_t)(b * nh + hd) * (64 * NKL);
      (void)vh;
#pragma unroll
      for (int ai = 0; ai < 2; ++ai)
#pragma unroll
        for (int m = 0; m < 4; ++m) {
          asm volatile("" ::: "memory");
          const int s = s0 + ai * 128 + m * 16;
          u16* vk = vb + vf_off((is_ctx ? 0 : 256) + s, c8);
#pragma unroll
          for (int bj = 0; bj < 2; ++bj)
#pragma unroll
            for (int n = 0; n < 2; ++n) {
              const unsigned lo = cvtpk(acc[ai][bj][m][n][0], acc[ai][bj][m][n][1]), hi = cvtpk(acc[ai][bj][m][n][2], acc[ai][bj][m][n][3]);
              u16* q = vk + bj * 512 + n * 32;
              q[0] = (u16)(lo & 0xffffu); q[8] = (u16)(lo >> 16); q[16] = (u16)(hi & 0xffffu); q[24] = (u16)(hi >> 16);
            }
          if (is_ctx) {
            float* op = ob + (size_t)s * 64;
            st_nt4(op, acc[ai][0][m][0]); st_nt4(op + 4, acc[ai][0][m][1]); st_nt4(op + 32, acc[ai][1][m][0]); st_nt4(op + 36, acc[ai][1][m][1]);
          }
        }
    } else if (wcb < 32) {
      const bool isq = wcb < 28;
      const int hd = isq ? wcb - 24 : wcb - 28;
      const float* g = (isq ? p.g_df_q : p.g_df_k) + l * 32 + c8;
      const f32x4 g0 = *(const f32x4*)(g), g1 = *(const f32x4*)(g + 4);
      const int ra = fq >> 1, half = fq & 1;
#pragma unroll
      for (int ai = 0; ai < 2; ++ai)
#pragma unroll
        for (int m = 0; m < 4; ++m) {
          asm volatile("" ::: "memory");
          const int t = r0 + ai * 128 + m * 16, s = s0 + ai * 128 + m * 16;
          f32x4 v[2][2];
#pragma unroll
          for (int bj = 0; bj < 2; ++bj) {
            float ss = dot4(acc[ai][bj][m][0]) + dot4(acc[ai][bj][m][1]);
            ss = rowsum_q(ss);
            const float rstd = rsqrtf(ss * (1.f / 32.f) + EPS) * (isq ? 0.25503486164919736f : 1.f);
            v[bj][0] = acc[ai][bj][m][0] * rstd * g0;
            v[bj][1] = acc[ai][bj][m][1] * rstd * g1;
          }
          if (!is_ctx) {
            const float pos = ra ? (float)(s & 63) : (float)(s >> 6);
#pragma unroll
            for (int bj = 0; bj < 2; ++bj)
#pragma unroll
              for (int n = 0; n < 2; ++n)
#pragma unroll
                for (int e = 0; e < 4; ++e) {
                  const int i = 4 * n + e;
                  const float inv = (i == 0) ? 1.0f : (i == 1) ? 0.31622776601683794f : (i == 2) ? 0.1f : (i == 3) ? 0.031622776601683794f
                                  : (i == 4) ? 0.01f : (i == 5) ? 0.0031622776601683794f : (i == 6) ? 0.001f : 0.00031622776601683794f;
                  const float ang = pos * inv;
                  const float cs = __cosf(ang), sn = __sinf(ang);
                  const float x = v[bj][n][e];
                  const float partner = __shfl_xor(x, 16);
                  v[bj][n][e] = x * cs + (half ? partner : -partner) * sn;
                }
          }
          if (isq) {
            u16* qp = p.qdf + (size_t)t * 256 + hd * 64 + c8;
            st_bf8(qp, v[0][0], v[0][1]); st_bf8(qp + 32, v[1][0], v[1][1]);
          } else if (is_ctx) {
            float* op = p.out + OUT_DFK + ((size_t)((b * 2 + l) * 4 + hd) * 256 + s) * 64 + c8;
            st_nt4(op, v[0][0]); st_nt4(op + 4, v[0][1]); st_nt4(op + 32, v[1][0]); st_nt4(op + 36, v[1][1]);
            u16* kp = p.kdf_c + (size_t)(b * 4 + hd) * (256 * 64);
            st_bf8(kp + kf_off(s, c8, 4), v[0][0], v[0][1]); st_bf8(kp + kf_off(s, 32 + c8, 4), v[1][0], v[1][1]);
          } else {
            u16* kp = p.kdf_l + (size_t)l * (2 * 4 * NKL * 64) + (size_t)(b * 4 + hd) * (NKL * 64);
            st_bf8(kp + kf_off(256 + s, c8, 4), v[0][0], v[0][1]); st_bf8(kp + kf_off(256 + s, 32 + c8, 4), v[1][0], v[1][1]);
          }
        }
    } else {
#pragma unroll
      for (int ai = 0; ai < 2; ++ai)
#pragma unroll
        for (int m = 0; m < 4; ++m) {
          asm volatile("" ::: "memory");
          const int t = r0 + ai * 128 + m * 16, s = s0 + ai * 128 + m * 16;
          float* kp = p.krope + (size_t)t * 32 + c8;
          *(f32x4*)(kp) = acc[ai][0][m][0]; *(f32x4*)(kp + 4) = acc[ai][0][m][1];
          if (is_ctx) {
            float* op = p.out + OUT_KROPE + ((size_t)(b * 2 + l) * 256 + s) * 32 + c8;
            st_nt4(op, acc[ai][0][m][0]); st_nt4(op + 4, acc[ai][0][m][1]);
          }
        }
    }
  }
};

template <int WHICH  >
struct EpiRes {
  const Params& p; int l;
  DI void operator()(const AccT& acc, const pg8::Unit& u, int wr, int wc, int fr, int fq) const {
    const int cond = u.pm < 32 ? 0 : 1 + ((u.pm - 32) >> 2);
    const int c0 = u.pn * 256 + wc * 64 + 8 * fq;
    const float* gate = p.mod + (size_t)((l * 3 + cond) * 6 + (WHICH == 0 ? 2 : 5)) * D + c0;
    f32x4 gv[2][2];
#pragma unroll
    for (int bj = 0; bj < 2; ++bj)
#pragma unroll
      for (int n = 0; n < 2; ++n) gv[bj][n] = *(const f32x4*)(gate + bj * 32 + 4 * n);
    u16* dsth = (WHICH == 0) ? p.xa : p.xb;
    const bool to_out = (WHICH == 1 && l == 1);
#pragma unroll
    for (int ai = 0; ai < 2; ++ai)
#pragma unroll
      for (int mh = 0; mh < 2; ++mh) {
        f32x4 xi[2][2][2];
        if (WHICH == 0 && l == 0) {
#pragma unroll
          for (int mm = 0; mm < 2; ++mm) {
            const int t = u.pm * 256 + ai * 128 + wr * 64 + (mh * 2 + mm) * 16 + fr;
            const float* xin = (u.pm < 32 ? p.x_prompt + (size_t)t * D : p.x_sample + (size_t)(t - TCTX) * D) + c0;
#pragma unroll
            for (int bj = 0; bj < 2; ++bj)
#pragma unroll
              for (int n = 0; n < 2; ++n) xi[mm][bj][n] = __builtin_nontemporal_load((const f32x4*)(xin + bj * 32 + 4 * n));
          }
        } else {
          const u16* hsrc = (WHICH == 0) ? p.xb : p.xa;
#pragma unroll
          for (int mm = 0; mm < 2; ++mm) {
            const int t = u.pm * 256 + ai * 128 + wr * 64 + (mh * 2 + mm) * 16 + fr;
#pragma unroll
            for (int bj = 0; bj < 2; ++bj) {
              const uint4 q = *(const uint4*)(hsrc + (size_t)t * D + c0 + bj * 32);
              xi[mm][bj][0] = bf4_to_f32(make_uint2(q.x, q.y));
              xi[mm][bj][1] = bf4_to_f32(make_uint2(q.z, q.w));
            }
          }
        }
#pragma unroll
        for (int mm = 0; mm < 2; ++mm) {
          const int m = mh * 2 + mm;
          const int t = u.pm * 256 + ai * 128 + wr * 64 + m * 16 + fr;
          if (to_out) {
            float* xo = p.out + (size_t)t * D + c0;
#pragma unroll
            for (int bj = 0; bj < 2; ++bj)
#pragma unroll
              for (int n = 0; n < 2; ++n) st_nt4(xo + bj * 32 + 4 * n, xi[mm][bj][n] + gv[bj][n] * acc[ai][bj][m][n]);
          } else {
            u16* xo = dsth + (size_t)t * D + c0;
#pragma unroll
            for (int bj = 0; bj < 2; ++bj)
              st_bf8(xo + bj * 32, xi[mm][bj][0] + gv[bj][0] * acc[ai][bj][m][0], xi[mm][bj][1] + gv[bj][1] * acc[ai][bj][m][1]);
          }
        }
      }
  }
};

struct EpiGU {
  const Params& p;
  DI void operator()(const AccT& acc, const pg8::Unit& u, int wr, int wc, int fr, int fq) const {
    const int f0 = u.pn * 128 + wc * 32 + 8 * fq;
#pragma unroll
    for (int ai = 0; ai < 2; ++ai)
#pragma unroll
      for (int m = 0; m < 4; ++m) {
        const int t = u.pm * 256 + ai * 128 + wr * 64 + m * 16 + fr;
        f32x4 o[2];
#pragma unroll
        for (int n = 0; n < 2; ++n)
#pragma unroll
          for (int e = 0; e < 4; ++e) {
            const float gvv = acc[ai][0][m][n][e], uv = acc[ai][1][m][n][e];
            o[n][e] = gvv * __builtin_amdgcn_rcpf(1.f + __builtin_amdgcn_exp2f(-1.4426950408889634f * gvv)) * uv;
          }
        st_bf8(p.act + (size_t)t * DFF + f0, o[0], o[1]);
      }
  }
};

DI void mla_q_load(const Params& p, int l, int tb, bf16x8 (&bfr)[16], float& rstd) {
  const int lane = TIDX & 63, l31 = lane & 31, hh = lane >> 5;
  const int tok = tb * 32 + l31;
  const float* cqrow = p.cq + (size_t)tok * 256;
  const float* gq = p.g_qa + l * 256;
  float ss = 0.f;
#pragma unroll
  for (int ks = 0; ks < 16; ++ks) {
    const int k = ks * 16 + 8 * hh;
    const float4 a = *(const float4*)(cqrow + k), b2 = *(const float4*)(cqrow + k + 4);
    const float4 ga = *(const float4*)(gq + k), gb = *(const float4*)(gq + k + 4);
    ss += a.x * a.x + a.y * a.y + a.z * a.z + a.w * a.w + b2.x * b2.x + b2.y * b2.y + b2.z * b2.z + b2.w * b2.w;
    bfr[ks] = pack8(a.x * ga.x, a.y * ga.y, a.z * ga.z, a.w * ga.w, b2.x * gb.x, b2.y * gb.y, b2.z * gb.z, b2.w * gb.w);
  }
  ss += __shfl_xor(ss, 32);
  rstd = rsqrtf(ss * (1.f / 256.f) + EPS);
}

DI void mla_q_compute(const Params& p, int l, int tb, int h, const LAS unsigned char* wl, const bf16x8 (&bfr)[16], float rstd) {
  const int lane = TIDX & 63, l31 = lane & 31, hh = lane >> 5;
  const int tok = tb * 32 + l31;
  float4 gq2[3][4];
#pragma unroll
  for (int nt = 0; nt < 3; ++nt)
#pragma unroll
    for (int gi = 0; gi < 4; ++gi) gq2[nt][gi] = *(const float4*)(p.g_mla_q + l * 96 + nt * 32 + 8 * gi + 4 * hh);
  f32x16 acc[3];
  const LAS unsigned char* W = wl + lane * 16;
#pragma unroll
  for (int nt = 0; nt < 3; ++nt) {
#pragma unroll
    for (int r = 0; r < 16; ++r) acc[nt][r] = 0.f;
#pragma unroll
    for (int ks = 0; ks < 16; ++ks) {
      const bf16x8 wf = *(const LAS bf16x8*)(W + (nt * 16 + ks) * 1024);
      acc[nt] = mfma32(wf, bfr[ks], acc[nt]);
    }
  }
  float s2 = 0.f;
#pragma unroll
  for (int nt = 0; nt < 3; ++nt)
#pragma unroll
    for (int r = 0; r < 16; ++r) { acc[nt][r] *= rstd; s2 += acc[nt][r] * acc[nt][r]; }
  s2 += __shfl_xor(s2, 32);
  const float rstd2 = rsqrtf(s2 * (1.f / 96.f) + EPS) * 0.14724444602590306f;
#pragma unroll
  for (int nt = 0; nt < 3; ++nt)
#pragma unroll
    for (int gi = 0; gi < 4; ++gi) {
      const float4 gg = gq2[nt][gi];
      acc[nt][4 * gi + 0] *= rstd2 * gg.x; acc[nt][4 * gi + 1] *= rstd2 * gg.y;
      acc[nt][4 * gi + 2] *= rstd2 * gg.z; acc[nt][4 * gi + 3] *= rstd2 * gg.w;
    }
  if (tok >= TCTX) rope32(acc[2], (tok - TCTX) & 1023, hh);
  u16* qo = p.qmla + (size_t)tok * 576 + h * 96 + 4 * hh;
#pragma unroll
  for (int nt = 0; nt < 3; ++nt)
#pragma unroll
    for (int gi = 0; gi < 4; ++gi)
      st_bf4(qo + nt * 32 + 8 * gi, acc[nt][4 * gi], acc[nt][4 * gi + 1], acc[nt][4 * gi + 2], acc[nt][4 * gi + 3]);
}

struct KvRow { const float* csrc; const float* krsrc; int b, s; bool is_tok, is_ctx; };
DI KvRow kv_row(const Params& p, int l, int rb) {
  const int lane = TIDX & 63, l31 = lane & 31;
  const int row = rb * 32 + l31;
  KvRow r;
  r.is_tok = row < T;
  r.is_ctx = row < TCTX;
  if (r.is_tok) {
    r.csrc = p.ckv + (size_t)row * 128;
    r.krsrc = p.krope + (size_t)row * 32;
    if (r.is_ctx) { r.b = row >> 8; r.s = row & 255; }
    else { r.b = (row - TCTX) >> 10; r.s = (row - TCTX) & 1023; }
  } else {
    const int rr = row - T;
    r.b = rr >> 8; r.s = rr & 255;
    r.csrc = p.cache_mla_ckv + ((size_t)(r.b * 2 + l) * 256 + r.s) * 128;
    r.krsrc = p.cache_mla_krope + ((size_t)(r.b * 2 + l) * 256 + r.s) * 32;
  }
  return r;
}

DI void mla_kv_load(const Params& p, int l, int rb, bf16x8 (&bfr)[8], float& rstd) {
  const int lane = TIDX & 63, hh = lane >> 5;
  const KvRow R = kv_row(p, l, rb);
  const float* gk = p.g_kva + l * 128;
  float ss = 0.f;
#pragma unroll
  for (int ks = 0; ks < 8; ++ks) {
    const int k = ks * 16 + 8 * hh;
    const float4 a = *(const float4*)(R.csrc + k), b2 = *(const float4*)(R.csrc + k + 4);
    float4 ga = make_float4(1.f, 1.f, 1.f, 1.f), gb = ga;
    if (R.is_tok) { ga = *(const float4*)(gk + k); gb = *(const float4*)(gk + k + 4); }
    ss += a.x * a.x + a.y * a.y + a.z * a.z + a.w * a.w + b2.x * b2.x + b2.y * b2.y + b2.z * b2.z + b2.w * b2.w;
    bfr[ks] = pack8(a.x * ga.x, a.y * ga.y, a.z * ga.z, a.w * ga.w, b2.x * gb.x, b2.y * gb.y, b2.z * gb.z, b2.w * gb.w);
  }
  ss += __shfl_xor(ss, 32);
  rstd = R.is_tok ? rsqrtf(ss * (1.f / 128.f) + EPS) : 1.f;
}

DI void mla_kv_compute(const Params& p, int l, int rb, int h, const LAS unsigned char* wl, const bf16x8 (&bfr)[8], float rstd) {
  const int lane = TIDX & 63, hh = lane >> 5;
  const KvRow R = kv_row(p, l, rb);
  const bool is_tok = R.is_tok, is_ctx = R.is_ctx;
  const int b = R.b, s = R.s;
  const float* gk = p.g_kva + l * 128;
  f32x16 kr;
#pragma unroll
  for (int gi = 0; gi < 4; ++gi) {
    const float4 v = *(const float4*)(R.krsrc + 8 * gi + 4 * hh);
    kr[4 * gi] = v.x; kr[4 * gi + 1] = v.y; kr[4 * gi + 2] = v.z; kr[4 * gi + 3] = v.w;
  }
  const float* g = p.g_mla_k + l * 96;
  float4 gk0[4], gk1[4], gk2[4];
#pragma unroll
  for (int gi = 0; gi < 4; ++gi) {
    gk0[gi] = *(const float4*)(g + 8 * gi + 4 * hh); gk1[gi] = *(const float4*)(g + 32 + 8 * gi + 4 * hh); gk2[gi] = *(const float4*)(g + 64 + 8 * gi + 4 * hh);
  }
  f32x16 acc[4];
  const LAS unsigned char* W = wl + lane * 16;
#pragma unroll
  for (int nt = 0; nt < 4; ++nt) {
#pragma unroll
    for (int r = 0; r < 16; ++r) acc[nt][r] = 0.f;
#pragma unroll
    for (int ks = 0; ks < 8; ++ks) {
      const bf16x8 wf = *(const LAS bf16x8*)(W + (nt * 8 + ks) * 1024);
      acc[nt] = mfma32(wf, bfr[ks], acc[nt]);
    }
  }
  float sk = 0.f;
#pragma unroll
  for (int nt = 0; nt < 4; ++nt)
#pragma unroll
    for (int r = 0; r < 16; ++r) acc[nt][r] *= rstd;
#pragma unroll
  for (int r = 0; r < 16; ++r) sk += acc[0][r] * acc[0][r] + acc[1][r] * acc[1][r] + kr[r] * kr[r];
  sk += __shfl_xor(sk, 32);
  const float rstdk = rsqrtf(sk * (1.f / 96.f) + EPS);
#pragma unroll
  for (int gi = 0; gi < 4; ++gi) {
    const float4 g0 = gk0[gi], g1 = gk1[gi], g2 = gk2[gi];
    acc[0][4 * gi] *= rstdk * g0.x; acc[0][4 * gi + 1] *= rstdk * g0.y; acc[0][4 * gi + 2] *= rstdk * g0.z; acc[0][4 * gi + 3] *= rstdk * g0.w;
    acc[1][4 * gi] *= rstdk * g1.x; acc[1][4 * gi + 1] *= rstdk * g1.y; acc[1][4 * gi + 2] *= rstdk * g1.z; acc[1][4 * gi + 3] *= rstdk * g1.w;
    kr[4 * gi] *= rstdk * g2.x; kr[4 * gi + 1] *= rstdk * g2.y; kr[4 * gi + 2] *= rstdk * g2.z; kr[4 * gi + 3] *= rstdk * g2.w;
  }
  if (is_tok && !is_ctx) rope32(kr, s, hh);
  u16 *kd, *vd;
  int kidx;
  if (is_ctx) {
    kidx = s;
    kd = p.kmla_c + (size_t)(b * 6 + h) * (256 * 96);
    vd = p.vmla_c + (size_t)(b * 6 + h) * (64 * 256);
  } else {
    kidx = is_tok ? 256 + s : s;
    kd = p.kmla_l + (size_t)l * (2 * 6 * NKL * 96) + (size_t)(b * 6 + h) * (NKL * 96);
    vd = p.vmla_l + (size_t)l * (2 * 6 * 64 * NKL) + (size_t)(b * 6 + h) * (64 * NKL);
  }
#pragma unroll
  for (int gi = 0; gi < 4; ++gi) {
    st_bf4(kd + kf_off(kidx, 8 * gi, 6) + 4 * hh, acc[0][4 * gi], acc[0][4 * gi + 1], acc[0][4 * gi + 2], acc[0][4 * gi + 3]);
    st_bf4(kd + kf_off(kidx, 32 + 8 * gi, 6) + 4 * hh, acc[1][4 * gi], acc[1][4 * gi + 1], acc[1][4 * gi + 2], acc[1][4 * gi + 3]);
    st_bf4(kd + kf_off(kidx, 64 + 8 * gi, 6) + 4 * hh, kr[4 * gi], kr[4 * gi + 1], kr[4 * gi + 2], kr[4 * gi + 3]);
  }
#pragma unroll
  for (int nt = 0; nt < 2; ++nt)
#pragma unroll
    for (int r = 0; r < 16; ++r) {
      const int d = nt * 32 + (r & 3) + 8 * (r >> 2) + 4 * hh;
      vd[vf_off(kidx, d)] = f2bf(acc[2 + nt][r]);
    }
  if (is_ctx && h == 0) {
    float* ob = p.out + OUT_CKV + ((size_t)(b * 2 + l) * 256 + s) * 128;
    float4 oa[8], obv[8];
#pragma unroll
    for (int ks = 0; ks < 8; ++ks) {
      const int k = ks * 16 + 8 * hh;
      const float4 a = *(const float4*)(R.csrc + k), b2 = *(const float4*)(R.csrc + k + 4);
      const float4 ga = *(const float4*)(gk + k), gb = *(const float4*)(gk + k + 4);
      oa[ks] = make_float4(a.x * rstd * ga.x, a.y * rstd * ga.y, a.z * rstd * ga.z, a.w * rstd * ga.w);
      obv[ks] = make_float4(b2.x * rstd * gb.x, b2.y * rstd * gb.y, b2.z * rstd * gb.z, b2.w * rstd * gb.w);
    }
#pragma unroll
    for (int ks = 0; ks < 8; ++ks) {
      const int k = ks * 16 + 8 * hh;
      st_nt4(ob + k, (f32x4){oa[ks].x, oa[ks].y, oa[ks].z, oa[ks].w});
      st_nt4(ob + k + 4, (f32x4){obv[ks].x, obv[ks].y, obv[ks].z, obv[ks].w});
    }
  }
}

DI void phase_mla_up(const Params& p, int l, char* lds) {
  const int tid = TIDX, lane = tid & 63, w = __builtin_amdgcn_readfirstlane(tid >> 6);
  LAS unsigned char* ldsl = (LAS unsigned char*)lds;
  const int nslot = ((int)gridDim.x + 7) >> 3;
  for (int it0 = (BIDX & 7) * nslot + (BIDX >> 3); it0 < 252 + 8 * nslot; it0 += 8 * nslot) {
    const int item = it0;
    if (item >= 252 || (BIDX >> 3) >= nslot) break;
    __syncthreads();
    const bool hasq = item < 240;
    const int h = item % 6, grp = item / 6;
    if (hasq) {
      const u16* wsrc = p.wuq_t + (size_t)l * 576 * 256 + (size_t)(h * 3) * (16 * 512) + lane * 8;
#pragma unroll
      for (int i = 0; i < 6; ++i) {
        const int blk = w + 8 * i;
        __builtin_amdgcn_global_load_lds((const unsigned*)(wsrc + blk * 512), (LAS unsigned*)(ldsl + blk * 1024), 16, 0, 0);
      }
    }
    {
      const u16* wsrc = p.wukv_t + (size_t)l * 768 * 128 + (size_t)(h * 4) * (8 * 512) + lane * 8;
#pragma unroll
      for (int i = 0; i < 4; ++i) {
        const int blk = w + 8 * i;
        __builtin_amdgcn_global_load_lds((const unsigned*)(wsrc + blk * 512), (LAS unsigned*)(ldsl + 49152 + blk * 1024), 16, 0, 0);
      }
    }
    bf16x8 bq[16], bk[8];
    float rq = 1.f, rk = 1.f;
    if (hasq) mla_q_load(p, l, grp * 8 + w, bq, rq);
    mla_kv_load(p, l, grp * 8 + w, bk, rk);
    asm volatile("s_waitcnt vmcnt(0)" ::: "memory");
    __syncthreads();
    if (hasq) mla_q_compute(p, l, grp * 8 + w, h, ldsl, bq, rq);
    mla_kv_compute(p, l, grp * 8 + w, h, ldsl + 49152, bk, rk);
  }
}

constexpr int ATT_NST = 8, ATT_STB = 10240, ATT_RPB_OFF = ATT_NST * ATT_STB;
#define ATT_BAR() do { __builtin_amdgcn_s_barrier(); asm volatile("" ::: "memory"); } while (0)

template <int NDK>
DI void att_issue(LAS unsigned char* lds, const u16* Kb, const u16* Vb, int kt, int st, int w, int lane) {
#pragma unroll
  for (int i = 0; i < 2; ++i) {
    const int j = w + 8 * i;
    if (j < NDK + 4) {
      const u16* src = (j < NDK) ? Kb + (size_t)kt * (NDK * 512) + j * 512 : Vb + (size_t)kt * 2048 + (j - NDK) * 512;
      const int dst = st * ATT_STB + ((j < NDK) ? j * 1024 : 6144 + (j - NDK) * 1024);
      __builtin_amdgcn_global_load_lds((const unsigned*)(src + lane * 8), (LAS unsigned*)(lds + dst), 16, 0, 0);
    }
  }
}

template <int DQK, int MODE>
DI void attn_block_single(LAS unsigned char* lds, const u16* __restrict__ Kb, const u16* __restrict__ Vb, const u16* __restrict__ qrow,
                          u16* __restrict__ orow, float scale, int ntiles, int r, int qc, int rs0) {
  const int tid = TIDX, lane = tid & 63, w = __builtin_amdgcn_readfirstlane(tid >> 6), hh = lane >> 5;
  constexpr int NDK = DQK / 16;
  const int nl = (w + 8 < NDK + 4) ? 2 : 1;
#define ATT_KT(t_) ((MODE == 1 && (t_) >= 8) ? 8 + (rs0 + (((t_) - 8) >> 1)) * 2 + (((t_) - 8) & 1) : (t_))
  for (int tt = 0; tt < ATT_NST - 1; ++tt) { const int tc = min(tt, ntiles - 1); att_issue<NDK>(lds, Kb, Vb, ATT_KT(tc), tt, w, lane); }
  bf16x8 qf[NDK];
#pragma unroll
  for (int dk = 0; dk < NDK; ++dk) qf[dk] = *(const bf16x8*)(qrow + dk * 16 + 8 * hh);
#pragma unroll
  for (int dk = 0; dk < NDK; ++dk) asm volatile("" :: "v"(qf[dk]));
  f32x16 o0, o1;
#pragma unroll
  for (int i = 0; i < 16; ++i) { o0[i] = 0.f; o1[i] = 0.f; }
  float mrun = -1e30f, lsum = 0.f;
  int rs = 0, cs = 0;
  if (MODE == 1) { rs = min(max(r - 4, 0), 8); cs = min(max(qc - 8, 0), 48); }
  const LAS float* rpbl = (const LAS float*)(lds + ATT_RPB_OFF);
  for (int t = 0; t < ntiles; ++t) {
    if (nl == 2) asm volatile("s_waitcnt vmcnt(12)" ::: "memory"); else asm volatile("s_waitcnt vmcnt(6)" ::: "memory");
    ATT_BAR();
    { const int tn = min(t + ATT_NST - 1, ntiles - 1); att_issue<NDK>(lds, Kb, Vb, ATT_KT(tn), (t + ATT_NST - 1) & (ATT_NST - 1), w, lane); }
    int jr = 0, ct = 0;
    if (MODE == 1 && t >= 8) {
      jr = rs0 + ((t - 8) >> 1) - rs; ct = (t - 8) & 1;
      if (jr < 0 || jr > 7) continue;
    }
    const LAS unsigned char* sp = lds + (t & (ATT_NST - 1)) * ATT_STB + lane * 16;
    f32x16 s;
#pragma unroll
    for (int i = 0; i < 16; ++i) s[i] = 0.f;
    __builtin_amdgcn_s_setprio(1);
#pragma unroll
    for (int dk = 0; dk < NDK; ++dk) s = mfma32(*(const LAS bf16x8*)(sp + dk * 1024), qf[dk], s);
    __builtin_amdgcn_s_setprio(0);
    const bf16x8 v00 = *(const LAS bf16x8*)(sp + 6144), v01 = *(const LAS bf16x8*)(sp + 6144 + 1024),
                 v10 = *(const LAS bf16x8*)(sp + 6144 + 2048), v11 = *(const LAS bf16x8*)(sp + 6144 + 3072);
    float tmax = -1e30f;
    if (MODE == 1 && t >= 8) {
      const LAS float* rp = rpbl + (rs + jr - r + 7) * 31;
#pragma unroll
      for (int reg = 0; reg < 16; ++reg) {
        const int kc = ct * 32 + (reg & 3) + 8 * (reg >> 2) + 4 * hh;
        const int rc = min(max(kc - qc, -15), 15) + 15;
        const float bias = rp[rc];
        const float v = (kc >= cs && kc < cs + 16) ? s[reg] + bias : -1e30f;
        s[reg] = v;
        tmax = fmaxf(tmax, v);
      }
    } else {
#pragma unroll
      for (int reg = 0; reg < 16; ++reg) tmax = fmaxf(tmax, s[reg]);
    }
    tmax = fmaxf(tmax, __shfl_xor(tmax, 32));
    const float mn = fmaxf(mrun, tmax);
    if (__builtin_amdgcn_ballot_w64(mn != mrun) != 0ull) {
      const float alpha = __builtin_amdgcn_exp2f(mrun - mn);
      lsum *= alpha;
#pragma unroll
      for (int i = 0; i < 16; ++i) { o0[i] *= alpha; o1[i] *= alpha; }
    }
    mrun = mn;
    float ps = 0.f;
#pragma unroll
    for (int reg = 0; reg < 16; ++reg) { const float pv = __builtin_amdgcn_exp2f(s[reg] - mn); s[reg] = pv; ps += pv; }
    lsum += ps;
    const bf16x8 pf0 = pack8(s[0], s[1], s[2], s[3], s[4], s[5], s[6], s[7]);
    const bf16x8 pf1 = pack8(s[8], s[9], s[10], s[11], s[12], s[13], s[14], s[15]);
    __builtin_amdgcn_s_setprio(1);
    o0 = mfma32(v00, pf0, o0);
    o1 = mfma32(v01, pf0, o1);
    o0 = mfma32(v10, pf1, o0);
    o1 = mfma32(v11, pf1, o1);
    __builtin_amdgcn_s_setprio(0);
  }
#undef ATT_KT
  asm volatile("s_waitcnt vmcnt(0)" ::: "memory");
  ATT_BAR();
  lsum += __shfl_xor(lsum, 32);
  const float inv = 1.f / lsum;
  u16* op = orow + 4 * hh;
#pragma unroll
  for (int gi = 0; gi < 4; ++gi) {
    st_bf4(op + 8 * gi, o0[4 * gi] * inv, o0[4 * gi + 1] * inv, o0[4 * gi + 2] * inv, o0[4 * gi + 3] * inv);
    st_bf4(op + 32 + 8 * gi, o1[4 * gi] * inv, o1[4 * gi + 1] * inv, o1[4 * gi + 2] * inv, o1[4 * gi + 3] * inv);
  }
}

template <int DQK>
DI void attn_block_pp(LAS unsigned char* lds, const u16* __restrict__ Kb, const u16* __restrict__ Vb, const u16* __restrict__ qrow,
                      u16* __restrict__ orow, int ntiles) {
  const int tid = TIDX, lane = tid & 63, w = __builtin_amdgcn_readfirstlane(tid >> 6), hh = lane >> 5;
  constexpr int NDK = DQK / 16;
  const int nl = (w + 8 < NDK + 4) ? 2 : 1;
  for (int tt = 0; tt < ATT_NST - 1; ++tt) att_issue<NDK>(lds, Kb, Vb, min(tt, ntiles - 1), tt, w, lane);
  bf16x8 qf[NDK];
#pragma unroll
  for (int dk = 0; dk < NDK; ++dk) qf[dk] = *(const bf16x8*)(qrow + dk * 16 + 8 * hh);
#pragma unroll
  for (int dk = 0; dk < NDK; ++dk) asm volatile("" :: "v"(qf[dk]));
  f32x16 o0, o1;
#pragma unroll
  for (int i = 0; i < 16; ++i) { o0[i] = 0.f; o1[i] = 0.f; }
  float mrun = -1e30f, lsum = 0.f;
  asm volatile("s_waitcnt vmcnt(0)" ::: "memory");
  ATT_BAR();
  f32x16 sn;
#pragma unroll
  for (int i = 0; i < 16; ++i) sn[i] = 0.f;
  {
    const LAS unsigned char* sp0 = lds + lane * 16;
#pragma unroll
    for (int dk = 0; dk < NDK; ++dk) sn = mfma32(*(const LAS bf16x8*)(sp0 + dk * 1024), qf[dk], sn);
  }
  for (int t = 0; t < ntiles; ++t) {
    if (nl == 2) asm volatile("s_waitcnt vmcnt(10)" ::: "memory"); else asm volatile("s_waitcnt vmcnt(5)" ::: "memory");
    ATT_BAR();
    { const int tn = min(t + ATT_NST - 1, ntiles - 1); att_issue<NDK>(lds, Kb, Vb, tn, (t + ATT_NST - 1) & (ATT_NST - 1), w, lane); }
    const LAS unsigned char* sp = lds + (t & (ATT_NST - 1)) * ATT_STB + lane * 16;
    const LAS unsigned char* spn = lds + ((t + 1) & (ATT_NST - 1)) * ATT_STB + lane * 16;
    f32x16 s = sn;
    const bf16x8 v00 = *(const LAS bf16x8*)(sp + 6144), v01 = *(const LAS bf16x8*)(sp + 6144 + 1024),
                 v10 = *(const LAS bf16x8*)(sp + 6144 + 2048), v11 = *(const LAS bf16x8*)(sp + 6144 + 3072);
#pragma unroll
    for (int i = 0; i < 16; ++i) sn[i] = 0.f;
#pragma unroll
    for (int dk = 0; dk < NDK; ++dk) sn = mfma32(*(const LAS bf16x8*)(spn + dk * 1024), qf[dk], sn);
    float tmax = -1e30f;
#pragma unroll
    for (int reg = 0; reg < 16; ++reg) tmax = fmaxf(tmax, s[reg]);
    tmax = fmaxf(tmax, __shfl_xor(tmax, 32));
    const float mn = fmaxf(mrun, tmax);
    {
      const float alpha = __builtin_amdgcn_exp2f(mrun - mn);
      lsum *= alpha;
#pragma unroll
      for (int i = 0; i < 16; ++i) { o0[i] *= alpha; o1[i] *= alpha; }
    }
    mrun = mn;
    float ps = 0.f;
#pragma unroll
    for (int reg = 0; reg < 16; ++reg) { const float pv = __builtin_amdgcn_exp2f(s[reg] - mn); s[reg] = pv; ps += pv; }
    lsum += ps;
    const bf16x8 pf0 = pack8(s[0], s[1], s[2], s[3], s[4], s[5], s[6], s[7]);
    const bf16x8 pf1 = pack8(s[8], s[9], s[10], s[11], s[12], s[13], s[14], s[15]);
    __builtin_amdgcn_s_setprio(1);
    o0 = mfma32(v00, pf0, o0);
    o1 = mfma32(v01, pf0, o1);
    o0 = mfma32(v10, pf1, o0);
    o1 = mfma32(v11, pf1, o1);
    __builtin_amdgcn_s_setprio(0);
  }
  asm volatile("s_waitcnt vmcnt(0)" ::: "memory");
  ATT_BAR();
  lsum += __shfl_xor(lsum, 32);
  const float inv = 1.f / lsum;
  u16* op = orow + 4 * hh;
#pragma unroll
  for (int gi = 0; gi < 4; ++gi) {
    st_bf4(op + 8 * gi, o0[4 * gi] * inv, o0[4 * gi + 1] * inv, o0[4 * gi + 2] * inv, o0[4 * gi + 3] * inv);
    st_bf4(op + 32 + 8 * gi, o1[4 * gi] * inv, o1[4 * gi + 1] * inv, o1[4 * gi + 2] * inv, o1[4 * gi + 3] * inv);
  }
}

DI void attn_block_diff(LAS unsigned char* lds, const u16* __restrict__ Kb, const u16* __restrict__ Vb, const u16* __restrict__ qrow,
                        u16* __restrict__ orow, float scale, int ntiles, float lam, const float* __restrict__ gsub, float outscale) {
  const int tid = TIDX, lane = tid & 63, w = __builtin_amdgcn_readfirstlane(tid >> 6), hh = lane >> 5;
  for (int tt = 0; tt < ATT_NST - 1; ++tt) att_issue<4>(lds, Kb, Vb, min(tt, ntiles - 1), tt, w, lane);
  bf16x8 qf[4];
#pragma unroll
  for (int dk = 0; dk < 4; ++dk) qf[dk] = *(const bf16x8*)(qrow + dk * 16 + 8 * hh);
#pragma unroll
  for (int dk = 0; dk < 4; ++dk) asm volatile("" :: "v"(qf[dk]));
  f32x16 oa0, oa1, ob0, ob1;
#pragma unroll
  for (int i = 0; i < 16; ++i) { oa0[i] = 0.f; oa1[i] = 0.f; ob0[i] = 0.f; ob1[i] = 0.f; }
  float m1 = -1e30f, l1 = 0.f, m2 = -1e30f, l2 = 0.f;
  for (int t = 0; t < ntiles; ++t) {
    asm volatile("s_waitcnt vmcnt(6)" ::: "memory");
    ATT_BAR();
    att_issue<4>(lds, Kb, Vb, min(t + ATT_NST - 1, ntiles - 1), (t + ATT_NST - 1) & (ATT_NST - 1), w, lane);
    const LAS unsigned char* sp = lds + (t & (ATT_NST - 1)) * ATT_STB + lane * 16;
    f32x16 s1, s2;
#pragma unroll
    for (int i = 0; i < 16; ++i) { s1[i] = 0.f; s2[i] = 0.f; }
    __builtin_amdgcn_s_setprio(1);
    s1 = mfma32(*(const LAS bf16x8*)(sp), qf[0], s1); s1 = mfma32(*(const LAS bf16x8*)(sp + 1024), qf[1], s1);
    s2 = mfma32(*(const LAS bf16x8*)(sp + 2048), qf[2], s2); s2 = mfma32(*(const LAS bf16x8*)(sp + 3072), qf[3], s2);
    __builtin_amdgcn_s_setprio(0);
    const bf16x8 v00 = *(const LAS bf16x8*)(sp + 6144), v10 = *(const LAS bf16x8*)(sp + 6144 + 1024),
                 v01 = *(const LAS bf16x8*)(sp + 6144 + 2048), v11 = *(const LAS bf16x8*)(sp + 6144 + 3072);
    float t1 = -1e30f, t2 = -1e30f;
#pragma unroll
    for (int reg = 0; reg < 16; ++reg) {
      t1 = fmaxf(t1, s1[reg]); t2 = fmaxf(t2, s2[reg]);
    }
    t1 = fmaxf(t1, __shfl_xor(t1, 32));
    t2 = fmaxf(t2, __shfl_xor(t2, 32));
    const float mn1 = fmaxf(m1, t1), mn2 = fmaxf(m2, t2);
    if (__builtin_amdgcn_ballot_w64(mn1 != m1) != 0ull) {
      const float a1 = __builtin_amdgcn_exp2f(m1 - mn1);
      l1 *= a1;
#pragma unroll
      for (int i = 0; i < 16; ++i) { oa0[i] *= a1; oa1[i] *= a1; }
    }
    if (__builtin_amdgcn_ballot_w64(mn2 != m2) != 0ull) {
      const float a2 = __builtin_amdgcn_exp2f(m2 - mn2);
      l2 *= a2;
#pragma unroll
      for (int i = 0; i < 16; ++i) { ob0[i] *= a2; ob1[i] *= a2; }
    }
    m1 = mn1; m2 = mn2;
    float p1 = 0.f, p2 = 0.f;
#pragma unroll
    for (int reg = 0; reg < 16; ++reg) {
      const float e1 = __builtin_amdgcn_exp2f(s1[reg] - mn1), e2 = __builtin_amdgcn_exp2f(s2[reg] - mn2);
      s1[reg] = e1; s2[reg] = e2; p1 += e1; p2 += e2;
    }
    l1 += p1; l2 += p2;
    const bf16x8 pa0 = pack8(s1[0], s1[1], s1[2], s1[3], s1[4], s1[5], s1[6], s1[7]);
    const bf16x8 pa1 = pack8(s1[8], s1[9], s1[10], s1[11], s1[12], s1[13], s1[14], s1[15]);
    const bf16x8 pb0 = pack8(s2[0], s2[1], s2[2], s2[3], s2[4], s2[5], s2[6], s2[7]);
    const bf16x8 pb1 = pack8(s2[8], s2[9], s2[10], s2[11], s2[12], s2[13], s2[14], s2[15]);
    __builtin_amdgcn_s_setprio(1);
    oa0 = mfma32(v00, pa0, oa0); oa1 = mfma32(v10, pa0, oa1);
    oa0 = mfma32(v01, pa1, oa0); oa1 = mfma32(v11, pa1, oa1);
    ob0 = mfma32(v00, pb0, ob0); ob1 = mfma32(v10, pb0, ob1);
    ob0 = mfma32(v01, pb1, ob0); ob1 = mfma32(v11, pb1, ob1);
    __builtin_amdgcn_s_setprio(0);
  }
  asm volatile("s_waitcnt vmcnt(0)" ::: "memory");
  ATT_BAR();
  l1 += __shfl_xor(l1, 32);
  l2 += __shfl_xor(l2, 32);
  const float i1 = 1.f / l1, i2 = lam / l2;
  float ss = 0.f;
#pragma unroll
  for (int i = 0; i < 16; ++i) {
    oa0[i] = oa0[i] * i1 - ob0[i] * i2;
    oa1[i] = oa1[i] * i1 - ob1[i] * i2;
    ss += oa0[i] * oa0[i] + oa1[i] * oa1[i];
  }
  ss += __shfl_xor(ss, 32);
  const float rstd = rsqrtf(ss * (1.f / 64.f) + EPS) * outscale;
  u16* op = orow + 4 * hh;
  float4 gs0[4], gs1[4];
#pragma unroll
  for (int gi = 0; gi < 4; ++gi) { gs0[gi] = *(const float4*)(gsub + 8 * gi + 4 * hh); gs1[gi] = *(const float4*)(gsub + 32 + 8 * gi + 4 * hh); }
#pragma unroll
  for (int gi = 0; gi < 4; ++gi) {
    const float4 g0 = gs0[gi], g1 = gs1[gi];
    st_bf4(op + 8 * gi, oa0[4 * gi] * rstd * g0.x, oa0[4 * gi + 1] * rstd * g0.y, oa0[4 * gi + 2] * rstd * g0.z, oa0[4 * gi + 3] * rstd * g0.w);
    st_bf4(op + 32 + 8 * gi, oa1[4 * gi] * rstd * g1.x, oa1[4 * gi + 1] * rstd * g1.y, oa1[4 * gi + 2] * rstd * g1.z, oa1[4 * gi + 3] * rstd * g1.w);
  }
}

constexpr int ATT_ITEMS = 640;
DI void phase_attn(const Params& p, int l, char* ldsg) {
  LAS unsigned char* lds = (LAS unsigned char*)ldsg;
  const int tid = TIDX, lane = tid & 63, l31 = lane & 31, w = __builtin_amdgcn_readfirstlane(tid >> 6);
  const float lam = p.lam[l];
  const float outscale = 1.f - lam_init_of(l);
  volatile LAS unsigned* slot = (volatile LAS unsigned*)(lds + 131072 + 8);
  for (;;) {
    __syncthreads();
    if (tid == 0) *slot = atomicAdd(&p.counters[l], 1u);
    __syncthreads();
    const unsigned it = __builtin_amdgcn_readfirstlane(*slot);
    if (it >= (unsigned)ATT_ITEMS) break;
    int idx = (int)it;
    if (idx < 32) {
      const int b = idx >> 4, h = (idx >> 2) & 3, qb = (idx & 3) * 8 + w;
      const int tok = TCTX + b * 1024 + qb * 32 + l31;
      attn_block_diff(lds, p.kdf_l + (size_t)l * (2 * 4 * NKL * 64) + (size_t)(b * 4 + h) * (NKL * 64),
                      p.vdf_l + (size_t)l * (2 * 4 * 64 * NKL) + (size_t)(b * 4 + h) * (64 * NKL), p.qdf + (size_t)tok * 256 + h * 64,
                      p.o + (size_t)tok * D + 768 + h * 64, 0.17677669529663687f, 40, lam, p.g_df_sub + l * 64, outscale);
      continue;
    }
    idx -= 32;
    if (idx < 48) {
      const int b = idx / 24, h = (idx >> 2) % 6, qb = (idx & 3) * 8 + w;
      const int tok = TCTX + b * 1024 + qb * 32 + l31;
      attn_block_pp<96>(lds, p.kmla_l + (size_t)l * (2 * 6 * NKL * 96) + (size_t)(b * 6 + h) * (NKL * 96),
                               p.vmla_l + (size_t)l * (2 * 6 * 64 * NKL) + (size_t)(b * 6 + h) * (64 * NKL), p.qmla + (size_t)tok * 576 + h * 96,
                               p.o + (size_t)tok * D + h * 64, 40);
      continue;
    }
    idx -= 48;
    if (idx < 48) {
      const int b = idx / 24, h = (idx >> 2) % 6, qt = idx & 3, qb = qt * 8 + w;
      const int tok = TCTX + b * 1024 + qb * 32 + l31;
      {
        const float* rg = p.na_rpb + (size_t)(l * 6 + h) * (15 * 31);
        LAS float* rl = (LAS float*)(lds + ATT_RPB_OFF);
        if (tid < 465) rl[tid] = rg[tid] * 1.4426950408889634f;
      }
      const int r0 = qt * 4;
      const int rs0 = min(max(r0 - 4, 0), 8), rs3 = min(max(r0 + 3 - 4, 0), 8);
      const int ntiles = 8 + 2 * (rs3 + 8 - rs0);
      attn_block_single<64, 1>(lds, p.kna_l + (size_t)l * (2 * 6 * NKL * 64) + (size_t)(b * 6 + h) * (NKL * 64),
                               p.vna_l + (size_t)l * (2 * 6 * 64 * NKL) + (size_t)(b * 6 + h) * (64 * NKL), p.qna + (size_t)tok * 384 + h * 64,
                               p.o + (size_t)tok * D + 384 + h * 64, 0.125f, ntiles, qb >> 1, (qb & 1) * 32 + l31, rs0);
      continue;
    }
    idx -= 48;
    if (idx < 192) {
      const int b = idx / 6, h = idx % 6;
      const int tok = b * 256 + w * 32 + l31;
      attn_block_pp<96>(lds, p.kmla_c + (size_t)(b * 6 + h) * (256 * 96), p.vmla_c + (size_t)(b * 6 + h) * (64 * 256),
                               p.qmla + (size_t)tok * 576 + h * 96, p.o + (size_t)tok * D + h * 64, 8);
      continue;
    }
    idx -= 192;
    if (idx < 192) {
      const int b = idx / 6, h = idx % 6;
      const int tok = b * 256 + w * 32 + l31;
      attn_block_pp<64>(lds, p.kna_c + (size_t)(b * 6 + h) * (256 * 64), p.vna_c + (size_t)(b * 6 + h) * (64 * 256),
                               p.qna + (size_t)tok * 384 + h * 64, p.o + (size_t)tok * D + 384 + h * 64, 8);
      continue;
    }
    idx -= 192;
    {
      const int b = idx >> 2, h = idx & 3;
      const int tok = b * 256 + w * 32 + l31;
      attn_block_diff(lds, p.kdf_c + (size_t)(b * 4 + h) * (256 * 64), p.vdf_c + (size_t)(b * 4 + h) * (64 * 256), p.qdf + (size_t)tok * 256 + h * 64,
                      p.o + (size_t)tok * D + 768 + h * 64, 0.17677669529663687f, 8, lam, p.g_df_sub + l * 64, outscale);
    }
  }
}

__global__ void __launch_bounds__(512, 2) fwd_megakernel(Params p, int ph_begin, int ph_end) {
  __shared__ __attribute__((aligned(16))) char lds[131072 + 16];
  cg::grid_group grid = cg::this_grid();
  if (ph_begin < 0) grid.sync();
  if (threadIdx.x == 0) *(uint4*)(lds + 131072) = make_uint4(0u, 0u, 0u, 0u);
  __syncthreads();
  XcdBarrier xb = xcd_barrier_post(p.bar, (volatile LAS unsigned*)(lds + 131072));
  LAS unsigned char* ldsl = (LAS unsigned char*)lds;
  for (int ph = ph_begin; ph < ph_end; ++ph) {
    if (ph > ph_begin) xcd_barrier(xb);
    if (ph == 0) { phase_prep(p, lds); continue; }
    const int l = (ph - 1) >> 3, s = (ph - 1) & 7;
    switch (s) {
      case 0: if (l == 1) prep_deferred(p, lds, 1 << 20); phase_norm(p, l, 0); break;
      case 1: { EpiIn e{p, l}; pg8::gemm_phase(ldsl, p.h, p.win_t + (size_t)l * NIN * D, T, NIN, D, e); } break;
      case 2: phase_mla_up(p, l, lds); break;
      case 3: phase_attn(p, l, lds); break;
      case 4: { EpiRes<0> e{p, l}; pg8::gemm_phase(ldsl, p.o, p.wout_t + (size_t)l * D * D, T, D, D, e); if (l == 0) prep_deferred(p, lds, BIDX >= 160 ? 4 : 0); } break;
      case 5: phase_norm(p, l, 1); break;
      case 6: { EpiGU e{p}; pg8::gemm_phase(ldsl, p.h, p.wgu_t + (size_t)l * NGU * D, T, NGU, D, e); } break;
      case 7: { EpiRes<1> e{p, l}; pg8::gemm_phase(ldsl, p.act, p.wdn_t + (size_t)l * D * DFF, T, D, DFF, e); if (l == 0) prep_deferred(p, lds, 1 << 20); } break;
    }
  }
}

extern "C" void kernel_launch(void* const* d_in, const int* in_sizes, int n_in, void* d_out, int out_size, void* d_ws, size_t ws_size,
                              hipStream_t stream) {
  static int grid_blocks = 0;
  if (!grid_blocks) {
    int dev = 0, cus = 0, per_cu = 0;
    hipGetDevice(&dev);
    hipDeviceGetAttribute(&cus, hipDeviceAttributeMultiprocessorCount, dev);
    hipOccupancyMaxActiveBlocksPerMultiprocessor(&per_cu, fwd_megakernel, 512, 0);
    if (per_cu > 1) per_cu = 1;
    if (per_cu < 1) per_cu = 1;
    grid_blocks = cus * per_cu;
  }
  Params p{};
  const float** ins = (const float**)&p;
  for (int i = 0; i < 35; ++i) ins[i] = (const float*)d_in[i];
  p.out = (float*)d_out;
  char* w = (char*)d_ws;
  size_t off = 0;
  auto alloc = [&](size_t bytes) { char* r = w + off; off += (bytes + 255) & ~(size_t)255; return r; };
  p.win_t = (u16*)alloc((size_t)2 * NIN * 1024 * 2);
  p.wuq_t = (u16*)alloc((size_t)2 * 576 * 256 * 2);
  p.wukv_t = (u16*)alloc((size_t)2 * 768 * 128 * 2);
  p.wout_t = (u16*)alloc((size_t)2 * 1024 * 1024 * 2);
  p.wgu_t = (u16*)alloc((size_t)2 * NGU * 1024 * 2);
  p.wdn_t = (u16*)alloc((size_t)2 * 1024 * DFF * 2);
  p.mod = (float*)alloc((size_t)2 * 3 * 6144 * 4);
  p.h = (u16*)alloc((size_t)T * D * 2);
  p.cq = (float*)alloc((size_t)T * 256 * 4);
  p.ckv = (float*)alloc((size_t)T * 128 * 4);
  p.krope = (float*)alloc((size_t)T * 32 * 4);
  p.qmla = (u16*)alloc((size_t)T * 576 * 2);
  p.qna = (u16*)alloc((size_t)T * 384 * 2);
  p.qdf = (u16*)alloc((size_t)T * 256 * 2);
  p.kmla_c = (u16*)alloc((size_t)32 * 6 * 256 * 96 * 2);
  p.vmla_c = (u16*)alloc((size_t)32 * 6 * 64 * 256 * 2);
  p.kna_c = (u16*)alloc((size_t)32 * 6 * 256 * 64 * 2);
  p.vna_c = (u16*)alloc((size_t)32 * 6 * 64 * 256 * 2);
  p.kdf_c = (u16*)alloc((size_t)32 * 4 * 256 * 64 * 2);
  p.vdf_c = (u16*)alloc((size_t)32 * 4 * 64 * 256 * 2);
  p.kmla_l = (u16*)alloc((size_t)2 * 2 * 6 * NKL * 96 * 2);
  p.vmla_l = (u16*)alloc((size_t)2 * 2 * 6 * 64 * NKL * 2);
  p.kna_l = (u16*)alloc((size_t)2 * 2 * 6 * NKL * 64 * 2);
  p.vna_l = (u16*)alloc((size_t)2 * 2 * 6 * 64 * NKL * 2);
  p.kdf_l = (u16*)alloc((size_t)2 * 2 * 4 * NKL * 64 * 2);
  p.vdf_l = (u16*)alloc((size_t)2 * 2 * 4 * 64 * NKL * 2);
  p.o = (u16*)alloc((size_t)T * D * 2);
  p.xa = (u16*)alloc((size_t)T * D * 2);
  p.xb = (u16*)alloc((size_t)T * D * 2);
  p.act = (u16*)alloc((size_t)T * DFF * 2);
  p.lam = (float*)alloc(256);
  p.bar = (unsigned*)alloc((size_t)XCD_BAR_WORDS * 4 + 256);
  p.counters = p.bar + XCD_BAR_WORDS;
  if (off > ws_size) { fprintf(stderr, "workspace too small: need %zu have %zu\n", off, ws_size); return; }
  hipMemsetAsync(p.bar, 0, (size_t)XCD_BAR_WORDS * 4 + 256, stream);
  int b = 0, e = 17;
  void* args[] = {&p, &b, &e};
  hipError_t err = hipLaunchCooperativeKernel((void*)fwd_megakernel, dim3(grid_blocks), dim3(512), args, 0, stream);
  if (err != hipSuccess) fprintf(stderr, "cooperative launch failed: %s (grid %d)\n", hipGetErrorString(err), grid_blocks);
}
```

```cpp
#include <hip/hip_runtime.h>
#include <hip/hip_cooperative_groups.h>
#include <cstdio>
#include <cstdint>
namespace cg = cooperative_groups;

typedef unsigned short u16;
typedef __attribute__((ext_vector_type(8))) short bf16x8;
typedef __attribute__((ext_vector_type(4))) float f32x4;
typedef __attribute__((ext_vector_type(16))) float f32x16;
typedef __attribute__((ext_vector_type(4))) unsigned u32x4;

#define DI __device__ __forceinline__

constexpr int D = 1024;
constexpr int TCTX = 8192;
constexpr int TLAT = 2048;
constexpr int T = TCTX + TLAT;
constexpr int NIN = 2560;
constexpr int DFF = 2816;
constexpr int NGU = 2 * DFF;
constexpr float EPS = 1e-6f;
constexpr int NKL = 1280;

constexpr size_t OUT_YP = 0;
constexpr size_t OUT_CKV = 10485760;
constexpr size_t OUT_KROPE = 12582912;
constexpr size_t OUT_NAK = 13107200;
constexpr size_t OUT_NAV = 19398656;
constexpr size_t OUT_DFK = 25690112;
constexpr size_t OUT_DFV = 29884416;

struct Params {
  const float *x_prompt, *x_sample, *cache_mla_ckv, *cache_mla_krope, *cache_na_k, *cache_na_v, *cache_df_k, *cache_df_v, *c, *c_ctx;
  const float *w_mod, *b_mod, *g_mix, *w_in, *g_qa, *w_uq, *g_kva, *w_ukv, *g_mla_q, *g_mla_k, *g_na_q, *g_na_k, *na_rpb, *g_df_q,
      *g_df_k, *df_lq1, *df_lk1, *df_lq2, *df_lk2, *g_df_sub, *w_out, *g_ffn, *w_gate, *w_up, *w_down;
  float* out;
  u16 *win_t, *wuq_t, *wukv_t, *wout_t, *wgu_t, *wdn_t;
  float* mod;
  u16* h;
  float *cq, *ckv, *krope;
  u16 *qmla, *qna, *qdf;
  u16 *kmla_c, *vmla_c, *kna_c, *vna_c, *kdf_c, *vdf_c;
  u16 *kmla_l, *vmla_l, *kna_l, *vna_l, *kdf_l, *vdf_l;
  u16* o;
  u16 *xa, *xb;
  u16* act;
  float* lam;
  unsigned* counters;
  unsigned* bar;
};

DI int opaque_v(int x) { asm volatile("" : "+v"(x)); return x; }
DI int opaque_s(int x) { asm volatile("" : "+s"(x)); return x; }
#define TIDX opaque_v((int)threadIdx.x)
#define BIDX opaque_s((int)blockIdx.x)
DI unsigned cvtpk(float lo, float hi) {
  unsigned r;
  asm volatile("v_cvt_pk_bf16_f32 %0, %1, %2" : "=v"(r) : "v"(lo), "v"(hi));
  return r;
}
DI u16 f2bf(float f) { return (u16)(cvtpk(f, 0.f) & 0xffffu); }
DI bf16x8 pack8(float a0, float a1, float a2, float a3, float a4, float a5, float a6, float a7) {
  uint4 u;
  u.x = cvtpk(a0, a1); u.y = cvtpk(a2, a3); u.z = cvtpk(a4, a5); u.w = cvtpk(a6, a7);
  return __builtin_bit_cast(bf16x8, u);
}
DI void st_bf4(u16* p, float a, float b, float c, float d) {
  uint2 u; u.x = cvtpk(a, b); u.y = cvtpk(c, d);
  *(uint2*)p = u;
}
DI f32x16 mfma32(bf16x8 a, bf16x8 b, f32x16 c) { return __builtin_amdgcn_mfma_f32_32x32x16_bf16(a, b, c, 0, 0, 0); }
DI f32x4 mfma16(bf16x8 a, bf16x8 b, f32x4 c) { return __builtin_amdgcn_mfma_f32_16x16x32_bf16(a, b, c, 0, 0, 0); }
DI float lam_init_of(int l) { return l == 0 ? 0.2f : 0.35550906759f; }
DI f32x4 bf4_to_f32(uint2 u) {
  f32x4 r;
  r[0] = __uint_as_float(u.x << 16); r[1] = __uint_as_float(u.x & 0xffff0000u);
  r[2] = __uint_as_float(u.y << 16); r[3] = __uint_as_float(u.y & 0xffff0000u);
  return r;
}
struct ResSrc { const float* f; const u16* h; };
DI ResSrc xrow_in(const Params& p, int l, int t) {
  ResSrc r; r.f = nullptr; r.h = nullptr;
  if (l == 0) r.f = t < TCTX ? p.x_prompt + (size_t)t * D : p.x_sample + (size_t)(t - TCTX) * D;
  else r.h = p.xb + (size_t)t * D;
  return r;
}
DI ResSrc xa_row(const Params& p, int t) { ResSrc r; r.f = nullptr; r.h = p.xa + (size_t)t * D; return r; }
DI f32x4 res_ld4(const ResSrc& s, int c) { return s.f ? __builtin_nontemporal_load((const f32x4*)(s.f + c)) : bf4_to_f32(*(const uint2*)(s.h + c)); }
DI int cond_of(int t) { return t < TCTX ? 0 : 1 + ((t - TCTX) >> 10); }

DI void rope32(f32x16& x, int s, int hh) {
  const float prow = (float)(s >> 6), pcol = (float)(s & 63);
  const float hs = hh ? 0.01f : 1.0f;
  f32x16 y;
#pragma unroll
  for (int reg = 0; reg < 16; ++reg) {
    const int a = reg >> 3, half = (reg >> 2) & 1, i3 = reg & 3;
    const float base = (i3 == 0) ? 1.0f : (i3 == 1) ? 0.31622776601683794f : (i3 == 2) ? 0.1f : 0.031622776601683794f;
    const float ang = (a ? pcol : prow) * (base * hs);
    const float cs = __cosf(ang), sn = __sinf(ang);
    const float partner = x[reg ^ 4];
    y[reg] = x[reg] * cs + (half ? partner : -partner) * sn;
  }
  x = y;
}


#define XB_TMO      128
#define XB_XCNT(j)  (256  + 64 * (j))
#define XB_XSUB(j)  (1280 + 64 * (j))
#define XB_XGEN(j)  (2304 + 64 * (j))
#define XB_TOP      3328
#define XB_TOPGEN   3392
#define XCD_BAR_WORDS 3456
#define XB_SPIN_CAP (1u << 22)
#define LAS __attribute__((address_space(3)))
DI unsigned xb_ld(unsigned* p) { return __hip_atomic_load(p, __ATOMIC_RELAXED, __HIP_MEMORY_SCOPE_AGENT); }
DI unsigned xb_add(unsigned* p, unsigned v) { return __hip_atomic_fetch_add(p, v, __ATOMIC_RELAXED, __HIP_MEMORY_SCOPE_AGENT); }
DI unsigned xb_xcc_id() { return (unsigned)__builtin_amdgcn_s_getreg((3 << 11) | 20) & 0xFu; }
#define XB_SPIN(cond, bar) do { unsigned _sp = 0; while (cond) { __builtin_amdgcn_s_sleep(1); \
    if ((++_sp & 255u) == 0u) { if (xb_ld(&(bar)[XB_TMO])) break; if (_sp > XB_SPIN_CAP) { atomicAdd(&(bar)[XB_TMO], 1u); break; } } } } while (0)
struct XcdBarrier { unsigned* bar; unsigned x; volatile LAS unsigned* st; };
DI XcdBarrier xcd_barrier_post(unsigned* bar, volatile LAS unsigned* st) {
  XcdBarrier b; b.bar = bar; b.x = xb_xcc_id(); b.st = st;
  if (threadIdx.x == 0) (void)xb_add(&bar[XB_XCNT(b.x)], 1u);
  return b;
}
DI void xcd_barrier_complete(unsigned* bar, unsigned x, unsigned& nloc, unsigned& nx) {
  const unsigned G = gridDim.x * gridDim.y * gridDim.z;
  unsigned sum, cnt, mine, sp = 0u;
  for (;;) {
    sum = 0u; cnt = 0u; mine = 0u;
#pragma unroll
    for (unsigned j = 0; j < 16; ++j) { const unsigned c = xb_ld(&bar[XB_XCNT(j)]); sum += c; cnt += (c > 0u) ? 1u : 0u; mine = (j == x) ? c : mine; }
    if (sum == G) break;
    __builtin_amdgcn_s_sleep(1);
    if ((++sp & 255u) == 0u) { if (xb_ld(&bar[XB_TMO])) break; if (sp > XB_SPIN_CAP) { atomicAdd(&bar[XB_TMO], 1u); break; } }
  }
  nloc = mine > 0u ? mine : 1u; nx = cnt > 0u ? cnt : 1u;
}
DI void xcd_barrier(const XcdBarrier& b) {
  asm volatile("s_waitcnt vmcnt(0)" ::: "memory");
  __syncthreads();
  if (threadIdx.x == 0) {
    unsigned* bar = b.bar;
    __builtin_amdgcn_s_waitcnt(0);
    unsigned nloc = b.st[0], nx = b.st[1];
    if (nloc == 0u) { xcd_barrier_complete(bar, b.x, nloc, nx); b.st[0] = nloc; b.st[1] = nx; }
    const unsigned old = xb_add(&bar[XB_XSUB(b.x)], 1u);
    const unsigned gen = old / nloc;
    if (old + 1u == (gen + 1u) * nloc) {
      __builtin_amdgcn_fence(__ATOMIC_RELEASE, "agent");
      asm volatile("s_waitcnt vmcnt(0)" ::: "memory");
      const unsigned og = xb_add(&bar[XB_TOP], 1u);
      const unsigned tg = og / nx;
      if (og + 1u == (tg + 1u) * nx) xb_add(&bar[XB_TOPGEN], 1u);
      else XB_SPIN(xb_ld(&bar[XB_TOPGEN]) == tg, bar);
      __builtin_amdgcn_fence(__ATOMIC_ACQUIRE, "agent");
      xb_add(&bar[XB_XGEN(b.x)], 1u);
      asm volatile("s_waitcnt vmcnt(0)" ::: "memory");
    } else {
      XB_SPIN(xb_ld(&bar[XB_XGEN(b.x)]) == gen, bar);
      __builtin_amdgcn_fence(__ATOMIC_ACQUIRE, "agent");
      asm volatile("s_waitcnt vmcnt(0)" ::: "memory");
    }
  }
  __syncthreads();
}

DI size_t kf_off(int kidx, int d8  , int ndk) { return ((size_t)((kidx >> 5) * ndk + (d8 >> 4)) * 64 + ((d8 >> 3) & 1) * 32 + (kidx & 31)) * 8; }
DI size_t vf_off(int kidx, int d) {
  const int kin = kidx & 31, q = kin & 15;
  return ((size_t)(((kidx >> 5) * 2 + (kin >> 4)) * 2 + (d >> 5)) * 64 + ((q >> 2) & 1) * 32 + (d & 31)) * 8 + 4 * (q >> 3) + (q & 3);
}

DI int phys_row(int L) {
  const int cl = L & 31;
  const int rho = 16 * ((cl >> 2) & 1) + 4 * (cl >> 3) + (cl & 3);
  return (L & ~255) + ((L >> 5) & 1) * 128 + ((L >> 6) & 3) * 32 + rho;
}
DI int map_row(int type, int n) {
  if (type == 1) {
    const int L = (n < 384) ? n : (n < 416) ? 2304 + (n - 384) : n - 32;
    return phys_row(L);
  }
  if (type == 2 || type == 3) {
    const int cl = n & 31;
    const int rho = 16 * ((cl >> 2) & 1) + 4 * (cl >> 3) + (cl & 3);
    return (n >> 7) * 256 + (type == 3 ? 128 : 0) + ((n >> 5) & 3) * 32 + rho;
  }
  if (type == 0) return phys_row(n);
  return n;
}
DI void transpose_tile(const float* __restrict__ src, int ld_src, int N, int k0, int n0, u16* __restrict__ dst, int ld_dst,
                       int type, int mode, u16* tile, int ng) {
  const int tid = TIDX;
  {
    const int c4 = tid & 15, r0 = tid >> 4;
    float4 v[4][2];
#pragma unroll
    for (int j = 0; j < 4; ++j)
#pragma unroll
      for (int ps = 0; ps < 2; ++ps) {
        v[j][ps] = make_float4(0.f, 0.f, 0.f, 0.f);
        if (j < ng && n0 + j * 64 + c4 * 4 < N) {
          const f32x4 t4 = __builtin_nontemporal_load((const f32x4*)(src + (size_t)(k0 + r0 + ps * 32) * ld_src + n0 + j * 64 + c4 * 4));
          v[j][ps] = make_float4(t4[0], t4[1], t4[2], t4[3]);
        }
      }
#pragma unroll
    for (int j = 0; j < 4; ++j)
      if (j < ng) {
#pragma unroll
        for (int ps = 0; ps < 2; ++ps) {
          unsigned* tp = (unsigned*)(tile + j * 4224 + (r0 + ps * 32) * 66 + c4 * 4);
          tp[0] = cvtpk(v[j][ps].x, v[j][ps].y);
          tp[1] = cvtpk(v[j][ps].z, v[j][ps].w);
        }
      }
  }
  __syncthreads();
  {
    const int kc = tid & 7, nrow = tid >> 3;
    const int k = k0 + kc * 8;
#pragma unroll
    for (int j = 0; j < 4; ++j) {
      const int n = n0 + j * 64 + nrow;
      if (j < ng && n < N) {
        const u16* tj = tile + j * 4224;
        unsigned w[4];
#pragma unroll
        for (int q = 0; q < 4; ++q) {
          const unsigned lo = tj[(kc * 8 + 2 * q) * 66 + nrow];
          const unsigned hi = tj[(kc * 8 + 2 * q + 1) * 66 + nrow];
          w[q] = lo | (hi << 16);
        }
        size_t off;
        if (mode == 0) {
          if (type == 4) {
            off = ((size_t)((n >> 5) * (ld_dst >> 4) + (k >> 4)) * 64 + ((k >> 3) & 1) * 32 + (n & 31)) * 8;
          } else off = (size_t)map_row(type, n) * ld_dst + k;
          *(uint4*)(dst + off) = make_uint4(w[0], w[1], w[2], w[3]);
        } else {
          const size_t o0 = vf_off(k, n);
          *(uint2*)(dst + o0) = make_uint2(w[0], w[1]);
          *(uint2*)(dst + o0 + 32 * 8) = make_uint2(w[2], w[3]);
        }
      }
    }
  }
  __syncthreads();
}

DI void mod_item(const Params& p, int l, int chunk, float* lds) {
  const int tid = TIDX;
  float* sv = lds;
  float* red = lds + 3072;
  for (int i = tid; i < 3072; i += 512) {
    const int n = i >> 10, k = i & 1023;
    const float v = (n == 0) ? p.c_ctx[k] : p.c[(n - 1) * 1024 + k];
    sv[i] = v / (1.f + expf(-v));
  }
  __syncthreads();
  const int c4 = tid & 15, kg = tid >> 4;
  const int c0 = chunk * 64;
  float acc[3][4];
#pragma unroll
  for (int n = 0; n < 3; ++n)
#pragma unroll
    for (int e = 0; e < 4; ++e) acc[n][e] = 0.f;
  const float* wp = p.w_mod + ((size_t)l * 1024 + kg * 32) * 6144 + c0 + c4 * 4;
#pragma unroll 8
  for (int kk = 0; kk < 32; ++kk) {
    const f32x4 w4 = __builtin_nontemporal_load((const f32x4*)(wp + (size_t)kk * 6144));
    const float4 w = make_float4(w4[0], w4[1], w4[2], w4[3]);
    const int k = kg * 32 + kk;
#pragma unroll
    for (int n = 0; n < 3; ++n) {
      const float s = sv[n * 1024 + k];
      acc[n][0] += s * w.x; acc[n][1] += s * w.y; acc[n][2] += s * w.z; acc[n][3] += s * w.w;
    }
  }
#pragma unroll
  for (int n = 0; n < 3; ++n)
#pragma unroll
    for (int e = 0; e < 4; ++e) red[(kg * 12 + n * 4 + e) * 16 + c4] = acc[n][e];
  __syncthreads();
  if (tid < 192) {
    const int n = tid >> 6, cc = tid & 63, cc4 = cc >> 2, e = cc & 3;
    float s = 0.f;
#pragma unroll
    for (int g = 0; g < 32; ++g) s += red[(g * 12 + n * 4 + e) * 16 + cc4];
    p.mod[(size_t)(l * 3 + n) * 6144 + c0 + cc] = s + p.b_mod[(size_t)l * 6144 + c0 + cc];
  }
  __syncthreads();
}

constexpr int P0_TR_PER_LAYER = 160 + 12 + 6 + 64 + 176 + 176 + 176 + 48 + 32;
constexpr int P0_MOD_PER_LAYER = 96;
constexpr int P0_KC_PER_LAYER = 20;
constexpr int P0_PER_LAYER = P0_TR_PER_LAYER + P0_MOD_PER_LAYER + P0_KC_PER_LAYER;

DI void prep_item(const Params& p, int l, int r, char* lds) {
  const int tid = TIDX;
    if (r < P0_MOD_PER_LAYER) { mod_item(p, l, r, (float*)lds); return; }
    r -= P0_MOD_PER_LAYER;
    u16* tile = (u16*)lds;
    if (r < 160) {
      const int kt = r / 10, g = r % 10;
      transpose_tile(p.w_in + (size_t)l * 1024 * 2336, 2336, 2336, kt * 64, g * 256, p.win_t + (size_t)l * NIN * 1024, 1024, 1, 0, tile, min(4, 37 - 4 * g));
      return;
    }
    r -= 160;
    if (r < 12) {
      const int kt = r / 3, g = r % 3;
      transpose_tile(p.w_uq + (size_t)l * 256 * 576, 576, 576, kt * 64, g * 256, p.wuq_t + (size_t)l * 576 * 256, 256, 4, 0, tile, min(4, 9 - 4 * g));
      return;
    }
    r -= 12;
    if (r < 6) {
      const int kt = r / 3, g = r % 3;
      transpose_tile(p.w_ukv + (size_t)l * 128 * 768, 768, 768, kt * 64, g * 256, p.wukv_t + (size_t)l * 768 * 128, 128, 4, 0, tile, 4);
      return;
    }
    r -= 6;
    if (r < 64) {
      const int kt = r / 4, g = r % 4;
      transpose_tile(p.w_out + (size_t)l * 1024 * 1024, 1024, 1024, kt * 64, g * 256, p.wout_t + (size_t)l * 1024 * 1024, 1024, 0, 0, tile, 4);
      return;
    }
    r -= 64;
    if (r < 176) {
      const int kt = r / 11, g = r % 11;
      transpose_tile(p.w_gate + (size_t)l * 1024 * DFF, DFF, DFF, kt * 64, g * 256, p.wgu_t + (size_t)l * NGU * 1024, 1024, 2, 0, tile, 4);
      return;
    }
    r -= 176;
    if (r < 176) {
      const int kt = r / 11, g = r % 11;
      transpose_tile(p.w_up + (size_t)l * 1024 * DFF, DFF, DFF, kt * 64, g * 256, p.wgu_t + (size_t)l * NGU * 1024, 1024, 3, 0, tile, 4);
      return;
    }
    r -= 176;
    if (r < 176) {
      const int kt = r / 4, g = r % 4;
      transpose_tile(p.w_down + (size_t)l * DFF * 1024, 1024, 1024, kt * 64, g * 256, p.wdn_t + (size_t)l * 1024 * DFF, DFF, 0, 0, tile, 4);
      return;
    }
    r -= 176;
    if (r < 48) {
      const int bh = r >> 2, kt = r & 3, b = bh / 6, hh = bh % 6;
      transpose_tile(p.cache_na_v + ((size_t)((b * 2 + l) * 6 + hh) * 256) * 64, 64, 64, kt * 64, 0,
                     p.vna_l + (size_t)l * (2 * 6 * 64 * NKL) + (size_t)bh * (64 * NKL), 0, 0, 1, tile, 1);
      return;
    }
    r -= 48;
    if (r < 32) {
      const int bh = r >> 2, kt = r & 3, b = bh / 4, hh = bh % 4;
      transpose_tile(p.cache_df_v + ((size_t)((b * 2 + l) * 4 + hh) * 256) * 64, 64, 64, kt * 64, 0,
                     p.vdf_l + (size_t)l * (2 * 4 * 64 * NKL) + (size_t)bh * (64 * NKL), 0, 0, 1, tile, 1);
      return;
    }
    r -= 32;
    {
      const float* src;
      u16* dst;
      if (r < 12) {
        const int b = r / 6, hh = r % 6;
        src = p.cache_na_k + ((size_t)((b * 2 + l) * 6 + hh) * 256) * 64;
        dst = p.kna_l + (size_t)l * (2 * 6 * NKL * 64) + (size_t)(b * 6 + hh) * (NKL * 64);
      } else {
        const int q = r - 12, b = q / 4, hh = q % 4;
        src = p.cache_df_k + ((size_t)((b * 2 + l) * 4 + hh) * 256) * 64;
        dst = p.kdf_l + (size_t)l * (2 * 4 * NKL * 64) + (size_t)(b * 4 + hh) * (NKL * 64);
      }
      float4 v[8];
#pragma unroll
      for (int i = 0; i < 8; ++i) v[i] = *(const float4*)(src + (tid + 512 * i) * 4);
#pragma unroll
      for (int i = 0; i < 8; ++i) {
        const int e = (tid + 512 * i) * 4;
        const int key = e >> 6, d4 = e & 63;
        st_bf4(dst + kf_off(key, d4 & ~7, 4) + (d4 & 7), v[i].x, v[i].y, v[i].z, v[i].w);
      }
    }
}

constexpr int P0_W_ITEMS = 160 + 12 + 6 + 64 + 176 + 176 + 176;
DI void phase_prep(const Params& p, char* lds) {
  const int tid = TIDX;
  if (BIDX == 0 && tid == 0) {
    for (int l = 0; l < 2; ++l) {
      float s1 = 0.f, s2 = 0.f;
      for (int i = 0; i < 32; ++i) {
        s1 += p.df_lq1[l * 32 + i] * p.df_lk1[l * 32 + i];
        s2 += p.df_lq2[l * 32 + i] * p.df_lk2[l * 32 + i];
      }
      p.lam[l] = expf(s1) - expf(s2) + lam_init_of(l);
    }
  }
  constexpr int NREST0 = P0_PER_LAYER - P0_MOD_PER_LAYER;
  constexpr int NREST1 = P0_PER_LAYER - P0_MOD_PER_LAYER - P0_W_ITEMS;
  for (int item = BIDX; item < 2 * P0_MOD_PER_LAYER + NREST0 + NREST1; item += gridDim.x) {
    int l, r;
    if (item < 2 * P0_MOD_PER_LAYER) { l = item / P0_MOD_PER_LAYER; r = item % P0_MOD_PER_LAYER; }
    else if (item < 2 * P0_MOD_PER_LAYER + NREST0) { l = 0; r = P0_MOD_PER_LAYER + (item - 2 * P0_MOD_PER_LAYER); }
    else { l = 1; r = P0_MOD_PER_LAYER + P0_W_ITEMS + (item - 2 * P0_MOD_PER_LAYER - NREST0); }
    prep_item(p, l, r, lds);
  }
}

DI void prep_deferred(const Params& p, char* lds, int cap) {
  const int tid = TIDX;
  volatile LAS unsigned* slot = (volatile LAS unsigned*)((LAS unsigned char*)lds + 131072 + 8);
  for (int n = 0; n < cap; ++n) {
    __syncthreads();
    if (tid == 0) *slot = atomicAdd(&p.counters[8], 1u);
    __syncthreads();
    const unsigned it = __builtin_amdgcn_readfirstlane(*slot);
    if (it >= (unsigned)P0_W_ITEMS) break;
    prep_item(p, 1, P0_MOD_PER_LAYER + (int)it, lds);
  }
}

DI void phase_norm(const Params& p, int l, int which  ) {
  const int lane = TIDX & 63, wid = TIDX >> 6;
  const float* g = (which == 0 ? p.g_mix : p.g_ffn) + l * D;
  const int nw = gridDim.x * 8;
  for (int t = BIDX * 8 + wid; t < T; t += 2 * nw) {
    const int t1 = t + nw;
    const bool has1 = t1 < T;
    const int tb = has1 ? t1 : t;
    const bool f32src = (which == 0 && l == 0);
    const float* sh0 = p.mod + (size_t)((l * 3 + cond_of(t)) * 6 + (which == 0 ? 0 : 3)) * D;
    const float* sh1 = p.mod + (size_t)((l * 3 + cond_of(tb)) * 6 + (which == 0 ? 0 : 3)) * D;
    float4 v0[4], v1[4], gg[4], sa0[4], sb0[4], sa1[4], sb1[4];
#pragma unroll
    for (int i = 0; i < 4; ++i) {
      const int c = i * 256 + lane * 4;
      gg[i] = *(const float4*)(g + c);
      sb0[i] = *(const float4*)(sh0 + c); sa0[i] = *(const float4*)(sh0 + D + c);
      sb1[i] = *(const float4*)(sh1 + c); sa1[i] = *(const float4*)(sh1 + D + c);
    }
    if (f32src) {
      const float* x0 = t < TCTX ? p.x_prompt + (size_t)t * D : p.x_sample + (size_t)(t - TCTX) * D;
      const float* x1 = tb < TCTX ? p.x_prompt + (size_t)tb * D : p.x_sample + (size_t)(tb - TCTX) * D;
#pragma unroll
      for (int i = 0; i < 4; ++i) {
        const int c = i * 256 + lane * 4;
        const f32x4 a = __builtin_nontemporal_load((const f32x4*)(x0 + c)), b2 = __builtin_nontemporal_load((const f32x4*)(x1 + c));
        v0[i] = make_float4(a[0], a[1], a[2], a[3]); v1[i] = make_float4(b2[0], b2[1], b2[2], b2[3]);
      }
    } else {
      const u16* hsrc = (which == 0) ? p.xb : p.xa;
#pragma unroll
      for (int i = 0; i < 4; ++i) {
        const int c = i * 256 + lane * 4;
        const f32x4 a = bf4_to_f32(*(const uint2*)(hsrc + (size_t)t * D + c)), b2 = bf4_to_f32(*(const uint2*)(hsrc + (size_t)tb * D + c));
        v0[i] = make_float4(a[0], a[1], a[2], a[3]); v1[i] = make_float4(b2[0], b2[1], b2[2], b2[3]);
      }
    }
    float ss0 = 0.f, ss1 = 0.f;
#pragma unroll
    for (int i = 0; i < 4; ++i) {
      ss0 += v0[i].x * v0[i].x + v0[i].y * v0[i].y + v0[i].z * v0[i].z + v0[i].w * v0[i].w;
      ss1 += v1[i].x * v1[i].x + v1[i].y * v1[i].y + v1[i].z * v1[i].z + v1[i].w * v1[i].w;
    }
#pragma unroll
    for (int m = 1; m < 64; m <<= 1) { ss0 += __shfl_xor(ss0, m); ss1 += __shfl_xor(ss1, m); }
    const float r0 = rsqrtf(ss0 * (1.f / D) + EPS), r1 = rsqrtf(ss1 * (1.f / D) + EPS);
#pragma unroll
    for (int i = 0; i < 4; ++i) {
      const int c = i * 256 + lane * 4;
      st_bf4(p.h + (size_t)t * D + c, v0[i].x * r0 * gg[i].x * (1.f + sa0[i].x) + sb0[i].x, v0[i].y * r0 * gg[i].y * (1.f + sa0[i].y) + sb0[i].y,
             v0[i].z * r0 * gg[i].z * (1.f + sa0[i].z) + sb0[i].z, v0[i].w * r0 * gg[i].w * (1.f + sa0[i].w) + sb0[i].w);
    }
    if (has1) {
#pragma unroll
      for (int i = 0; i < 4; ++i) {
        const int c = i * 256 + lane * 4;
        st_bf4(p.h + (size_t)t1 * D + c, v1[i].x * r1 * gg[i].x * (1.f + sa1[i].x) + sb1[i].x, v1[i].y * r1 * gg[i].y * (1.f + sa1[i].y) + sb1[i].y,
               v1[i].z * r1 * gg[i].z * (1.f + sa1[i].z) + sb1[i].z, v1[i].w * r1 * gg[i].w * (1.f + sa1[i].w) + sb1[i].w);
      }
    }
  }
}

namespace pg8 {
typedef unsigned short bf16_t;
constexpr int BM = 256, BK = 64, HALF = 128, HTB = HALF * BK * 2, STAGE_BYTES = 8 * HTB, NXCD = 8, WGM = 8;
DI int lds_byte(int r, int c) { const int st = (r >> 4) * 2 + (c >> 5), rr = r & 15, cc = c & 31, ob = rr * 64 + cc * 2; return st * 1024 + (ob ^ (((ob >> 9) & 1) << 5)); }
DI void stage_rc(int b, int& R, int& C) { const int st = b / 1024, sb = b % 1024, swz = sb ^ (((sb >> 9) & 1) << 5); R = (st >> 1) * 16 + swz / 64; C = (st & 1) * 32 + (swz % 64) / 2; }
struct Unit { int pm, pn; };
struct StaticOrder {
  int nM, nN, nwg, G, c;
  DI void init(int M, int N, int G_, int c_) { nM = M / BM; nN = N / BM; nwg = nM * nN; G = G_; c = c_; }
  DI bool next(int i, Unit& u) const {
    const long L = (long)i * G + c; if (L >= nwg) return false;
    int wgid = (int)L; { const int q = nwg / NXCD, r = nwg % NXCD, xcd = wgid % NXCD, off = wgid / NXCD; wgid = (xcd < r ? xcd * (q + 1) : r * (q + 1) + (xcd - r) * q) + off; }
    const int nig = WGM * nN, gid = wgid / nig, fm = gid * WGM, gsz = (nM - fm) < WGM ? (nM - fm) : WGM;
    u.pm = fm + ((wgid % nig) % gsz); u.pn = (wgid % nig) / gsz; return true;
  }
};

template <class Epi>
DI void gemm_phase(LAS unsigned char* lds, const bf16_t* gA, const bf16_t* gBt, int M, int N, int K, const Epi& E) {
  const int tid = TIDX, wid = __builtin_amdgcn_readfirstlane(tid >> 6), lane = tid & 63, wr = wid >> 2, wc = wid & 3, fr = lane & 15, fq = lane >> 4;
  const int nt = K / BK;
  StaticOrder S; S.init(M, N, (int)gridDim.x, BIDX);
  unsigned voffA[2];
#pragma unroll
  for (int i = 0; i < 2; ++i) { int R, C; stage_rc(tid * 16 + i * 8192, R, C); voffA[i] = (unsigned)(R * K + C) * 2u; }
  const size_t kstep = (size_t)(BK * 2);
  const size_t hstep = (size_t)HALF * K * 2;
  const size_t tstep = 2 * hstep;
  const unsigned ldsw = (unsigned)wid * 1024u;
  const int aoff = lds_byte(wr * 64 + fr, fq * 8), boff = lds_byte(wc * 32 + fr, fq * 8);
#define PG8_SA(b, h) (((b) * 2 + (h)) * HTB)
#define PG8_SB(b, h) ((4 + (b) * 2 + (h)) * HTB)
#define PG8_STAGE(bufoff, gbase) do { _Pragma("unroll") for (int _i = 0; _i < 2; ++_i) \
    __builtin_amdgcn_global_load_lds((const unsigned*)((const char*)(gbase) + voffA[_i]), (LAS unsigned*)(lds + (bufoff) + ldsw + _i * 8192), 16, 0, 0); } while (0)
#define PG8_LDA(dst, b, h) do { _Pragma("unroll") for (int m = 0; m < 4; ++m) _Pragma("unroll") for (int k = 0; k < 2; ++k) dst[m][k] = *(const LAS bf16x8*)(lds + PG8_SA(b, h) + aoff + m * 2048 + k * 1024); } while (0)
#define PG8_LDB(dst, b, h) do { _Pragma("unroll") for (int n = 0; n < 2; ++n) _Pragma("unroll") for (int k = 0; k < 2; ++k) dst[n][k] = *(const LAS bf16x8*)(lds + PG8_SB(b, h) + boff + n * 2048 + k * 1024); } while (0)
#define PG8_MMA(ai, bj, At, Bt) do { __builtin_amdgcn_s_setprio(1); _Pragma("unroll") for (int m = 0; m < 4; ++m) _Pragma("unroll") for (int n = 0; n < 2; ++n) _Pragma("unroll") for (int k = 0; k < 2; ++k) \
    acc[ai][bj][m][n] = __builtin_amdgcn_mfma_f32_16x16x32_bf16(Bt[n][k], At[m][k], acc[ai][bj][m][n], 0, 0, 0); __builtin_amdgcn_s_setprio(0); } while (0)
#define PG8_WAIT_V(n) asm volatile("s_waitcnt vmcnt(" #n ")" ::: "memory")
#define PG8_WAIT_L(n) asm volatile("s_waitcnt lgkmcnt(" #n ")" ::: "memory")
#define PG8_BAR __builtin_amdgcn_s_barrier()
#define PG8_SCHED __builtin_amdgcn_sched_barrier(0)
  Unit cur, nxt; int ui = 0;
  if (!S.next(0, cur)) return;
  f32x4 acc[2][2][4][2];
#pragma unroll
  for (int a = 0; a < 2; ++a)
#pragma unroll
    for (int b = 0; b < 2; ++b)
#pragma unroll
      for (int m = 0; m < 4; ++m)
#pragma unroll
        for (int n = 0; n < 2; ++n) acc[a][b][m][n] = (f32x4){0.f, 0.f, 0.f, 0.f};
  bf16x8 At[4][2], B0[2][2], B1[2][2];
  const char* cA = (const char*)gA + (size_t)cur.pm * tstep; const char* cB = (const char*)gBt + (size_t)cur.pn * tstep;
  PG8_STAGE(PG8_SB(0, 0), cB); PG8_STAGE(PG8_SA(0, 0), cA); PG8_STAGE(PG8_SB(0, 1), cB + hstep); PG8_STAGE(PG8_SA(0, 1), cA + hstep);
  if (wr == 1) PG8_BAR;
  PG8_WAIT_V(4); PG8_BAR;
  PG8_STAGE(PG8_SB(1, 0), cB + kstep); PG8_STAGE(PG8_SA(1, 0), cA + kstep); PG8_STAGE(PG8_SB(1, 1), cB + hstep + kstep);
  PG8_WAIT_V(6); PG8_BAR;
  for (;;) {
    const bool has_next = S.next(ui + 1, nxt);
    const char* nA = has_next ? (const char*)gA + (size_t)nxt.pm * tstep : cA; const char* nB = has_next ? (const char*)gBt + (size_t)nxt.pn * tstep : cB;
    for (int t = 0; t < nt; t += 2) {
      const bool last = (t == nt - 2);
      const char* a1 = cA + (size_t)(t + 1) * kstep;
      const char* a2 = last ? nA : cA + (size_t)(t + 2) * kstep; const char* b2 = last ? nB : cB + (size_t)(t + 2) * kstep;
      const char* a3 = a2 + kstep; const char* b3 = b2 + kstep;
      PG8_LDB(B0, 0, 0); PG8_SCHED; PG8_LDA(At, 0, 0); PG8_STAGE(PG8_SA(1, 1), a1 + hstep);
      PG8_WAIT_L(8); PG8_BAR; PG8_WAIT_L(0); PG8_MMA(0, 0, At, B0); PG8_BAR; PG8_SCHED;
      PG8_LDB(B1, 0, 1); PG8_STAGE(PG8_SB(0, 0), b2);
      PG8_BAR; PG8_WAIT_L(0); PG8_MMA(0, 1, At, B1); PG8_BAR;
      PG8_LDA(At, 0, 1); PG8_STAGE(PG8_SA(0, 0), a2);
      PG8_BAR; PG8_WAIT_L(0); PG8_MMA(1, 0, At, B0); PG8_BAR; PG8_SCHED;
      PG8_STAGE(PG8_SB(0, 1), b2 + hstep);
      PG8_WAIT_V(6); PG8_BAR; PG8_MMA(1, 1, At, B1); PG8_BAR;
      PG8_LDB(B0, 1, 0); PG8_SCHED; PG8_LDA(At, 1, 0); PG8_STAGE(PG8_SA(0, 1), a2 + hstep);
      PG8_WAIT_L(8); PG8_BAR; PG8_WAIT_L(0); PG8_MMA(0, 0, At, B0); PG8_BAR; PG8_SCHED;
      PG8_LDB(B1, 1, 1); PG8_STAGE(PG8_SB(1, 0), b3);
      PG8_BAR; PG8_WAIT_L(0); PG8_MMA(0, 1, At, B1); PG8_BAR;
      PG8_LDA(At, 1, 1); PG8_STAGE(PG8_SA(1, 0), a3);
      PG8_BAR; PG8_WAIT_L(0); PG8_MMA(1, 0, At, B0); PG8_BAR; PG8_SCHED;
      PG8_STAGE(PG8_SB(1, 1), b3 + hstep);
      PG8_WAIT_V(6); PG8_BAR; PG8_MMA(1, 1, At, B1); PG8_BAR;
    }
    {
      int fr2 = fr, fq2 = fq; Unit cu = cur;
      asm volatile("" : "+v"(fr2), "+v"(fq2), "+s"(cu.pm), "+s"(cu.pn));
      E(acc, cu, wr, wc, fr2, fq2);
    }
    if (!has_next) break;
#pragma unroll
    for (int a = 0; a < 2; ++a)
#pragma unroll
      for (int b = 0; b < 2; ++b)
#pragma unroll
        for (int m = 0; m < 4; ++m)
#pragma unroll
          for (int n = 0; n < 2; ++n) acc[a][b][m][n] = (f32x4){0.f, 0.f, 0.f, 0.f};
    cur = nxt; cA = nA; cB = nB; ++ui;
  }
  PG8_WAIT_V(0);
  if (wr == 0) PG8_BAR;
  PG8_BAR;
#undef PG8_SA
#undef PG8_SB
#undef PG8_STAGE
#undef PG8_LDA
#undef PG8_LDB
#undef PG8_MMA
#undef PG8_WAIT_V
#undef PG8_WAIT_L
#undef PG8_BAR
#undef PG8_SCHED
}
}

typedef f32x4 AccT[2][2][4][2];
DI void st_nt4(float* p_, f32x4 v_) { __builtin_nontemporal_store(v_, (f32x4*)p_); }
DI float dot4(f32x4 a) { return a[0] * a[0] + a[1] * a[1] + a[2] * a[2] + a[3] * a[3]; }
DI float rowsum_q(float v) { v += __shfl_xor(v, 16); v += __shfl_xor(v, 32); return v; }
DI void st_bf8(u16* p, f32x4 a, f32x4 b) {
  u32x4 w; w.x = cvtpk(a[0], a[1]); w.y = cvtpk(a[2], a[3]); w.z = cvtpk(b[0], b[1]); w.w = cvtpk(b[2], b[3]);
  *(u32x4*)p = w;
}

struct EpiIn {
  const Params& p; int l;
  DI void operator()(const AccT& acc, const pg8::Unit& u, int wr, int wc, int fr, int fq) const {
    const int wcb = u.pn * 4 + wc;
    if (wcb > 36) return;
    const bool is_ctx = u.pm < 32;
    const int r0 = u.pm * 256 + wr * 64 + fr;
    int b, s0;
    if (is_ctx) { b = u.pm; s0 = wr * 64 + fr; }
    else { const int tl = r0 - TCTX; b = tl >> 10; s0 = tl & 1023; }
    const int c8 = 8 * fq;
    if (wcb < 4) {
#pragma unroll
      for (int ai = 0; ai < 2; ++ai)
#pragma unroll
        for (int m = 0; m < 4; ++m) {
          asm volatile("" ::: "memory");
          float* rp = p.cq + (size_t)(r0 + ai * 128 + m * 16) * 256 + wcb * 64 + c8;
#pragma unroll
          for (int bj = 0; bj < 2; ++bj)
#pragma unroll
            for (int n = 0; n < 2; ++n) *(f32x4*)(rp + bj * 32 + 4 * n) = acc[ai][bj][m][n];
        }
    } else if (wcb < 6) {
#pragma unroll
      for (int ai = 0; ai < 2; ++ai)
#pragma unroll
        for (int m = 0; m < 4; ++m) {
          asm volatile("" ::: "memory");
          float* rp = p.ckv + (size_t)(r0 + ai * 128 + m * 16) * 128 + (wcb - 4) * 64 + c8;
#pragma unroll
          for (int bj = 0; bj < 2; ++bj)
#pragma unroll
            for (int n = 0; n < 2; ++n) *(f32x4*)(rp + bj * 32 + 4 * n) = acc[ai][bj][m][n];
        }
    } else if (wcb < 18) {
      const bool isq = wcb < 12;
      const int hd = isq ? wcb - 6 : wcb - 12;
      const float* g = (isq ? p.g_na_q : p.g_na_k) + l * 64 + c8;
      f32x4 gv[2][2];
#pragma unroll
      for (int bj = 0; bj < 2; ++bj)
#pragma unroll
        for (int n = 0; n < 2; ++n) gv[bj][n] = *(const f32x4*)(g + bj * 32 + 4 * n);
#pragma unroll
      for (int ai = 0; ai < 2; ++ai)
#pragma unroll
        for (int m = 0; m < 4; ++m) {
          asm volatile("" ::: "memory");
          float ss = dot4(acc[ai][0][m][0]) + dot4(acc[ai][0][m][1]) + dot4(acc[ai][1][m][0]) + dot4(acc[ai][1][m][1]);
          ss = rowsum_q(ss);
          const float rstd = rsqrtf(ss * (1.f / 64.f) + EPS) * (isq ? 0.18033688011112042f : 1.f);
          const int t = r0 + ai * 128 + m * 16, s = s0 + ai * 128 + m * 16;
          f32x4 v[2][2];
#pragma unroll
          for (int bj = 0; bj < 2; ++bj)
#pragma unroll
            for (int n = 0; n < 2; ++n) v[bj][n] = acc[ai][bj][m][n] * rstd * gv[bj][n];
          if (isq) {
            u16* qp = p.qna + (size_t)t * 384 + hd * 64 + c8;
            st_bf8(qp, v[0][0], v[0][1]); st_bf8(qp + 32, v[1][0], v[1][1]);
          } else if (is_ctx) {
            float* op = p.out + OUT_NAK + ((size_t)((b * 2 + l) * 6 + hd) * 256 + s) * 64 + c8;
            st_nt4(op, v[0][0]); st_nt4(op + 4, v[0][1]); st_nt4(op + 32, v[1][0]); st_nt4(op + 36, v[1][1]);
            u16* kp = p.kna_c + (size_t)(b * 6 + hd) * (256 * 64);
            st_bf8(kp + kf_off(s, c8, 4), v[0][0], v[0][1]); st_bf8(kp + kf_off(s, 32 + c8, 4), v[1][0], v[1][1]);
          } else {
            u16* kp = p.kna_l + (size_t)l * (2 * 6 * NKL * 64) + (size_t)(b * 6 + hd) * (NKL * 64);
            st_bf8(kp + kf_off(256 + s, c8, 4), v[0][0], v[0][1]); st_bf8(kp + kf_off(256 + s, 32 + c8, 4), v[1][0], v[1][1]);
          }
        }
    } else if (wcb < 24 || (wcb >= 32 && wcb < 36)) {
      const bool isna = wcb < 24;
      const int hd = isna ? wcb - 18 : wcb - 32;
      const int nh = isna ? 6 : 4;
      const int vh = isna ? hd : 6 + hd;
      float* ob = p.out + (isna ? OUT_NAV : OUT_DFV) + ((size_t)((b * 2 + l) * nh + hd) * 256) * 64 + c8;
      u16* vb = is_ctx ? (isna ? p.vna_c : p.vdf_c) + (size_t)(b * nh + hd) * (64 * 256)
                       : (isna ? p.vna_l : p.vdf_l) + (size_t)l * (2 * nh * 64 * NKL) + (size_t)(b * nh + hd) * (64 * NKL);
      (void)vh;
#pragma unroll
      for (int ai = 0; ai < 2; ++ai)
#pragma unroll
        for (int m = 0; m < 4; ++m) {
          asm volatile("" ::: "memory");
          const int s = s0 + ai * 128 + m * 16;
          u16* vk = vb + vf_off((is_ctx ? 0 : 256) + s, c8);
#pragma unroll
          for (int bj = 0; bj < 2; ++bj)
#pragma unroll
            for (int n = 0; n < 2; ++n) {
              const unsigned lo = cvtpk(acc[ai][bj][m][n][0], acc[ai][bj][m][n][1]), hi = cvtpk(acc[ai][bj][m][n][2], acc[ai][bj][m][n][3]);
              u16* q = vk + bj * 512 + n * 32;
              q[0] = (u16)(lo & 0xffffu); q[8] = (u16)(lo >> 16); q[16] = (u16)(hi & 0xffffu); q[24] = (u16)(hi >> 16);
            }
          if (is_ctx) {
            float* op = ob + (size_t)s * 64;
            st_nt4(op, acc[ai][0][m][0]); st_nt4(op + 4, acc[ai][0][m][1]); st_nt4(op + 32, acc[ai][1][m][0]); st_nt4(op + 36, acc[ai][1][m][1]);
          }
        }
    } else if (wcb < 32) {
      const bool isq = wcb < 28;
      const int hd = isq ? wcb - 24 : wcb - 28;
      const float* g = (isq ? p.g_df_q : p.g_df_k) + l * 32 + c8;
      const f32x4 g0 = *(const f32x4*)(g), g1 = *(const f32x4*)(g + 4);
      const int ra = fq >> 1, half = fq & 1;
#pragma unroll
      for (int ai = 0; ai < 2; ++ai)
#pragma unroll
        for (int m = 0; m < 4; ++m) {
          asm volatile("" ::: "memory");
          const int t = r0 + ai * 128 + m * 16, s = s0 + ai * 128 + m * 16;
          f32x4 v[2][2];
#pragma unroll
          for (int bj = 0; bj < 2; ++bj) {
            float ss = dot4(acc[ai][bj][m][0]) + dot4(acc[ai][bj][m][1]);
            ss = rowsum_q(ss);
            const float rstd = rsqrtf(ss * (1.f / 32.f) + EPS) * (isq ? 0.25503486164919736f : 1.f);
            v[bj][0] = acc[ai][bj][m][0] * rstd * g0;
            v[bj][1] = acc[ai][bj][m][1] * rstd * g1;
          }
          if (!is_ctx) {
            const float pos = ra ? (float)(s & 63) : (float)(s >> 6);
#pragma unroll
            for (int bj = 0; bj < 2; ++bj)
#pragma unroll
              for (int n = 0; n < 2; ++n)
#pragma unroll
                for (int e = 0; e < 4; ++e) {
                  const int i = 4 * n + e;
                  const float inv = (i == 0) ? 1.0f : (i == 1) ? 0.31622776601683794f : (i == 2) ? 0.1f : (i == 3) ? 0.031622776601683794f
                                  : (i == 4) ? 0.01f : (i == 5) ? 0.0031622776601683794f : (i == 6) ? 0.001f : 0.00031622776601683794f;
                  const float ang = pos * inv;
                  const float cs = __cosf(ang), sn = __sinf(ang);
                  const float x = v[bj][n][e];
                  const float partner = __shfl_xor(x, 16);
                  v[bj][n][e] = x * cs + (half ? partner : -partner) * sn;
                }
          }
          if (isq) {
            u16* qp = p.qdf + (size_t)t * 256 + hd * 64 + c8;
            st_bf8(qp, v[0][0], v[0][1]); st_bf8(qp + 32, v[1][0], v[1][1]);
          } else if (is_ctx) {
            float* op = p.out + OUT_DFK + ((size_t)((b * 2 + l) * 4 + hd) * 256 + s) * 64 + c8;
            st_nt4(op, v[0][0]); st_nt4(op + 4, v[0][1]); st_nt4(op + 32, v[1][0]); st_nt4(op + 36, v[1][1]);
            u16* kp = p.kdf_c + (size_t)(b * 4 + hd) * (256 * 64);
            st_bf8(kp + kf_off(s, c8, 4), v[0][0], v[0][1]); st_bf8(kp + kf_off(s, 32 + c8, 4), v[1][0], v[1][1]);
          } else {
            u16* kp = p.kdf_l + (size_t)l * (2 * 4 * NKL * 64) + (size_t)(b * 4 + hd) * (NKL * 64);
            st_bf8(kp + kf_off(256 + s, c8, 4), v[0][0], v[0][1]); st_bf8(kp + kf_off(256 + s, 32 + c8, 4), v[1][0], v[1][1]);
          }
        }
    } else {
#pragma unroll
      for (int ai = 0; ai < 2; ++ai)
#pragma unroll
        for (int m = 0; m < 4; ++m) {
          asm volatile("" ::: "memory");
          const int t = r0 + ai * 128 + m * 16, s = s0 + ai * 128 + m * 16;
          float* kp = p.krope + (size_t)t * 32 + c8;
          *(f32x4*)(kp) = acc[ai][0][m][0]; *(f32x4*)(kp + 4) = acc[ai][0][m][1];
          if (is_ctx) {
            float* op = p.out + OUT_KROPE + ((size_t)(b * 2 + l) * 256 + s) * 32 + c8;
            st_nt4(op, acc[ai][0][m][0]); st_nt4(op + 4, acc[ai][0][m][1]);
          }
        }
    }
  }
};

template <int WHICH  >
struct EpiRes {
  const Params& p; int l;
  DI void operator()(const AccT& acc, const pg8::Unit& u, int wr, int wc, int fr, int fq) const {
    const int cond = u.pm < 32 ? 0 : 1 + ((u.pm - 32) >> 2);
    const int c0 = u.pn * 256 + wc * 64 + 8 * fq;
    const float* gate = p.mod + (size_t)((l * 3 + cond) * 6 + (WHICH == 0 ? 2 : 5)) * D + c0;
    f32x4 gv[2][2];
#pragma unroll
    for (int bj = 0; bj < 2; ++bj)
#pragma unroll
      for (int n = 0; n < 2; ++n) gv[bj][n] = *(const f32x4*)(gate + bj * 32 + 4 * n);
    u16* dsth = (WHICH == 0) ? p.xa : p.xb;
    const bool to_out = (WHICH == 1 && l == 1);
#pragma unroll
    for (int ai = 0; ai < 2; ++ai)
#pragma unroll
      for (int mh = 0; mh < 2; ++mh) {
        f32x4 xi[2][2][2];
        if (WHICH == 0 && l == 0) {
#pragma unroll
          for (int mm = 0; mm < 2; ++mm) {
            const int t = u.pm * 256 + ai * 128 + wr * 64 + (mh * 2 + mm) * 16 + fr;
            const float* xin = (u.pm < 32 ? p.x_prompt + (size_t)t * D : p.x_sample + (size_t)(t - TCTX) * D) + c0;
#pragma unroll
            for (int bj = 0; bj < 2; ++bj)
#pragma unroll
              for (int n = 0; n < 2; ++n) xi[mm][bj][n] = __builtin_nontemporal_load((const f32x4*)(xin + bj * 32 + 4 * n));
          }
        } else {
          const u16* hsrc = (WHICH == 0) ? p.xb : p.xa;
#pragma unroll
          for (int mm = 0; mm < 2; ++mm) {
            const int t = u.pm * 256 + ai * 128 + wr * 64 + (mh * 2 + mm) * 16 + fr;
#pragma unroll
            for (int bj = 0; bj < 2; ++bj) {
              const uint4 q = *(const uint4*)(hsrc + (size_t)t * D + c0 + bj * 32);
              xi[mm][bj][0] = bf4_to_f32(make_uint2(q.x, q.y));
              xi[mm][bj][1] = bf4_to_f32(make_uint2(q.z, q.w));
            }
          }
        }
#pragma unroll
        for (int mm = 0; mm < 2; ++mm) {
          const int m = mh * 2 + mm;
          const int t = u.pm * 256 + ai * 128 + wr * 64 + m * 16 + fr;
          if (to_out) {
            float* xo = p.out + (size_t)t * D + c0;
#pragma unroll
            for (int bj = 0; bj < 2; ++bj)
#pragma unroll
              for (int n = 0; n < 2; ++n) st_nt4(xo + bj * 32 + 4 * n, xi[mm][bj][n] + gv[bj][n] * acc[ai][bj][m][n]);
          } else {
            u16* xo = dsth + (size_t)t * D + c0;
#pragma unroll
            for (int bj = 0; bj < 2; ++bj)
              st_bf8(xo + bj * 32, xi[mm][bj][0] + gv[bj][0] * acc[ai][bj][m][0], xi[mm][bj][1] + gv[bj][1] * acc[ai][bj][m][1]);
          }
        }
      }
  }
};

struct EpiGU {
  const Params& p;
  DI void operator()(const AccT& acc, const pg8::Unit& u, int wr, int wc, int fr, int fq) const {
    const int f0 = u.pn * 128 + wc * 32 + 8 * fq;
#pragma unroll
    for (int ai = 0; ai < 2; ++ai)
#pragma unroll
      for (int m = 0; m < 4; ++m) {
        const int t = u.pm * 256 + ai * 128 + wr * 64 + m * 16 + fr;
        f32x4 o[2];
#pragma unroll
        for (int n = 0; n < 2; ++n)
#pragma unroll
          for (int e = 0; e < 4; ++e) {
            const float gvv = acc[ai][0][m][n][e], uv = acc[ai][1][m][n][e];
            o[n][e] = gvv * __builtin_amdgcn_rcpf(1.f + __builtin_amdgcn_exp2f(-1.4426950408889634f * gvv)) * uv;
          }
        st_bf8(p.act + (size_t)t * DFF + f0, o[0], o[1]);
      }
  }
};

DI void mla_q_load(const Params& p, int l, int tb, bf16x8 (&bfr)[16], float& rstd) {
  const int lane = TIDX & 63, l31 = lane & 31, hh = lane >> 5;
  const int tok = tb * 32 + l31;
  const float* cqrow = p.cq + (size_t)tok * 256;
  const float* gq = p.g_qa + l * 256;
  float ss = 0.f;
#pragma unroll
  for (int ks = 0; ks < 16; ++ks) {
    const int k = ks * 16 + 8 * hh;
    const float4 a = *(const float4*)(cqrow + k), b2 = *(const float4*)(cqrow + k + 4);
    const float4 ga = *(const float4*)(gq + k), gb = *(const float4*)(gq + k + 4);
    ss += a.x * a.x + a.y * a.y + a.z * a.z + a.w * a.w + b2.x * b2.x + b2.y * b2.y + b2.z * b2.z + b2.w * b2.w;
    bfr[ks] = pack8(a.x * ga.x, a.y * ga.y, a.z * ga.z, a.w * ga.w, b2.x * gb.x, b2.y * gb.y, b2.z * gb.z, b2.w * gb.w);
  }
  ss += __shfl_xor(ss, 32);
  rstd = rsqrtf(ss * (1.f / 256.f) + EPS);
}

DI void mla_q_compute(const Params& p, int l, int tb, int h, const LAS unsigned char* wl, const bf16x8 (&bfr)[16], float rstd) {
  const int lane = TIDX & 63, l31 = lane & 31, hh = lane >> 5;
  const int tok = tb * 32 + l31;
  float4 gq2[3][4];
#pragma unroll
  for (int nt = 0; nt < 3; ++nt)
#pragma unroll
    for (int gi = 0; gi < 4; ++gi) gq2[nt][gi] = *(const float4*)(p.g_mla_q + l * 96 + nt * 32 + 8 * gi + 4 * hh);
  f32x16 acc[3];
  const LAS unsigned char* W = wl + lane * 16;
#pragma unroll
  for (int nt = 0; nt < 3; ++nt) {
#pragma unroll
    for (int r = 0; r < 16; ++r) acc[nt][r] = 0.f;
#pragma unroll
    for (int ks = 0; ks < 16; ++ks) {
      const bf16x8 wf = *(const LAS bf16x8*)(W + (nt * 16 + ks) * 1024);
      acc[nt] = mfma32(wf, bfr[ks], acc[nt]);
    }
  }
  float s2 = 0.f;
#pragma unroll
  for (int nt = 0; nt < 3; ++nt)
#pragma unroll
    for (int r = 0; r < 16; ++r) { acc[nt][r] *= rstd; s2 += acc[nt][r] * acc[nt][r]; }
  s2 += __shfl_xor(s2, 32);
  const float rstd2 = rsqrtf(s2 * (1.f / 96.f) + EPS) * 0.14724444602590306f;
#pragma unroll
  for (int nt = 0; nt < 3; ++nt)
#pragma unroll
    for (int gi = 0; gi < 4; ++gi) {
      const float4 gg = gq2[nt][gi];
      acc[nt][4 * gi + 0] *= rstd2 * gg.x; acc[nt][4 * gi + 1] *= rstd2 * gg.y;
      acc[nt][4 * gi + 2] *= rstd2 * gg.z; acc[nt][4 * gi + 3] *= rstd2 * gg.w;
    }
  if (tok >= TCTX) rope32(acc[2], (tok - TCTX) & 1023, hh);
  u16* qo = p.qmla + (size_t)tok * 576 + h * 96 + 4 * hh;
#pragma unroll
  for (int nt = 0; nt < 3; ++nt)
#pragma unroll
    for (int gi = 0; gi < 4; ++gi)
      st_bf4(qo + nt * 32 + 8 * gi, acc[nt][4 * gi], acc[nt][4 * gi + 1], acc[nt][4 * gi + 2], acc[nt][4 * gi + 3]);
}

struct KvRow { const float* csrc; const float* krsrc; int b, s; bool is_tok, is_ctx; };
DI KvRow kv_row(const Params& p, int l, int rb) {
  const int lane = TIDX & 63, l31 = lane & 31;
  const int row = rb * 32 + l31;
  KvRow r;
  r.is_tok = row < T;
  r.is_ctx = row < TCTX;
  if (r.is_tok) {
    r.csrc = p.ckv + (size_t)row * 128;
    r.krsrc = p.krope + (size_t)row * 32;
    if (r.is_ctx) { r.b = row >> 8; r.s = row & 255; }
    else { r.b = (row - TCTX) >> 10; r.s = (row - TCTX) & 1023; }
  } else {
    const int rr = row - T;
    r.b = rr >> 8; r.s = rr & 255;
    r.csrc = p.cache_mla_ckv + ((size_t)(r.b * 2 + l) * 256 + r.s) * 128;
    r.krsrc = p.cache_mla_krope + ((size_t)(r.b * 2 + l) * 256 + r.s) * 32;
  }
  return r;
}

DI void mla_kv_load(const Params& p, int l, int rb, bf16x8 (&bfr)[8], float& rstd) {
  const int lane = TIDX & 63, hh = lane >> 5;
  const KvRow R = kv_row(p, l, rb);
  const float* gk = p.g_kva + l * 128;
  float ss = 0.f;
#pragma unroll
  for (int ks = 0; ks < 8; ++ks) {
    const int k = ks * 16 + 8 * hh;
    const float4 a = *(const float4*)(R.csrc + k), b2 = *(const float4*)(R.csrc + k + 4);
    float4 ga = *(const float4*)(gk + k), gb = *(const float4*)(gk + k + 4);
    if (!R.is_tok) { ga = make_float4(1.f, 1.f, 1.f, 1.f); gb = ga; }
    ss += a.x * a.x + a.y * a.y + a.z * a.z + a.w * a.w + b2.x * b2.x + b2.y * b2.y + b2.z * b2.z + b2.w * b2.w;
    bfr[ks] = pack8(a.x * ga.x, a.y * ga.y, a.z * ga.z, a.w * ga.w, b2.x * gb.x, b2.y * gb.y, b2.z * gb.z, b2.w * gb.w);
  }
  ss += __shfl_xor(ss, 32);
  rstd = R.is_tok ? rsqrtf(ss * (1.f / 128.f) + EPS) : 1.f;
}

DI void mla_kv_compute(const Params& p, int l, int rb, int h, const LAS unsigned char* wl, const bf16x8 (&bfr)[8], float rstd) {
  const int lane = TIDX & 63, hh = lane >> 5;
  const KvRow R = kv_row(p, l, rb);
  const bool is_tok = R.is_tok, is_ctx = R.is_ctx;
  const int b = R.b, s = R.s;
  const float* gk = p.g_kva + l * 128;
  f32x16 kr;
#pragma unroll
  for (int gi = 0; gi < 4; ++gi) {
    const float4 v = *(const float4*)(R.krsrc + 8 * gi + 4 * hh);
    kr[4 * gi] = v.x; kr[4 * gi + 1] = v.y; kr[4 * gi + 2] = v.z; kr[4 * gi + 3] = v.w;
  }
  const float* g = p.g_mla_k + l * 96;
  float4 gk0[4], gk1[4], gk2[4];
#pragma unroll
  for (int gi = 0; gi < 4; ++gi) {
    gk0[gi] = *(const float4*)(g + 8 * gi + 4 * hh); gk1[gi] = *(const float4*)(g + 32 + 8 * gi + 4 * hh); gk2[gi] = *(const float4*)(g + 64 + 8 * gi + 4 * hh);
  }
  f32x16 acc[4];
  const LAS unsigned char* W = wl + lane * 16;
#pragma unroll
  for (int nt = 0; nt < 4; ++nt) {
#pragma unroll
    for (int r = 0; r < 16; ++r) acc[nt][r] = 0.f;
#pragma unroll
    for (int ks = 0; ks < 8; ++ks) {
      const bf16x8 wf = *(const LAS bf16x8*)(W + (nt * 8 + ks) * 1024);
      acc[nt] = mfma32(wf, bfr[ks], acc[nt]);
    }
  }
  float sk = 0.f;
#pragma unroll
  for (int nt = 0; nt < 4; ++nt)
#pragma unroll
    for (int r = 0; r < 16; ++r) acc[nt][r] *= rstd;
#pragma unroll
  for (int r = 0; r < 16; ++r) sk += acc[0][r] * acc[0][r] + acc[1][r] * acc[1][r] + kr[r] * kr[r];
  sk += __shfl_xor(sk, 32);
  const float rstdk = rsqrtf(sk * (1.f / 96.f) + EPS);
#pragma unroll
  for (int gi = 0; gi < 4; ++gi) {
    const float4 g0 = gk0[gi], g1 = gk1[gi], g2 = gk2[gi];
    acc[0][4 * gi] *= rstdk * g0.x; acc[0][4 * gi + 1] *= rstdk * g0.y; acc[0][4 * gi + 2] *= rstdk * g0.z; acc[0][4 * gi + 3] *= rstdk * g0.w;
    acc[1][4 * gi] *= rstdk * g1.x; acc[1][4 * gi + 1] *= rstdk * g1.y; acc[1][4 * gi + 2] *= rstdk * g1.z; acc[1][4 * gi + 3] *= rstdk * g1.w;
    kr[4 * gi] *= rstdk * g2.x; kr[4 * gi + 1] *= rstdk * g2.y; kr[4 * gi + 2] *= rstdk * g2.z; kr[4 * gi + 3] *= rstdk * g2.w;
  }
  if (is_tok && !is_ctx) rope32(kr, s, hh);
  u16 *kd, *vd;
  int kidx;
  if (is_ctx) {
    kidx = s;
    kd = p.kmla_c + (size_t)(b * 6 + h) * (256 * 96);
    vd = p.vmla_c + (size_t)(b * 6 + h) * (64 * 256);
  } else {
    kidx = is_tok ? 256 + s : s;
    kd = p.kmla_l + (size_t)l * (2 * 6 * NKL * 96) + (size_t)(b * 6 + h) * (NKL * 96);
    vd = p.vmla_l + (size_t)l * (2 * 6 * 64 * NKL) + (size_t)(b * 6 + h) * (64 * NKL);
  }
#pragma unroll
  for (int gi = 0; gi < 4; ++gi) {
    st_bf4(kd + kf_off(kidx, 8 * gi, 6) + 4 * hh, acc[0][4 * gi], acc[0][4 * gi + 1], acc[0][4 * gi + 2], acc[0][4 * gi + 3]);
    st_bf4(kd + kf_off(kidx, 32 + 8 * gi, 6) + 4 * hh, acc[1][4 * gi], acc[1][4 * gi + 1], acc[1][4 * gi + 2], acc[1][4 * gi + 3]);
    st_bf4(kd + kf_off(kidx, 64 + 8 * gi, 6) + 4 * hh, kr[4 * gi], kr[4 * gi + 1], kr[4 * gi + 2], kr[4 * gi + 3]);
  }
#pragma unroll
  for (int nt = 0; nt < 2; ++nt)
#pragma unroll
    for (int r = 0; r < 16; ++r) {
      const int d = nt * 32 + (r & 3) + 8 * (r >> 2) + 4 * hh;
      vd[vf_off(kidx, d)] = f2bf(acc[2 + nt][r]);
    }
  if (is_ctx && h == 0) {
    float* ob = p.out + OUT_CKV + ((size_t)(b * 2 + l) * 256 + s) * 128;
    float4 oa[8], obv[8];
#pragma unroll
    for (int ks = 0; ks < 8; ++ks) {
      const int k = ks * 16 + 8 * hh;
      const float4 a = *(const float4*)(R.csrc + k), b2 = *(const float4*)(R.csrc + k + 4);
      const float4 ga = *(const float4*)(gk + k), gb = *(const float4*)(gk + k + 4);
      oa[ks] = make_float4(a.x * rstd * ga.x, a.y * rstd * ga.y, a.z * rstd * ga.z, a.w * rstd * ga.w);
      obv[ks] = make_float4(b2.x * rstd * gb.x, b2.y * rstd * gb.y, b2.z * rstd * gb.z, b2.w * rstd * gb.w);
    }
#pragma unroll
    for (int ks = 0; ks < 8; ++ks) {
      const int k = ks * 16 + 8 * hh;
      st_nt4(ob + k, (f32x4){oa[ks].x, oa[ks].y, oa[ks].z, oa[ks].w});
      st_nt4(ob + k + 4, (f32x4){obv[ks].x, obv[ks].y, obv[ks].z, obv[ks].w});
    }
  }
}

DI void phase_mla_up(const Params& p, int l, char* lds) {
  const int tid = TIDX, lane = tid & 63, w = __builtin_amdgcn_readfirstlane(tid >> 6);
  LAS unsigned char* ldsl = (LAS unsigned char*)lds;
  const int nslot = ((int)gridDim.x + 7) >> 3;
  for (int it0 = (BIDX & 7) * nslot + (BIDX >> 3); it0 < 252 + 8 * nslot; it0 += 8 * nslot) {
    const int item = it0;
    if (item >= 252 || (BIDX >> 3) >= nslot) break;
    __syncthreads();
    const bool hasq = item < 240;
    const int h = item % 6, grp = item / 6;
    if (hasq) {
      const u16* wsrc = p.wuq_t + (size_t)l * 576 * 256 + (size_t)(h * 3) * (16 * 512) + lane * 8;
#pragma unroll
      for (int i = 0; i < 6; ++i) {
        const int blk = w + 8 * i;
        __builtin_amdgcn_global_load_lds((const unsigned*)(wsrc + blk * 512), (LAS unsigned*)(ldsl + blk * 1024), 16, 0, 0);
      }
    }
    {
      const u16* wsrc = p.wukv_t + (size_t)l * 768 * 128 + (size_t)(h * 4) * (8 * 512) + lane * 8;
#pragma unroll
      for (int i = 0; i < 4; ++i) {
        const int blk = w + 8 * i;
        __builtin_amdgcn_global_load_lds((const unsigned*)(wsrc + blk * 512), (LAS unsigned*)(ldsl + 49152 + blk * 1024), 16, 0, 0);
      }
    }
    bf16x8 bq[16], bk[8];
    float rq = 1.f, rk = 1.f;
    if (hasq) mla_q_load(p, l, grp * 8 + w, bq, rq);
    mla_kv_load(p, l, grp * 8 + w, bk, rk);
    asm volatile("s_waitcnt vmcnt(0)" ::: "memory");
    __syncthreads();
    if (hasq) mla_q_compute(p, l, grp * 8 + w, h, ldsl, bq, rq);
    mla_kv_compute(p, l, grp * 8 + w, h, ldsl + 49152, bk, rk);
  }
}

constexpr int ATT_NST = 8, ATT_STB = 10240, ATT_RPB_OFF = ATT_NST * ATT_STB;
#define ATT_BAR() do { __builtin_amdgcn_s_barrier(); asm volatile("" ::: "memory"); } while (0)

template <int NDK>
DI void att_issue(LAS unsigned char* lds, const u16* Kb, const u16* Vb, int kt, int st, int w, int lane) {
#pragma unroll
  for (int i = 0; i < 2; ++i) {
    const int j = w + 8 * i;
    if (j < NDK + 4) {
      const u16* src = (j < NDK) ? Kb + (size_t)kt * (NDK * 512) + j * 512 : Vb + (size_t)kt * 2048 + (j - NDK) * 512;
      const int dst = st * ATT_STB + ((j < NDK) ? j * 1024 : 6144 + (j - NDK) * 1024);
      __builtin_amdgcn_global_load_lds((const unsigned*)(src + lane * 8), (LAS unsigned*)(lds + dst), 16, 0, 0);
    }
  }
}

template <int DQK, int MODE>
DI void attn_block_single(LAS unsigned char* lds, const u16* __restrict__ Kb, const u16* __restrict__ Vb, const u16* __restrict__ qrow,
                          u16* __restrict__ orow, float scale, int ntiles, int r, int qc, int rs0) {
  const int tid = TIDX, lane = tid & 63, w = __builtin_amdgcn_readfirstlane(tid >> 6), hh = lane >> 5;
  constexpr int NDK = DQK / 16;
  const int nl = (w + 8 < NDK + 4) ? 2 : 1;
#define ATT_KT(t_) ((MODE == 1 && (t_) >= 8) ? 8 + (rs0 + (((t_) - 8) >> 1)) * 2 + (((t_) - 8) & 1) : (t_))
  for (int tt = 0; tt < ATT_NST - 1; ++tt) { const int tc = min(tt, ntiles - 1); att_issue<NDK>(lds, Kb, Vb, ATT_KT(tc), tt, w, lane); }
  bf16x8 qf[NDK];
#pragma unroll
  for (int dk = 0; dk < NDK; ++dk) qf[dk] = *(const bf16x8*)(qrow + dk * 16 + 8 * hh);
#pragma unroll
  for (int dk = 0; dk < NDK; ++dk) asm volatile("" :: "v"(qf[dk]));
  f32x16 o0, o1;
#pragma unroll
  for (int i = 0; i < 16; ++i) { o0[i] = 0.f; o1[i] = 0.f; }
  float mrun = -1e30f, lsum = 0.f;
  int rs = 0, cs = 0;
  if (MODE == 1) { rs = min(max(r - 4, 0), 8); cs = min(max(qc - 8, 0), 48); }
  const LAS float* rpbl = (const LAS float*)(lds + ATT_RPB_OFF);
  for (int t = 0; t < ntiles; ++t) {
    if (nl == 2) asm volatile("s_waitcnt vmcnt(12)" ::: "memory"); else asm volatile("s_waitcnt vmcnt(6)" ::: "memory");
    ATT_BAR();
    { const int tn = min(t + ATT_NST - 1, ntiles - 1); att_issue<NDK>(lds, Kb, Vb, ATT_KT(tn), (t + ATT_NST - 1) & (ATT_NST - 1), w, lane); }
    int jr = 0, ct = 0;
    if (MODE == 1 && t >= 8) {
      jr = rs0 + ((t - 8) >> 1) - rs; ct = (t - 8) & 1;
      if (jr < 0 || jr > 7) continue;
    }
    const LAS unsigned char* sp = lds + (t & (ATT_NST - 1)) * ATT_STB + lane * 16;
    f32x16 s;
#pragma unroll
    for (int i = 0; i < 16; ++i) s[i] = 0.f;
    __builtin_amdgcn_s_setprio(1);
#pragma unroll
    for (int dk = 0; dk < NDK; ++dk) s = mfma32(*(const LAS bf16x8*)(sp + dk * 1024), qf[dk], s);
    __builtin_amdgcn_s_setprio(0);
    const bf16x8 v00 = *(const LAS bf16x8*)(sp + 6144), v01 = *(const LAS bf16x8*)(sp + 6144 + 1024),
                 v10 = *(const LAS bf16x8*)(sp + 6144 + 2048), v11 = *(const LAS bf16x8*)(sp + 6144 + 3072);
    float tmax = -1e30f;
    if (MODE == 1 && t >= 8) {
      const LAS float* rp = rpbl + (rs + jr - r + 7) * 31;
#pragma unroll
      for (int reg = 0; reg < 16; ++reg) {
        const int kc = ct * 32 + (reg & 3) + 8 * (reg >> 2) + 4 * hh;
        const int rc = min(max(kc - qc, -15), 15) + 15;
        const float bias = rp[rc];
        const float v = (kc >= cs && kc < cs + 16) ? s[reg] + bias : -1e30f;
        s[reg] = v;
        tmax = fmaxf(tmax, v);
      }
    } else {
#pragma unroll
      for (int reg = 0; reg < 16; ++reg) tmax = fmaxf(tmax, s[reg]);
    }
    tmax = fmaxf(tmax, __shfl_xor(tmax, 32));
    const float mn = fmaxf(mrun, tmax);
    if (__builtin_amdgcn_ballot_w64(mn != mrun) != 0ull) {
      const float alpha = __builtin_amdgcn_exp2f(mrun - mn);
      lsum *= alpha;
#pragma unroll
      for (int i = 0; i < 16; ++i) { o0[i] *= alpha; o1[i] *= alpha; }
    }
    mrun = mn;
    float ps = 0.f;
#pragma unroll
    for (int reg = 0; reg < 16; ++reg) { const float pv = __builtin_amdgcn_exp2f(s[reg] - mn); s[reg] = pv; ps += pv; }
    lsum += ps;
    const bf16x8 pf0 = pack8(s[0], s[1], s[2], s[3], s[4], s[5], s[6], s[7]);
    const bf16x8 pf1 = pack8(s[8], s[9], s[10], s[11], s[12], s[13], s[14], s[15]);
    __builtin_amdgcn_s_setprio(1);
    o0 = mfma32(v00, pf0, o0);
    o1 = mfma32(v01, pf0, o1);
    o0 = mfma32(v10, pf1, o0);
    o1 = mfma32(v11, pf1, o1);
    __builtin_amdgcn_s_setprio(0);
  }
#undef ATT_KT
  asm volatile("s_waitcnt vmcnt(0)" ::: "memory");
  ATT_BAR();
  lsum += __shfl_xor(lsum, 32);
  const float inv = 1.f / lsum;
  u16* op = orow + 4 * hh;
#pragma unroll
  for (int gi = 0; gi < 4; ++gi) {
    st_bf4(op + 8 * gi, o0[4 * gi] * inv, o0[4 * gi + 1] * inv, o0[4 * gi + 2] * inv, o0[4 * gi + 3] * inv);
    st_bf4(op + 32 + 8 * gi, o1[4 * gi] * inv, o1[4 * gi + 1] * inv, o1[4 * gi + 2] * inv, o1[4 * gi + 3] * inv);
  }
}

template <int DQK>
DI void attn_block_pp(LAS unsigned char* lds, const u16* __restrict__ Kb, const u16* __restrict__ Vb, const u16* __restrict__ qrow,
                      u16* __restrict__ orow, int ntiles) {
  const int tid = TIDX, lane = tid & 63, w = __builtin_amdgcn_readfirstlane(tid >> 6), hh = lane >> 5;
  constexpr int NDK = DQK / 16;
  const int nl = (w + 8 < NDK + 4) ? 2 : 1;
  for (int tt = 0; tt < ATT_NST - 1; ++tt) att_issue<NDK>(lds, Kb, Vb, min(tt, ntiles - 1), tt, w, lane);
  bf16x8 qf[NDK];
#pragma unroll
  for (int dk = 0; dk < NDK; ++dk) qf[dk] = *(const bf16x8*)(qrow + dk * 16 + 8 * hh);
#pragma unroll
  for (int dk = 0; dk < NDK; ++dk) asm volatile("" :: "v"(qf[dk]));
  f32x16 o0, o1;
#pragma unroll
  for (int i = 0; i < 16; ++i) { o0[i] = 0.f; o1[i] = 0.f; }
  float mrun = -1e30f, lsum = 0.f;
  asm volatile("s_waitcnt vmcnt(0)" ::: "memory");
  ATT_BAR();
  f32x16 sn;
#pragma unroll
  for (int i = 0; i < 16; ++i) sn[i] = 0.f;
  {
    const LAS unsigned char* sp0 = lds + lane * 16;
#pragma unroll
    for (int dk = 0; dk < NDK; ++dk) sn = mfma32(*(const LAS bf16x8*)(sp0 + dk * 1024), qf[dk], sn);
  }
  for (int t = 0; t < ntiles; ++t) {
    if (nl == 2) asm volatile("s_waitcnt vmcnt(10)" ::: "memory"); else asm volatile("s_waitcnt vmcnt(5)" ::: "memory");
    ATT_BAR();
    { const int tn = min(t + ATT_NST - 1, ntiles - 1); att_issue<NDK>(lds, Kb, Vb, tn, (t + ATT_NST - 1) & (ATT_NST - 1), w, lane); }
    const LAS unsigned char* sp = lds + (t & (ATT_NST - 1)) * ATT_STB + lane * 16;
    const LAS unsigned char* spn = lds + ((t + 1) & (ATT_NST - 1)) * ATT_STB + lane * 16;
    f32x16 s = sn;
    const bf16x8 v00 = *(const LAS bf16x8*)(sp + 6144), v01 = *(const LAS bf16x8*)(sp + 6144 + 1024),
                 v10 = *(const LAS bf16x8*)(sp + 6144 + 2048), v11 = *(const LAS bf16x8*)(sp + 6144 + 3072);
#pragma unroll
    for (int i = 0; i < 16; ++i) sn[i] = 0.f;
#pragma unroll
    for (int dk = 0; dk < NDK; ++dk) sn = mfma32(*(const LAS bf16x8*)(spn + dk * 1024), qf[dk], sn);
    float tmax = -1e30f;
#pragma unroll
    for (int reg = 0; reg < 16; ++reg) tmax = fmaxf(tmax, s[reg]);
    tmax = fmaxf(tmax, __shfl_xor(tmax, 32));
    const float mn = fmaxf(mrun, tmax);
    {
      const float alpha = __builtin_amdgcn_exp2f(mrun - mn);
      lsum *= alpha;
#pragma unroll
      for (int i = 0; i < 16; ++i) { o0[i] *= alpha; o1[i] *= alpha; }
    }
    mrun = mn;
    float ps = 0.f;
#pragma unroll
    for (int reg = 0; reg < 16; ++reg) { const float pv = __builtin_amdgcn_exp2f(s[reg] - mn); s[reg] = pv; ps += pv; }
    lsum += ps;
    const bf16x8 pf0 = pack8(s[0], s[1], s[2], s[3], s[4], s[5], s[6], s[7]);
    const bf16x8 pf1 = pack8(s[8], s[9], s[10], s[11], s[12], s[13], s[14], s[15]);
    __builtin_amdgcn_s_setprio(1);
    o0 = mfma32(v00, pf0, o0);
    o1 = mfma32(v01, pf0, o1);
    o0 = mfma32(v10, pf1, o0);
    o1 = mfma32(v11, pf1, o1);
    __builtin_amdgcn_s_setprio(0);
  }
  asm volatile("s_waitcnt vmcnt(0)" ::: "memory");
  ATT_BAR();
  lsum += __shfl_xor(lsum, 32);
  const float inv = 1.f / lsum;
  u16* op = orow + 4 * hh;
#pragma unroll
  for (int gi = 0; gi < 4; ++gi) {
    st_bf4(op + 8 * gi, o0[4 * gi] * inv, o0[4 * gi + 1] * inv, o0[4 * gi + 2] * inv, o0[4 * gi + 3] * inv);
    st_bf4(op + 32 + 8 * gi, o1[4 * gi] * inv, o1[4 * gi + 1] * inv, o1[4 * gi + 2] * inv, o1[4 * gi + 3] * inv);
  }
}

DI void attn_block_diff(LAS unsigned char* lds, const u16* __restrict__ Kb, const u16* __restrict__ Vb, const u16* __restrict__ qrow,
                        u16* __restrict__ orow, float scale, int ntiles, float lam, const float* __restrict__ gsub, float outscale) {
  const int tid = TIDX, lane = tid & 63, w = __builtin_amdgcn_readfirstlane(tid >> 6), hh = lane >> 5;
  for (int tt = 0; tt < ATT_NST - 1; ++tt) att_issue<4>(lds, Kb, Vb, min(tt, ntiles - 1), tt, w, lane);
  bf16x8 qf[4];
#pragma unroll
  for (int dk = 0; dk < 4; ++dk) qf[dk] = *(const bf16x8*)(qrow + dk * 16 + 8 * hh);
#pragma unroll
  for (int dk = 0; dk < 4; ++dk) asm volatile("" :: "v"(qf[dk]));
  f32x16 oa0, oa1, ob0, ob1;
#pragma unroll
  for (int i = 0; i < 16; ++i) { oa0[i] = 0.f; oa1[i] = 0.f; ob0[i] = 0.f; ob1[i] = 0.f; }
  float m1 = -1e30f, l1 = 0.f, m2 = -1e30f, l2 = 0.f;
  for (int t = 0; t < ntiles; ++t) {
    asm volatile("s_waitcnt vmcnt(6)" ::: "memory");
    ATT_BAR();
    att_issue<4>(lds, Kb, Vb, min(t + ATT_NST - 1, ntiles - 1), (t + ATT_NST - 1) & (ATT_NST - 1), w, lane);
    const LAS unsigned char* sp = lds + (t & (ATT_NST - 1)) * ATT_STB + lane * 16;
    f32x16 s1, s2;
#pragma unroll
    for (int i = 0; i < 16; ++i) { s1[i] = 0.f; s2[i] = 0.f; }
    __builtin_amdgcn_s_setprio(1);
    s1 = mfma32(*(const LAS bf16x8*)(sp), qf[0], s1); s1 = mfma32(*(const LAS bf16x8*)(sp + 1024), qf[1], s1);
    s2 = mfma32(*(const LAS bf16x8*)(sp + 2048), qf[2], s2); s2 = mfma32(*(const LAS bf16x8*)(sp + 3072), qf[3], s2);
    __builtin_amdgcn_s_setprio(0);
    const bf16x8 v00 = *(const LAS bf16x8*)(sp + 6144), v10 = *(const LAS bf16x8*)(sp + 6144 + 1024),
                 v01 = *(const LAS bf16x8*)(sp + 6144 + 2048), v11 = *(const LAS bf16x8*)(sp + 6144 + 3072);
    float t1 = -1e30f, t2 = -1e30f;
#pragma unroll
    for (int reg = 0; reg < 16; ++reg) {
      t1 = fmaxf(t1, s1[reg]); t2 = fmaxf(t2, s2[reg]);
    }
    t1 = fmaxf(t1, __shfl_xor(t1, 32));
    t2 = fmaxf(t2, __shfl_xor(t2, 32));
    const float mn1 = fmaxf(m1, t1), mn2 = fmaxf(m2, t2);
    if (__builtin_amdgcn_ballot_w64(mn1 != m1) != 0ull) {
      const float a1 = __builtin_amdgcn_exp2f(m1 - mn1);
      l1 *= a1;
#pragma unroll
      for (int i = 0; i < 16; ++i) { oa0[i] *= a1; oa1[i] *= a1; }
    }
    if (__builtin_amdgcn_ballot_w64(mn2 != m2) != 0ull) {
      const float a2 = __builtin_amdgcn_exp2f(m2 - mn2);
      l2 *= a2;
#pragma unroll
      for (int i = 0; i < 16; ++i) { ob0[i] *= a2; ob1[i] *= a2; }
    }
    m1 = mn1; m2 = mn2;
    float p1 = 0.f, p2 = 0.f;
#pragma unroll
    for (int reg = 0; reg < 16; ++reg) {
      const float e1 = __builtin_amdgcn_exp2f(s1[reg] - mn1), e2 = __builtin_amdgcn_exp2f(s2[reg] - mn2);
      s1[reg] = e1; s2[reg] = e2; p1 += e1; p2 += e2;
    }
    l1 += p1; l2 += p2;
    const bf16x8 pa0 = pack8(s1[0], s1[1], s1[2], s1[3], s1[4], s1[5], s1[6], s1[7]);
    const bf16x8 pa1 = pack8(s1[8], s1[9], s1[10], s1[11], s1[12], s1[13], s1[14], s1[15]);
    const bf16x8 pb0 = pack8(s2[0], s2[1], s2[2], s2[3], s2[4], s2[5], s2[6], s2[7]);
    const bf16x8 pb1 = pack8(s2[8], s2[9], s2[10], s2[11], s2[12], s2[13], s2[14], s2[15]);
    __builtin_amdgcn_s_setprio(1);
    oa0 = mfma32(v00, pa0, oa0); oa1 = mfma32(v10, pa0, oa1);
    oa0 = mfma32(v01, pa1, oa0); oa1 = mfma32(v11, pa1, oa1);
    ob0 = mfma32(v00, pb0, ob0); ob1 = mfma32(v10, pb0, ob1);
    ob0 = mfma32(v01, pb1, ob0); ob1 = mfma32(v11, pb1, ob1);
    __builtin_amdgcn_s_setprio(0);
  }
  asm volatile("s_waitcnt vmcnt(0)" ::: "memory");
  ATT_BAR();
  l1 += __shfl_xor(l1, 32);
  l2 += __shfl_xor(l2, 32);
  const float i1 = 1.f / l1, i2 = lam / l2;
  float ss = 0.f;
#pragma unroll
  for (int i = 0; i < 16; ++i) {
    oa0[i] = oa0[i] * i1 - ob0[i] * i2;
    oa1[i] = oa1[i] * i1 - ob1[i] * i2;
    ss += oa0[i] * oa0[i] + oa1[i] * oa1[i];
  }
  ss += __shfl_xor(ss, 32);
  const float rstd = rsqrtf(ss * (1.f / 64.f) + EPS) * outscale;
  u16* op = orow + 4 * hh;
  float4 gs0[4], gs1[4];
#pragma unroll
  for (int gi = 0; gi < 4; ++gi) { gs0[gi] = *(const float4*)(gsub + 8 * gi + 4 * hh); gs1[gi] = *(const float4*)(gsub + 32 + 8 * gi + 4 * hh); }
#pragma unroll
  for (int gi = 0; gi < 4; ++gi) {
    const float4 g0 = gs0[gi], g1 = gs1[gi];
    st_bf4(op + 8 * gi, oa0[4 * gi] * rstd * g0.x, oa0[4 * gi + 1] * rstd * g0.y, oa0[4 * gi + 2] * rstd * g0.z, oa0[4 * gi + 3] * rstd * g0.w);
    st_bf4(op + 32 + 8 * gi, oa1[4 * gi] * rstd * g1.x, oa1[4 * gi + 1] * rstd * g1.y, oa1[4 * gi + 2] * rstd * g1.z, oa1[4 * gi + 3] * rstd * g1.w);
  }
}

constexpr int ATT_ITEMS = 640;
DI void phase_attn(const Params& p, int l, char* ldsg) {
  LAS unsigned char* lds = (LAS unsigned char*)ldsg;
  const int tid = TIDX, lane = tid & 63, l31 = lane & 31, w = __builtin_amdgcn_readfirstlane(tid >> 6);
  const float lam = p.lam[l];
  const float outscale = 1.f - lam_init_of(l);
  volatile LAS unsigned* slot = (volatile LAS unsigned*)(lds + 131072 + 8);
  for (;;) {
    __syncthreads();
    if (tid == 0) *slot = atomicAdd(&p.counters[l], 1u);
    __syncthreads();
    const unsigned it = __builtin_amdgcn_readfirstlane(*slot);
    if (it >= (unsigned)ATT_ITEMS) break;
    int idx = (int)it;
    if (idx < 32) {
      const int b = idx >> 4, h = (idx >> 2) & 3, qb = (idx & 3) * 8 + w;
      const int tok = TCTX + b * 1024 + qb * 32 + l31;
      attn_block_diff(lds, p.kdf_l + (size_t)l * (2 * 4 * NKL * 64) + (size_t)(b * 4 + h) * (NKL * 64),
                      p.vdf_l + (size_t)l * (2 * 4 * 64 * NKL) + (size_t)(b * 4 + h) * (64 * NKL), p.qdf + (size_t)tok * 256 + h * 64,
                      p.o + (size_t)tok * D + 768 + h * 64, 0.17677669529663687f, 40, lam, p.g_df_sub + l * 64, outscale);
      continue;
    }
    idx -= 32;
    if (idx < 48) {
      const int b = idx / 24, h = (idx >> 2) % 6, qb = (idx & 3) * 8 + w;
      const int tok = TCTX + b * 1024 + qb * 32 + l31;
      attn_block_pp<96>(lds, p.kmla_l + (size_t)l * (2 * 6 * NKL * 96) + (size_t)(b * 6 + h) * (NKL * 96),
                               p.vmla_l + (size_t)l * (2 * 6 * 64 * NKL) + (size_t)(b * 6 + h) * (64 * NKL), p.qmla + (size_t)tok * 576 + h * 96,
                               p.o + (size_t)tok * D + h * 64, 40);
      continue;
    }
    idx -= 48;
    if (idx < 48) {
      const int b = idx / 24, h = (idx >> 2) % 6, qt = idx & 3, qb = qt * 8 + w;
      const int tok = TCTX + b * 1024 + qb * 32 + l31;
      {
        const float* rg = p.na_rpb + (size_t)(l * 6 + h) * (15 * 31);
        LAS float* rl = (LAS float*)(lds + ATT_RPB_OFF);
        if (tid < 465) rl[tid] = rg[tid] * 1.4426950408889634f;
      }
      const int r0 = qt * 4;
      const int rs0 = min(max(r0 - 4, 0), 8), rs3 = min(max(r0 + 3 - 4, 0), 8);
      const int ntiles = 8 + 2 * (rs3 + 8 - rs0);
      attn_block_single<64, 1>(lds, p.kna_l + (size_t)l * (2 * 6 * NKL * 64) + (size_t)(b * 6 + h) * (NKL * 64),
                               p.vna_l + (size_t)l * (2 * 6 * 64 * NKL) + (size_t)(b * 6 + h) * (64 * NKL), p.qna + (size_t)tok * 384 + h * 64,
                               p.o + (size_t)tok * D + 384 + h * 64, 0.125f, ntiles, qb >> 1, (qb & 1) * 32 + l31, rs0);
      continue;
    }
    idx -= 48;
    if (idx < 192) {
      const int b = idx / 6, h = idx % 6;
      const int tok = b * 256 + w * 32 + l31;
      attn_block_pp<96>(lds, p.kmla_c + (size_t)(b * 6 + h) * (256 * 96), p.vmla_c + (size_t)(b * 6 + h) * (64 * 256),
                               p.qmla + (size_t)tok * 576 + h * 96, p.o + (size_t)tok * D + h * 64, 8);
      continue;
    }
    idx -= 192;
    if (idx < 192) {
      const int b = idx / 6, h = idx % 6;
      const int tok = b * 256 + w * 32 + l31;
      attn_block_pp<64>(lds, p.kna_c + (size_t)(b * 6 + h) * (256 * 64), p.vna_c + (size_t)(b * 6 + h) * (64 * 256),
                               p.qna + (size_t)tok * 384 + h * 64, p.o + (size_t)tok * D + 384 + h * 64, 8);
      continue;
    }
    idx -= 192;
    {
      const int b = idx >> 2, h = idx & 3;
      const int tok = b * 256 + w * 32 + l31;
      attn_block_diff(lds, p.kdf_c + (size_t)(b * 4 + h) * (256 * 64), p.vdf_c + (size_t)(b * 4 + h) * (64 * 256), p.qdf + (size_t)tok * 256 + h * 64,
                      p.o + (size_t)tok * D + 768 + h * 64, 0.17677669529663687f, 8, lam, p.g_df_sub + l * 64, outscale);
    }
  }
}

__global__ void __launch_bounds__(512, 2) fwd_megakernel(Params p, int ph_begin, int ph_end) {
  __shared__ __attribute__((aligned(16))) char lds[131072 + 16];
  cg::grid_group grid = cg::this_grid();
  if (ph_begin < 0) grid.sync();
  if (threadIdx.x == 0) *(uint4*)(lds + 131072) = make_uint4(0u, 0u, 0u, 0u);
  __syncthreads();
  XcdBarrier xb = xcd_barrier_post(p.bar, (volatile LAS unsigned*)(lds + 131072));
  LAS unsigned char* ldsl = (LAS unsigned char*)lds;
  for (int ph = ph_begin; ph < ph_end; ++ph) {
    if (ph > ph_begin) xcd_barrier(xb);
    if (ph == 0) { phase_prep(p, lds); continue; }
    const int l = (ph - 1) >> 3, s = (ph - 1) & 7;
    switch (s) {
      case 0: if (l == 1) prep_deferred(p, lds, 1 << 20); phase_norm(p, l, 0); break;
      case 1: { EpiIn e{p, l}; pg8::gemm_phase(ldsl, p.h, p.win_t + (size_t)l * NIN * D, T, NIN, D, e); } break;
      case 2: phase_mla_up(p, l, lds); break;
      case 3: phase_attn(p, l, lds); break;
      case 4: { EpiRes<0> e{p, l}; pg8::gemm_phase(ldsl, p.o, p.wout_t + (size_t)l * D * D, T, D, D, e); if (l == 0) prep_deferred(p, lds, BIDX >= 160 ? 4 : 0); } break;
      case 5: phase_norm(p, l, 1); break;
      case 6: { EpiGU e{p}; pg8::gemm_phase(ldsl, p.h, p.wgu_t + (size_t)l * NGU * D, T, NGU, D, e); } break;
      case 7: { EpiRes<1> e{p, l}; pg8::gemm_phase(ldsl, p.act, p.wdn_t + (size_t)l * D * DFF, T, D, DFF, e); if (l == 0) prep_deferred(p, lds, 1 << 20); } break;
    }
  }
}

extern "C" void kernel_launch(void* const* d_in, const int* in_sizes, int n_in, void* d_out, int out_size, void* d_ws, size_t ws_size,
                              hipStream_t stream) {
  static int grid_blocks = 0;
  if (!grid_blocks) {
    int dev = 0, cus = 0, per_cu = 0;
    hipGetDevice(&dev);
    hipDeviceGetAttribute(&cus, hipDeviceAttributeMultiprocessorCount, dev);
    hipOccupancyMaxActiveBlocksPerMultiprocessor(&per_cu, fwd_megakernel, 512, 0);
    if (per_cu > 1) per_cu = 1;
    if (per_cu < 1) per_cu = 1;
    grid_blocks = cus * per_cu;
  }
  Params p{};
  const float** ins = (const float**)&p;
  for (int i = 0; i < 35; ++i) ins[i] = (const float*)d_in[i];
  p.out = (float*)d_out;
  char* w = (char*)d_ws;
  size_t off = 0;
  auto alloc = [&](size_t bytes) { char* r = w + off; off += (bytes + 255) & ~(size_t)255; return r; };
  p.win_t = (u16*)alloc((size_t)2 * NIN * 1024 * 2);
  p.wuq_t = (u16*)alloc((size_t)2 * 576 * 256 * 2);
  p.wukv_t = (u16*)alloc((size_t)2 * 768 * 128 * 2);
  p.wout_t = (u16*)alloc((size_t)2 * 1024 * 1024 * 2);
  p.wgu_t = (u16*)alloc((size_t)2 * NGU * 1024 * 2);
  p.wdn_t = (u16*)alloc((size_t)2 * 1024 * DFF * 2);
  p.mod = (float*)alloc((size_t)2 * 3 * 6144 * 4);
  p.h = (u16*)alloc((size_t)T * D * 2);
  p.cq = (float*)alloc((size_t)T * 256 * 4);
  p.ckv = (float*)alloc((size_t)T * 128 * 4);
  p.krope = (float*)alloc((size_t)T * 32 * 4);
  p.qmla = (u16*)alloc((size_t)T * 576 * 2);
  p.qna = (u16*)alloc((size_t)T * 384 * 2);
  p.qdf = (u16*)alloc((size_t)T * 256 * 2);
  p.kmla_c = (u16*)alloc((size_t)32 * 6 * 256 * 96 * 2);
  p.vmla_c = (u16*)alloc((size_t)32 * 6 * 64 * 256 * 2);
  p.kna_c = (u16*)alloc((size_t)32 * 6 * 256 * 64 * 2);
  p.vna_c = (u16*)alloc((size_t)32 * 6 * 64 * 256 * 2);
  p.kdf_c = (u16*)alloc((size_t)32 * 4 * 256 * 64 * 2);
  p.vdf_c = (u16*)alloc((size_t)32 * 4 * 64 * 256 * 2);
  p.kmla_l = (u16*)alloc((size_t)2 * 2 * 6 * NKL * 96 * 2);
  p.vmla_l = (u16*)alloc((size_t)2 * 2 * 6 * 64 * NKL * 2);
  p.kna_l = (u16*)alloc((size_t)2 * 2 * 6 * NKL * 64 * 2);
  p.vna_l = (u16*)alloc((size_t)2 * 2 * 6 * 64 * NKL * 2);
  p.kdf_l = (u16*)alloc((size_t)2 * 2 * 4 * NKL * 64 * 2);
  p.vdf_l = (u16*)alloc((size_t)2 * 2 * 4 * 64 * NKL * 2);
  p.o = (u16*)alloc((size_t)T * D * 2);
  p.xa = (u16*)alloc((size_t)T * D * 2);
  p.xb = (u16*)alloc((size_t)T * D * 2);
  p.act = (u16*)alloc((size_t)T * DFF * 2);
  p.lam = (float*)alloc(256);
  p.bar = (unsigned*)alloc((size_t)XCD_BAR_WORDS * 4 + 256);
  p.counters = p.bar + XCD_BAR_WORDS;
  if (off > ws_size) { fprintf(stderr, "workspace too small: need %zu have %zu\n", off, ws_size); return; }
  hipMemsetAsync(p.bar, 0, (size_t)XCD_BAR_WORDS * 4 + 256, stream);
  int b = 0, e = 17;
  void* args[] = {&p, &b, &e};
  hipError_t err = hipLaunchCooperativeKernel((void*)fwd_megakernel, dim3(grid_blocks), dim3(512), args, 0, stream);
  if (err != hipSuccess) fprintf(stderr, "cooperative launch failed: %s (grid %d)\n", hipGetErrorString(err), grid_blocks);
}
```
